# Optimizing an MI355X kernel written in HIP

```python
import math
import jax, jax.numpy as jnp
from jax import lax
import numpy as np

D_MODEL = 1024
BATCH = 4
SEQ = 8192
DEPTH = 1

CHUNK = 64
Q_BLOCK = 128
EPS = 1e-6

FOX_HEAD_DIM = 64
FOX_WIDTH = D_MODEL // 2
FOX_HEADS = FOX_WIDTH // FOX_HEAD_DIM

SSM_WIDTH = D_MODEL // 2
SSM_GROUP = 16
SSM_GROUPS = SSM_WIDTH // SSM_GROUP
SSM_STATE = 64
DT_MIN = 1e-3
DT_MAX = 1e-1

N_BRANCHES = 2

COL_Q = FOX_WIDTH
COL_K = COL_Q + FOX_WIDTH
COL_V = COL_K + FOX_WIDTH
COL_F = COL_V + FOX_HEADS
COL_U = COL_F + SSM_WIDTH
IN_COLS = COL_U + N_BRANCHES * D_MODEL

N_GROUPS = 4
EXPERTS_PER_GROUP = 4
N_EXPERTS = N_GROUPS * EXPERTS_PER_GROUP
TOP_K_IN_GROUP = 2
EXPERT_FF = D_MODEL // 4

kernel_name = "hybrid_fox_s5_hiermoe_block"


def rms_norm(x, g):
    xf = x.astype(jnp.float32)
    y = xf * lax.rsqrt(jnp.mean(xf * xf, axis=-1, keepdims=True) + EPS)
    return (y * g.astype(jnp.float32)).astype(x.dtype)


def forgetting_attention(q, k, v, cum):
    seq = q.shape[1]
    scale = 1.0 / math.sqrt(FOX_HEAD_DIM)
    cum_h = jnp.transpose(cum, (0, 2, 1))
    outs = []
    for blk in range(seq // Q_BLOCK):
        lo, hi = blk * Q_BLOCK, (blk + 1) * Q_BLOCK
        qb, kb, vb = q[:, lo:hi], k[:, :hi], v[:, :hi]
        s = jnp.einsum('bqhd,bkhd->bhqk', qb, kb).astype(jnp.float32) * scale
        s = s + cum_h[:, :, lo:hi, None] - cum_h[:, :, None, :hi]
        q_pos = lo + jnp.arange(Q_BLOCK)
        k_pos = jnp.arange(hi)
        mask = k_pos[None, :] <= q_pos[:, None]
        s = jnp.where(mask[None, None], s, -jnp.inf)
        p = jax.nn.softmax(s, axis=-1).astype(vb.dtype)
        outs.append(jnp.einsum('bhqk,bkhd->bqhd', p, vb))
    return jnp.concatenate(outs, axis=1)


def s5_ssm(u, lambda_re, lambda_im, log_step, b_re, b_im, c_re, c_im, d_skip):
    bsz, seq, _ = u.shape
    f32 = jnp.float32
    ug = u.reshape(bsz, seq, SSM_GROUPS, SSM_GROUP).astype(f32)
    dt = jnp.exp(log_step.astype(f32))[:, None]
    lr = lambda_re.astype(f32)
    li = lambda_im.astype(f32)
    mag = jnp.exp(lr * dt)
    abar_re = mag * jnp.cos(li * dt)
    abar_im = mag * jnp.sin(li * dt)
    den = lr * lr + li * li
    num_re = abar_re - 1.0
    z_re = (num_re * lr + abar_im * li) / den
    z_im = (abar_im * lr - num_re * li) / den
    br = b_re.astype(f32)
    bi = b_im.astype(f32)
    bb_re = z_re[..., None] * br - z_im[..., None] * bi
    bb_im = z_re[..., None] * bi + z_im[..., None] * br
    bu_re = jnp.einsum('bsgc,gpc->bsgp', ug, bb_re)
    bu_im = jnp.einsum('bsgc,gpc->bsgp', ug, bb_im)
    a_re = jnp.broadcast_to(abar_re, (1, seq, SSM_GROUPS, SSM_STATE))
    a_im = jnp.broadcast_to(abar_im, (1, seq, SSM_GROUPS, SSM_STATE))

    def combine(left, right):
        ar1, ai1, br1, bi1 = left
        ar2, ai2, br2, bi2 = right
        return (ar2 * ar1 - ai2 * ai1,
                ar2 * ai1 + ai2 * ar1,
                ar2 * br1 - ai2 * bi1 + br2,
                ar2 * bi1 + ai2 * br1 + bi2)

    _, _, s_re, s_im = lax.associative_scan(combine, (a_re, a_im, bu_re, bu_im), axis=1)
    y = (jnp.einsum('bsgp,gcp->bsgc', s_re, c_re.astype(f32))
         - jnp.einsum('bsgp,gcp->bsgc', s_im, c_im.astype(f32)))
    y = y + d_skip.astype(f32).reshape(SSM_GROUPS, SSM_GROUP) * ug
    return y.reshape(bsz, seq, SSM_WIDTH)


def hierarchical_moe(h, w_rg, b_rg, w_re, b_re, w_gate, w_up, w_down):
    f32 = jnp.float32
    logits_g = (h @ w_rg).astype(f32) + b_rg.astype(f32)
    p_g = jax.nn.softmax(logits_g, axis=-1)
    g_idx = jnp.argmax(logits_g, axis=-1)
    p_sel = jnp.max(p_g, axis=-1)
    logits_e = ((h @ w_re).astype(f32) + b_re.astype(f32)).reshape(
        h.shape[0], h.shape[1], N_GROUPS, EXPERTS_PER_GROUP)
    le_sel = jnp.einsum('bsg,bsge->bse', jax.nn.one_hot(g_idx, N_GROUPS, dtype=f32), logits_e)
    top_v, top_i = lax.top_k(le_sel, TOP_K_IN_GROUP)
    w = jax.nn.softmax(top_v, axis=-1) * p_sel[..., None]
    expert_id = g_idx[..., None] * EXPERTS_PER_GROUP + top_i
    combine_w = jnp.einsum('bsk,bske->bse', w,
                           jax.nn.one_hot(expert_id, N_EXPERTS, dtype=f32)).astype(h.dtype)
    hg = jnp.einsum('bsd,edf->bsef', h, w_gate)
    hu = jnp.einsum('bsd,edf->bsef', h, w_up)
    act = jax.nn.silu(hg) * hu * combine_w[..., None]
    return jnp.einsum('bsef,efd->bsd', act, w_down)


def setup_inputs(seed: int = 0) -> dict:
    key = jax.random.key(seed)
    ks = jax.random.split(key, 32)
    f32 = jnp.float32
    L = DEPTH

    def nrm(k, shape, scale):
        return jax.random.normal(k, shape, f32) * scale

    x = nrm(ks[0], (BATCH, SEQ, D_MODEL), 1.0)
    g_mix = 1.0 + nrm(ks[1], (L, D_MODEL), 0.02)
    w_in = nrm(ks[2], (L, D_MODEL, IN_COLS), D_MODEL ** -0.5)
    b_forget = 2.0 + nrm(ks[3], (L, FOX_HEADS), 0.1)
    b_gate = nrm(ks[4], (L, N_BRANCHES * D_MODEL), 0.02)
    w_out_a = nrm(ks[5], (L, FOX_WIDTH, D_MODEL), FOX_WIDTH ** -0.5)
    lambda_re = -0.5 + nrm(ks[6], (L, SSM_GROUPS, SSM_STATE), 0.01)
    lambda_im = (jnp.pi * jnp.arange(SSM_STATE, dtype=f32))[None, None, :] \
        + nrm(ks[7], (L, SSM_GROUPS, SSM_STATE), 0.01)
    log_step = jax.random.uniform(ks[8], (L, SSM_GROUPS), f32,
                                  math.log(DT_MIN), math.log(DT_MAX))
    ssm_b_re = nrm(ks[9], (L, SSM_GROUPS, SSM_STATE, SSM_GROUP), (2 * SSM_GROUP) ** -0.5)
    ssm_b_im = nrm(ks[10], (L, SSM_GROUPS, SSM_STATE, SSM_GROUP), (2 * SSM_GROUP) ** -0.5)
    ssm_c_re = nrm(ks[11], (L, SSM_GROUPS, SSM_GROUP, SSM_STATE), SSM_STATE ** -0.5)
    ssm_c_im = nrm(ks[12], (L, SSM_GROUPS, SSM_GROUP, SSM_STATE), SSM_STATE ** -0.5)
    ssm_d = nrm(ks[13], (L, SSM_WIDTH), 1.0)
    w_glu = nrm(ks[14], (L, SSM_WIDTH, SSM_WIDTH), SSM_WIDTH ** -0.5)
    b_glu = nrm(ks[15], (L, SSM_WIDTH), 0.02)
    w_out_b = nrm(ks[16], (L, SSM_WIDTH, D_MODEL), SSM_WIDTH ** -0.5)
    w_out = nrm(ks[17], (L, D_MODEL, D_MODEL), D_MODEL ** -0.5)
    g_ffn = 1.0 + nrm(ks[18], (L, D_MODEL), 0.02)
    w_router_group = nrm(ks[19], (L, D_MODEL, N_GROUPS), D_MODEL ** -0.5)
    b_router_group = nrm(ks[20], (L, N_GROUPS), 0.01)
    w_router_expert = nrm(ks[21], (L, D_MODEL, N_EXPERTS), D_MODEL ** -0.5)
    b_router_expert = nrm(ks[22], (L, N_EXPERTS), 0.01)
    w_exp_gate = nrm(ks[23], (L, N_EXPERTS, D_MODEL, EXPERT_FF), D_MODEL ** -0.5)
    w_exp_up = nrm(ks[24], (L, N_EXPERTS, D_MODEL, EXPERT_FF), D_MODEL ** -0.5)
    w_exp_down = nrm(ks[25], (L, N_EXPERTS, EXPERT_FF, D_MODEL), EXPERT_FF ** -0.5)
    g_final = 1.0 + nrm(ks[26], (D_MODEL,), 0.02)
    return {
        "x": x, "g_mix": g_mix, "w_in": w_in, "b_forget": b_forget, "b_gate": b_gate,
        "w_out_a": w_out_a, "lambda_re": lambda_re, "lambda_im": lambda_im,
        "log_step": log_step, "ssm_b_re": ssm_b_re, "ssm_b_im": ssm_b_im,
        "ssm_c_re": ssm_c_re, "ssm_c_im": ssm_c_im, "ssm_d": ssm_d,
        "w_glu": w_glu, "b_glu": b_glu, "w_out_b": w_out_b, "w_out": w_out,
        "g_ffn": g_ffn, "w_router_group": w_router_group, "b_router_group": b_router_group,
        "w_router_expert": w_router_expert, "b_router_expert": b_router_expert,
        "w_exp_gate": w_exp_gate, "w_exp_up": w_exp_up, "w_exp_down": w_exp_down,
        "g_final": g_final,
    }


def reference(x, g_mix, w_in, b_forget, b_gate, w_out_a, lambda_re, lambda_im, log_step,
              ssm_b_re, ssm_b_im, ssm_c_re, ssm_c_im, ssm_d, w_glu, b_glu, w_out_b, w_out,
              g_ffn, w_router_group, b_router_group, w_router_expert, b_router_expert,
              w_exp_gate, w_exp_up, w_exp_down, g_final):
    bsz, seq, _ = x.shape
    for layer in range(DEPTH):
        h = rms_norm(x, g_mix[layer])
        proj = h @ w_in[layer]
        q, k, v, f_logit, u, gate_logit = jnp.split(
            proj, [COL_Q, COL_K, COL_V, COL_F, COL_U], axis=-1)

        q = q.reshape(bsz, seq, FOX_HEADS, FOX_HEAD_DIM)
        k = k.reshape(bsz, seq, FOX_HEADS, FOX_HEAD_DIM)
        v = v.reshape(bsz, seq, FOX_HEADS, FOX_HEAD_DIM)
        log_f = jax.nn.log_sigmoid(f_logit.astype(jnp.float32)
                                   + b_forget[layer].astype(jnp.float32))
        cum = jnp.cumsum(log_f, axis=1)
        o_a = forgetting_attention(q, k, v, cum).reshape(bsz, seq, FOX_WIDTH)
        y_a = o_a @ w_out_a[layer]

        y_s = s5_ssm(u, lambda_re[layer], lambda_im[layer], log_step[layer],
                     ssm_b_re[layer], ssm_b_im[layer], ssm_c_re[layer], ssm_c_im[layer],
                     ssm_d[layer]).astype(x.dtype)
        z = jax.nn.gelu(y_s)
        z = z * jax.nn.sigmoid(z @ w_glu[layer] + b_glu[layer])
        y_b = z @ w_out_b[layer]

        gates = jax.nn.sigmoid(gate_logit + b_gate[layer]).reshape(
            bsz, seq, N_BRANCHES, D_MODEL)
        merged = gates[:, :, 0, :] * y_a + gates[:, :, 1, :] * y_b
        x = x + merged @ w_out[layer]

        h2 = rms_norm(x, g_ffn[layer])
        x = x + hierarchical_moe(h2, w_router_group[layer], b_router_group[layer],
                                 w_router_expert[layer], b_router_expert[layer],
                                 w_exp_gate[layer], w_exp_up[layer], w_exp_down[layer])
    return rms_norm(x, g_final)
```

```cpp
#include <hip/hip_runtime.h>
#include <cstdint>
#include <cstdio>

#ifndef FAST_SSM
#define FAST_SSM 1
#endif
#ifndef FAST_ATTN
#define FAST_ATTN 1
#endif
#ifndef FAST_GEMM
#define FAST_GEMM 1
#endif
constexpr int BATCH = 4, SEQ = 8192, DM = 1024, T = BATCH * SEQ;
constexpr int NH = 8, HD = 64, FW = 512;
constexpr int SG = 32, SC = 16, SP = 64, SW = 512, LCH = 32, NCHB = SEQ / LCH, NCH = T / LCH;
constexpr int KY = 640;
constexpr int NPROJ = 4096;
constexpr int WIN_LD = 4104;
constexpr int NE = 16, FF = 256, NCLS = 24;
constexpr int MAXTILES = T / 256 + NCLS;
constexpr float EPS = 1e-6f;
constexpr float LOG2E = 1.4426950408889634f;
constexpr float C2 = 0.125f * LOG2E;

constexpr size_t MiB = 1u << 20;
constexpr size_t WS_CTL = 0;
constexpr size_t WS_WIN = 1 * MiB;
constexpr size_t WS_WOA = 9 * MiB;
constexpr size_t WS_WGLU = 10 * MiB;
constexpr size_t WS_WOB = 11 * MiB;
constexpr size_t WS_WO = 12 * MiB;
constexpr size_t WS_WGU = 14 * MiB;
constexpr size_t WS_WD = 30 * MiB;
constexpr size_t WS_MX = 54 * MiB;
constexpr size_t WS_WS = 74 * MiB;
constexpr size_t WS_AL = 79 * MiB;
constexpr size_t WS_CK2 = 80 * MiB;
constexpr size_t WS_LF = 81 * MiB;
constexpr size_t WS_CLS = 82 * MiB;
constexpr size_t WS_WAB = WS_CLS + 128 * 1024;
constexpr size_t WS_CNT = WS_WAB + 256 * 1024;
constexpr size_t WS_P2T = WS_CNT + 32 * 1024;
constexpr size_t WS_PW = WS_P2T + 160 * 1024;
constexpr size_t WS_TCLS = WS_PW + 320 * 1024;
constexpr size_t WS_QN = 83 * MiB;
constexpr size_t WS_KN = 83 * MiB + 65536;
constexpr size_t WS_NP = 84 * MiB;
constexpr size_t WS_XN = 96 * MiB;
constexpr size_t WS_T1 = WS_XN, WS_H2 = WS_XN;
constexpr size_t WS_Q = 160 * MiB, WS_K = 192 * MiB, WS_V = 224 * MiB;
constexpr size_t WS_MERGED = WS_Q;
constexpr size_t WS_HACT = WS_Q;
constexpr size_t WS_ZZ = WS_V;
constexpr size_t WS_UH = 256 * MiB;
constexpr size_t WS_S = 296 * MiB;
constexpr size_t WS_GATES = 312 * MiB;
constexpr size_t WS_XG = WS_GATES;
constexpr size_t WS_LIST = WS_UH;
constexpr size_t WS_LPW = WS_UH + 4 * MiB;
constexpr size_t WS_Y = WS_GATES;
constexpr size_t WS_TPOS = WS_UH + 20 * MiB;
constexpr size_t WS_PART = 392 * MiB;
constexpr size_t WS_OA = 440 * MiB;
constexpr size_t WS_Z = 472 * MiB;
constexpr size_t WS_END = 504 * MiB;

#define LAS __attribute__((address_space(3)))
typedef unsigned short bf16;
typedef float f32x4 __attribute__((ext_vector_type(4)));
typedef unsigned u32x4 __attribute__((ext_vector_type(4)));
typedef unsigned u32x2 __attribute__((ext_vector_type(2)));
typedef short bf16x8 __attribute__((ext_vector_type(8)));

typedef float f32x2_cv __attribute__((ext_vector_type(2))); typedef __bf16 bf16x2_cv __attribute__((ext_vector_type(2)));
__device__ __forceinline__ unsigned pk2(float lo, float hi) { const f32x2_cv v = {lo, hi}; const bf16x2_cv b = __builtin_convertvector(v, bf16x2_cv); return __builtin_bit_cast(unsigned, b); }
__device__ __forceinline__ unsigned f2bf(float f) { return pk2(f, 0.f) & 0xffffu; }
__device__ __forceinline__ float bf2f(unsigned b) { return __builtin_bit_cast(float, b << 16); }
__device__ __forceinline__ float wave_sum(float v) {
#pragma unroll
    for (int o = 1; o < 64; o <<= 1) v += __shfl_xor(v, o);
    return v;
}
__device__ __forceinline__ float sigmoidf_(float v) { return __builtin_amdgcn_rcpf(1.0f + __builtin_amdgcn_exp2f(v * -LOG2E)); }
__device__ __forceinline__ float sigmoid_b(float v, float nb) { return __builtin_amdgcn_rcpf(1.0f + __builtin_amdgcn_exp2f(__builtin_fmaf(v, -LOG2E, nb))); }
__device__ __forceinline__ float gelu_tanh(float y) { const float y2 = y * y; const float t = y * __builtin_fmaf(y2, -2.0f * LOG2E * 0.7978845608028654f * 0.044715f, -2.0f * LOG2E * 0.7978845608028654f); return y * __builtin_amdgcn_rcpf(1.0f + __builtin_amdgcn_exp2f(t)); }
__device__ __forceinline__ void store8(bf16* p, const float (&v)[8]) { u32x4 w; w.x = pk2(v[0], v[1]); w.y = pk2(v[2], v[3]); w.z = pk2(v[4], v[5]); w.w = pk2(v[6], v[7]); *(u32x4*)p = w; }
__device__ __forceinline__ void load8(const bf16* p, float (&v)[8]) { const u32x4 w = *(const u32x4*)p; v[0] = bf2f(w.x & 0xffffu); v[1] = bf2f(w.x >> 16); v[2] = bf2f(w.y & 0xffffu); v[3] = bf2f(w.y >> 16); v[4] = bf2f(w.z & 0xffffu); v[5] = bf2f(w.z >> 16); v[6] = bf2f(w.w & 0xffffu); v[7] = bf2f(w.w >> 16); }

__host__ __device__ __forceinline__ int pair_a(int pi) { return (pi >= 3) + (pi >= 5); }
__host__ __device__ __forceinline__ int pair_b(int pi) { return pi < 3 ? pi + 1 : (pi < 5 ? pi - 1 : 3); }
__host__ __device__ __forceinline__ int pair_idx(int a, int b) { return a == 0 ? b - 1 : (a == 1 ? b + 1 : 5); }

struct Params {
    const float* in[27];
    float* out;
    unsigned char* ws;
    int ph_lo, ph_hi;
};

struct UnitX { int pm, pn; const char* A; const char* B; int aux, tic, cnt; const char* A2; const char* B2; };
struct GemmDims { int K, lda, ldb; };
constexpr int RT_ROWB = 528;

struct SchedPlain {
    static constexpr bool GATHER = false;
    static constexpr int KSPLIT = 1 << 20;
    const bf16* A; const bf16* Bt; int nM, nN; GemmDims d;
    __device__ __forceinline__ int count() const { return nM * nN; }
    __device__ __forceinline__ bool get(int idx, UnitX& u) const {
        if (idx >= nM * nN) return false;
        int wgid = idx; { const int nwg = nM * nN, q = nwg / 8, r = nwg % 8, xcd = wgid % 8, off = wgid / 8; wgid = (xcd < r ? xcd * (q + 1) : r * (q + 1) + (xcd - r) * q) + off; }
        const int nig = 8 * nN, gid = wgid / nig, fm = gid * 8, gsz = (nM - fm) < 8 ? (nM - fm) : 8;
        u.pm = fm + ((wgid % nig) % gsz); u.pn = (wgid % nig) / gsz; u.aux = 0;
        u.A = (const char*)A + (size_t)u.pm * 256 * d.lda * 2; u.B = (const char*)Bt + (size_t)u.pn * 256 * d.ldb * 2; return true;
    }
};
struct SchedOutAB {
    static constexpr bool GATHER = false; static constexpr int KSPLIT = 8;
    const bf16* OA; const bf16* ZZ; const bf16* WoaT; const bf16* WobT;
    __device__ __forceinline__ bool get(int idx, UnitX& u) const {
        const int nM = T / 256, nN = 4; if (idx >= nM * nN) return false;
        int wgid = idx; { const int nwg = nM * nN, q = nwg / 8, r = nwg % 8, xcd = wgid % 8, off = wgid / 8; wgid = (xcd < r ? xcd * (q + 1) : r * (q + 1) + (xcd - r) * q) + off; }
        const int nig = 8 * nN, gid = wgid / nig, fm = gid * 8, gsz = (nM - fm) < 8 ? (nM - fm) : 8;
        u.pm = fm + ((wgid % nig) % gsz); u.pn = (wgid % nig) / gsz; u.aux = 0; u.tic = 0; u.cnt = 0;
        u.A = (const char*)(OA + (size_t)u.pm * 256 * 512); u.B = (const char*)(WoaT + (size_t)u.pn * 256 * 512);
        u.A2 = (const char*)(ZZ + (size_t)u.pm * 256 * 512) - (size_t)KSPLIT * 128; u.B2 = (const char*)(WobT + (size_t)u.pn * 256 * 512) - (size_t)KSPLIT * 128; return true;
    }
};
struct SchedSsmS {
    static constexpr bool GATHER = false, NHALF = true;
    static constexpr int KSPLIT = 1 << 20;
    const bf16* UH; const bf16* WsT;
    __device__ __forceinline__ int count() const { return SG * 4; }
    __device__ __forceinline__ bool get(int idx, UnitX& u) const {
        if (idx >= SG * 4) return false; const int g = idx >> 2, mt = idx & 3;
        u.pm = g * 4 + mt; u.pn = 0; u.aux = g; u.A = (const char*)(UH + ((size_t)g * NCH + mt * 256) * KY); u.B = (const char*)(WsT + (size_t)g * 128 * 512); return true;
    }
};
struct SchedSsmY {
    static constexpr bool GATHER = false;
    static constexpr int KSPLIT = 1 << 20;
    const bf16* UH; const bf16* MxT; int G;
    __device__ __forceinline__ int count() const { return SG * 8; }
    __device__ __forceinline__ bool get(int idx, UnitX& u) const {
        const int k = idx / G, c = idx - k * G; if (c >= SG * 4 || k >= 2) return false; const int g = c >> 2, mt = c & 3, nt = k;
        u.pm = g * 4 + mt; u.pn = nt; u.aux = g; u.A = (const char*)(UH + ((size_t)g * NCH + mt * 256) * KY); u.B = (const char*)(MxT + ((size_t)g * 512 + nt * 256) * KY); return true;
    }
};
struct MoeRange { int base, end, per, wskip, G;
    __device__ __forceinline__ int unit(int idx) const { int u;
        if (per > 0) { const int k = idx / G, c = idx - k * G - wskip; if (c < 0 || k >= per) return -1; u = base + c * per + k; } else u = base + idx;
        return u < end ? u : -1; } };
struct SchedMoeGU {
    static constexpr bool GATHER = true;
    static constexpr int KSPLIT = 1 << 20;
    const bf16* H2; const bf16* WguT; const int* LIST; const LAS int* tt;
    MoeRange R;
    __device__ __forceinline__ int count() const { return MAXTILES * 4; }
    __device__ __forceinline__ bool get(int idx_, UnitX& u) const {
        const int idx = R.unit(idx_); if (idx < 0) return false; const int tile = idx >> 2, pn = idx & 3; const int cls = tt[2 * tile]; if (cls < 0) return false;
        const int grp = cls / 6, pi = cls % 6, e = grp * 4 + ((pn >> 1) ? pair_b(pi) : pair_a(pi));
        u.pm = tile; u.pn = pn; u.aux = cls; u.tic = tt[2 * tile + 1]; u.cnt = tt[512 + cls]; u.A = (const char*)H2; u.B = (const char*)(WguT + ((size_t)e * 512 + (pn & 1) * 256) * DM); return true;
    }
    __device__ __forceinline__ unsigned rowoff(const UnitX& u, int r) const { const int pos = u.tic * 256 + r; const int tok = pos < u.cnt ? LIST[(size_t)u.aux * T + pos] : 0; return (unsigned)tok * (unsigned)(DM * 2); }
};
struct SchedMoeDN {
    static constexpr bool GATHER = false;
    static constexpr int KSPLIT = 1 << 20;
    const bf16* HACT; const bf16* WdT; const LAS int* tt;
    MoeRange R;
    __device__ __forceinline__ int count() const { return MAXTILES * 4; }
    __device__ __forceinline__ bool get(int idx_, UnitX& u) const {
        const int idx = R.unit(idx_); if (idx < 0) return false; const int tile = idx >> 2, pn = idx & 3; const int cls = tt[2 * tile]; if (cls < 0) return false;
        u.pm = tile; u.pn = pn; u.aux = cls; u.tic = tt[2 * tile + 1]; u.cnt = tt[512 + cls]; u.A = (const char*)(HACT + (size_t)tile * 256 * 512); u.B = (const char*)(WdT + ((size_t)cls * 1024 + pn * 256) * 512); return true;
    }
};

struct NoIn {};
struct EpiProj {
    static constexpr bool PAIR = false;
    bf16 *Q, *K, *V, *UH, *GATES; const LAS float* bgate; float* NP;
    struct In { f32x4 b0, b1; };
    __device__ __forceinline__ In load(const UnitX& u, int r, int c) const { In in; const int pn = __builtin_amdgcn_readfirstlane(u.pn);
        if (pn >= 8) { const LAS float* bp = bgate + (pn - 8) * 256 + c; in.b0 = *(const LAS f32x4*)bp; in.b1 = *(const LAS f32x4*)(bp + 4); } else { in.b0 = (f32x4){0.f, 0.f, 0.f, 0.f}; in.b1 = in.b0; } return in; }
    __device__ __forceinline__ void apply(const UnitX& u, int r, int c, const float (&v)[8], const In& in) const {
        const int pn = __builtin_amdgcn_readfirstlane(u.pn); const unsigned row = (unsigned)(u.pm * 256 + r);
        static_assert(WS_K - WS_Q == 32 * MiB && WS_V - WS_K == 32 * MiB, "q | k | v buffers equally spaced");
        if (pn < 6) { bf16* base = Q + (size_t)(pn >> 1) * (size_t)(16u << 20); const float sc = pn < 2 ? C2 : 1.0f; float w[8];
#pragma unroll
            for (int e = 0; e < 8; ++e) w[e] = v[e] * sc;
            store8(base + (row * 512u + (unsigned)((pn & 1) * 256 + c)), w);
            if (pn < 4) { float ss = ((w[0] * w[0] + w[1] * w[1]) + (w[2] * w[2] + w[3] * w[3])) + ((w[4] * w[4] + w[5] * w[5]) + (w[6] * w[6] + w[7] * w[7]));
                ss += __shfl_xor(ss, 16); ss += __shfl_xor(ss, 32);
                if ((c & 24) == 0) NP[row * 32u + (unsigned)((pn >> 1) * 16 + (pn & 1) * 8 + (c >> 5))] = ss; } }
        else if (pn < 8) { const int cc = (pn - 6) * 256 + c, g = cc >> 4, ch0 = cc & 15; const unsigned n = row >> 5, i = row & 31u; store8(UH + (((unsigned)g * NCH + n) * (unsigned)KY + i * 16u + (unsigned)ch0), v); }
        else { const unsigned cc = (unsigned)((pn - 8) * 256 + c); unsigned q[8]; const float bb[8] = {in.b0.x, in.b0.y, in.b0.z, in.b0.w, in.b1.x, in.b1.y, in.b1.z, in.b1.w};
#pragma unroll
            for (int e = 0; e < 8; ++e) q[e] = (unsigned)__builtin_fmaf(sigmoid_b(v[e], bb[e]), 255.0f, 0.5f);
            u32x2 w; w.x = q[0] | (q[1] << 8) | (q[2] << 16) | (q[3] << 24); w.y = q[4] | (q[5] << 8) | (q[6] << 16) | (q[7] << 24);
            *(u32x2*)((unsigned char*)GATES + (row * 2048u + cc)) = w; }
    }
};
struct EpiSsmS {
    static constexpr bool PAIR = false;
    float* S;
    typedef NoIn In;
    __device__ __forceinline__ In load(const UnitX&, int, int) const { return In{}; }
    __device__ __forceinline__ void apply(const UnitX& u, int r, int c, const float (&v)[8], const In&) const {
        if (c >= 128) return;
        float* p = S + ((size_t)u.pm * 256 + r) * 128 + c;
        *(f32x4*)p = (f32x4){v[0], v[1], v[2], v[3]}; *(f32x4*)(p + 4) = (f32x4){v[4], v[5], v[6], v[7]};
    }
};
struct EpiSsmY {
    static constexpr bool PAIR = false;
    bf16* Z;
    typedef NoIn In;
    __device__ __forceinline__ In load(const UnitX&, int, int) const { return In{}; }
    __device__ __forceinline__ void apply(const UnitX& u, int r, int c, const float (&v)[8], const In&) const {
        const int g = u.aux, chunk = (u.pm & 3) * 256 + r, col = u.pn * 256 + c, j = col >> 4, o0 = col & 15; const int token = chunk * LCH + j; float w[8];
#pragma unroll
        for (int e = 0; e < 8; ++e) w[e] = gelu_tanh(v[e]);
        store8(Z + (size_t)token * SW + g * 16 + o0, w);
    }
};
struct EpiGlu {
    static constexpr bool PAIR = false;
    const bf16* Z; bf16* ZZ; const LAS float* bglu;
    struct In { u32x4 z; f32x4 b0, b1; };
    __device__ __forceinline__ In load(const UnitX& u, int r, int c) const { In in; const int row = u.pm * 256 + r, col = u.pn * 256 + c;
        in.z = *(const u32x4*)(Z + (size_t)row * SW + col); in.b0 = *(const LAS f32x4*)(bglu + col); in.b1 = *(const LAS f32x4*)(bglu + col + 4); return in; }
    __device__ __forceinline__ void apply(const UnitX& u, int r, int c, const float (&v)[8], const In& in) const {
        const int row = u.pm * 256 + r, col = u.pn * 256 + c; float w[8];
        const float z[8] = {bf2f(in.z.x & 0xffffu), bf2f(in.z.x >> 16), bf2f(in.z.y & 0xffffu), bf2f(in.z.y >> 16), bf2f(in.z.z & 0xffffu), bf2f(in.z.z >> 16), bf2f(in.z.w & 0xffffu), bf2f(in.z.w >> 16)};
        const float bb[8] = {in.b0.x, in.b0.y, in.b0.z, in.b0.w, in.b1.x, in.b1.y, in.b1.z, in.b1.w};
#pragma unroll
        for (int e = 0; e < 8; ++e) w[e] = z[e] * sigmoid_b(v[e], bb[e]);
        store8(ZZ + (size_t)row * SW + col, w);
    }
};
__device__ __forceinline__ void unpack_u8(const u32x2 w, float (&v)[8]) { const float s = 1.0f / 255.0f;
    v[0] = (float)(w.x & 0xffu) * s; v[1] = (float)((w.x >> 8) & 0xffu) * s; v[2] = (float)((w.x >> 16) & 0xffu) * s; v[3] = (float)(w.x >> 24) * s;
    v[4] = (float)(w.y & 0xffu) * s; v[5] = (float)((w.y >> 8) & 0xffu) * s; v[6] = (float)((w.y >> 16) & 0xffu) * s; v[7] = (float)(w.y >> 24) * s; }
struct EpiOutA {
    static constexpr bool PAIR = false;
    const bf16* GATES; bf16* T1;
    struct In { u32x2 g; };
    __device__ __forceinline__ In load(const UnitX& u, int r, int c) const { In in; in.g = *(const u32x2*)((const unsigned char*)GATES + (size_t)(u.pm * 256 + r) * 2048 + u.pn * 256 + c); return in; }
    __device__ __forceinline__ void apply(const UnitX& u, int r, int c, const float (&v)[8], const In& in) const {
        const int row = u.pm * 256 + r, col = u.pn * 256 + c; float g[8], w[8]; unpack_u8(in.g, g);
#pragma unroll
        for (int e = 0; e < 8; ++e) w[e] = g[e] * v[e];
        store8(T1 + (size_t)row * DM + col, w);
    }
};
struct EpiOutB {
    static constexpr bool PAIR = false;
    const bf16* GATES; const bf16* T1; bf16* MG;
    struct In { u32x2 g; u32x4 t; };
    __device__ __forceinline__ In load(const UnitX& u, int r, int c) const { In in; const int row = u.pm * 256 + r, col = u.pn * 256 + c;
        in.g = *(const u32x2*)((const unsigned char*)GATES + (size_t)row * 2048 + 1024 + col); in.t = *(const u32x4*)(T1 + (size_t)row * DM + col); return in; }
    __device__ __forceinline__ void apply(const UnitX& u, int r, int c, const float (&v)[8], const In& in) const {
        const int row = u.pm * 256 + r, col = u.pn * 256 + c; float g[8], w[8]; unpack_u8(in.g, g);
        const float t[8] = {bf2f(in.t.x & 0xffffu), bf2f(in.t.x >> 16), bf2f(in.t.y & 0xffffu), bf2f(in.t.y >> 16), bf2f(in.t.z & 0xffffu), bf2f(in.t.z >> 16), bf2f(in.t.w & 0xffffu), bf2f(in.t.w >> 16)};
#pragma unroll
        for (int e = 0; e < 8; ++e) w[e] = t[e] + g[e] * v[e];
        store8(MG + (size_t)row * DM + col, w);
    }
};
struct EpiOutAB {
    static constexpr bool PAIR = false, MID = true;
    const unsigned char* GATES; bf16* MG;
    struct In { u32x2 g; };
    struct MidIn { u32x2 g0, g1; };
    __device__ __forceinline__ MidIn mid_load(const UnitX& u, int r, int c) const { MidIn in; const unsigned char* p = GATES + (size_t)(u.pm * 256 + r) * 2048 + u.pn * 256 + c; in.g0 = *(const u32x2*)p; in.g1 = *(const u32x2*)(p + 1024); return in; }
    __device__ __forceinline__ void mid_apply(float (&v)[8], const MidIn& in) const { float g0[8], g1[8]; unpack_u8(in.g0, g0); unpack_u8(in.g1, g1);
#pragma unroll
        for (int e = 0; e < 8; ++e) v[e] *= g0[e] * __builtin_amdgcn_rcpf(fmaxf(g1[e], 1.0f / 512.0f)); }
    __device__ __forceinline__ In load(const UnitX& u, int r, int c) const { In in; in.g = *(const u32x2*)(GATES + (size_t)(u.pm * 256 + r) * 2048 + 1024 + u.pn * 256 + c); return in; }
    __device__ __forceinline__ void apply(const UnitX& u, int r, int c, const float (&v)[8], const In& in) const {
        float g1[8], w[8]; unpack_u8(in.g, g1);
#pragma unroll
        for (int e = 0; e < 8; ++e) w[e] = v[e] * fmaxf(g1[e], 1.0f / 512.0f);
        store8(MG + (size_t)(u.pm * 256 + r) * DM + u.pn * 256 + c, w);
    }
};
struct EpiWout {
    static constexpr bool PAIR = false, ROWJ = true;
    const float* x; bf16* X1B; float* PART; const LAS unsigned char* TB;
    struct In { f32x4 a, b; };
    __device__ __forceinline__ In load(const UnitX& u, int r, int c) const { In in; const size_t off = (size_t)(u.pm * 256 + r) * DM + u.pn * 256 + c; in.a = *(const f32x4*)(x + off); in.b = *(const f32x4*)(x + off + 4); return in; }
    __device__ __forceinline__ void apply2(const UnitX& u, int r, int c, const float (&v0)[8], const float (&v1)[8], const In& i0, const In& i1) const {
        const int fr = r & 15, fq = (c >> 3) & 3, wc = c >> 5; const unsigned row = (unsigned)(u.pm * 256 + r);
        const float xa[2][8] = {{i0.a.x + v0[0], i0.a.y + v0[1], i0.a.z + v0[2], i0.a.w + v0[3], i0.b.x + v0[4], i0.b.y + v0[5], i0.b.z + v0[6], i0.b.w + v0[7]},
                                {i1.a.x + v1[0], i1.a.y + v1[1], i1.a.z + v1[2], i1.a.w + v1[3], i1.b.x + v1[4], i1.b.y + v1[5], i1.b.z + v1[6], i1.b.w + v1[7]}};
        float ss = 0.f; f32x4 lg0 = {0.f, 0.f, 0.f, 0.f}, lg1 = {0.f, 0.f, 0.f, 0.f};
        const LAS unsigned char* t0 = TB + fr * RT_ROWB + c * 2; const LAS unsigned char* t1 = TB + (16 + (fr & 3)) * RT_ROWB + c * 2;
#pragma unroll
        for (int bj = 0; bj < 2; ++bj) { const float (&xv)[8] = xa[bj];
            const unsigned h0 = pk2(xv[0], xv[1]), h1 = pk2(xv[2], xv[3]), h2 = pk2(xv[4], xv[5]), h3 = pk2(xv[6], xv[7]);
            const unsigned l0 = pk2(xv[0] - bf2f(h0 & 0xffffu), xv[1] - bf2f(h0 >> 16)), l1 = pk2(xv[2] - bf2f(h1 & 0xffffu), xv[3] - bf2f(h1 >> 16)),
                           l2 = pk2(xv[4] - bf2f(h2 & 0xffffu), xv[5] - bf2f(h2 >> 16)), l3 = pk2(xv[6] - bf2f(h3 & 0xffffu), xv[7] - bf2f(h3 >> 16));
            *(u32x4*)(X1B + (row * (unsigned)DM + (unsigned)(u.pn * 256 + bj * 128 + c))) = (u32x4){h0, h1, h2, h3};
            ss += ((xv[0] * xv[0] + xv[1] * xv[1]) + (xv[2] * xv[2] + xv[3] * xv[3])) + ((xv[4] * xv[4] + xv[5] * xv[5]) + (xv[6] * xv[6] + xv[7] * xv[7]));
            const bf16x8 xh = __builtin_bit_cast(bf16x8, (u32x4){h0, h1, h2, h3}), xl = __builtin_bit_cast(bf16x8, (u32x4){l0, l1, l2, l3});
            const bf16x8 th0 = *(const LAS bf16x8*)(t0 + bj * 256), tl0 = *(const LAS bf16x8*)(t0 + bj * 256 + 20 * RT_ROWB), th1 = *(const LAS bf16x8*)(t1 + bj * 256), tl1 = *(const LAS bf16x8*)(t1 + bj * 256 + 20 * RT_ROWB);
            lg0 = __builtin_amdgcn_mfma_f32_16x16x32_bf16(th0, xh, lg0, 0, 0, 0); lg0 = __builtin_amdgcn_mfma_f32_16x16x32_bf16(th0, xl, lg0, 0, 0, 0); lg0 = __builtin_amdgcn_mfma_f32_16x16x32_bf16(tl0, xh, lg0, 0, 0, 0);
            lg1 = __builtin_amdgcn_mfma_f32_16x16x32_bf16(th1, xh, lg1, 0, 0, 0); lg1 = __builtin_amdgcn_mfma_f32_16x16x32_bf16(th1, xl, lg1, 0, 0, 0); lg1 = __builtin_amdgcn_mfma_f32_16x16x32_bf16(tl1, xh, lg1, 0, 0, 0); }
        ss += __shfl_xor(ss, 16); ss += __shfl_xor(ss, 32);
        f32x4* p = (f32x4*)PART + ((unsigned)((u.pn * 4 + wc) * 6) * (unsigned)T + row);
        p[(unsigned)fq * (unsigned)T] = lg0; if (fq == 0) p[4u * (unsigned)T] = lg1; if (fq == 1) p[5u * (unsigned)T] = (f32x4){ss, 0.f, 0.f, 0.f};
    }
};
struct EpiMoeGU {
    static constexpr bool PAIR = true;
    bf16* HACT; const float* LPW;
    struct In { f32x4 pw; };
    __device__ __forceinline__ In load(const UnitX& u, int r, int) const { In in; const int pos = u.tic * 256 + r; in.pw = (f32x4){0.f, 0.f, 0.f, 0.f}; if (pos < u.cnt) in.pw = *((const f32x4*)LPW + (size_t)u.aux * T + pos); return in; }
    __device__ __forceinline__ void apply_pair(const UnitX& u, int r, int c, const float (&vg)[8], const float (&vu)[8], const In& in) const {
        const float w = (u.pn >> 1) ? in.pw.y : in.pw.x, rs = in.pw.z; float o[8];
#pragma unroll
        for (int e = 0; e < 8; ++e) { const float gt = vg[e] * rs; o[e] = gt * sigmoidf_(gt) * (vu[e] * rs) * w; }
        store8(HACT + (size_t)(u.pm * 256 + r) * 512 + (u.pn >> 1) * 256 + (u.pn & 1) * 128 + c, o);
    }
};
struct EpiMoeDN {
    static constexpr bool PAIR = false;
    bf16* Y;
    typedef NoIn In;
    __device__ __forceinline__ In load(const UnitX&, int, int) const { return In{}; }
    __device__ __forceinline__ void apply(const UnitX& u, int r, int c, const float (&v)[8], const In&) const { store8(Y + (size_t)(u.pm * 256 + r) * DM + u.pn * 256 + c, v); }
};

namespace pg8 {
constexpr int BM = 256, BK = 64, HALF = 128, HTB = HALF * BK * 2, STAGE_BYTES = 8 * HTB;
__host__ __device__ __forceinline__ int lds_byte(int r, int c) { const int st = (r >> 4) * 2 + (c >> 5), rr = r & 15, cc = c & 31, ob = rr * 64 + cc * 2; return st * 1024 + (ob ^ (((ob >> 9) & 1) << 5)); }
__host__ __device__ __forceinline__ void stage_rc(int b, int& R, int& C) { const int st = b / 1024, sb = b % 1024, swz = sb ^ (((sb >> 9) & 1) << 5); R = (st >> 1) * 16 + swz / 64; C = (st & 1) * 32 + (swz % 64) / 2; }
__host__ __device__ __forceinline__ int perm32(int rho) { const int n = rho >> 4, i = rho & 15; return 8 * (i >> 2) + 4 * n + (i & 3); }

template <class Epi, class = void> struct HasMid { static constexpr bool value = false; };
template <class Epi> struct HasMid<Epi, decltype((void)Epi::MID)> { static constexpr bool value = Epi::MID; };
template <class S, class = void> struct HasNHalf { static constexpr bool value = false; };
template <class S> struct HasNHalf<S, decltype((void)S::NHALF)> { static constexpr bool value = S::NHALF; };
template <class Epi, class = void> struct HasRowJ { static constexpr bool value = false; };
template <class Epi> struct HasRowJ<Epi, decltype((void)Epi::ROWJ)> { static constexpr bool value = Epi::ROWJ; };
template <class Epi> struct EpiAdapt {
    static constexpr bool PERM = true, MID = HasMid<Epi>::value;
    Epi E;
    __device__ __forceinline__ void mid(f32x4 (&acc)[2][2][4][2], const UnitX& u, int wr, int wc, int fr, int fq) const {
        if constexpr (MID) { asm volatile("" : "+v"(fr), "+v"(fq));
            const int c = wc * 32 + 8 * fq;
#pragma unroll
            for (int ai = 0; ai < 2; ++ai) { typename Epi::MidIn in[4][2];
#pragma unroll
                for (int m = 0; m < 4; ++m)
#pragma unroll
                    for (int bj = 0; bj < 2; ++bj) in[m][bj] = E.mid_load(u, ai * HALF + wr * 64 + m * 16 + fr, bj * HALF + c);
#pragma unroll
                for (int m = 0; m < 4; ++m)
#pragma unroll
                    for (int bj = 0; bj < 2; ++bj) { f32x4& a0 = acc[ai][bj][m][0]; f32x4& a1 = acc[ai][bj][m][1]; float v[8] = {a0[0], a0[1], a0[2], a0[3], a1[0], a1[1], a1[2], a1[3]};
                        E.mid_apply(v, in[m][bj]); a0 = (f32x4){v[0], v[1], v[2], v[3]}; a1 = (f32x4){v[4], v[5], v[6], v[7]}; } } }
    }
    __device__ __forceinline__ void operator()(const f32x4 (&acc)[2][2][4][2], const UnitX& u, int wr, int wc, int fr, int fq) const {
        asm volatile("" : "+v"(fr), "+v"(fq));
        const int c = wc * 32 + 8 * fq;
#pragma unroll
        for (int ai = 0; ai < 2; ++ai) {
            if constexpr (Epi::PAIR) { typename Epi::In in[4];
#pragma unroll
                for (int m = 0; m < 4; ++m) in[m] = E.load(u, ai * HALF + wr * 64 + m * 16 + fr, c);
#pragma unroll
                for (int m = 0; m < 4; ++m) { const int r = ai * HALF + wr * 64 + m * 16 + fr; const f32x4 g0 = acc[ai][0][m][0], g1 = acc[ai][0][m][1], u0 = acc[ai][1][m][0], u1 = acc[ai][1][m][1];
                    const float vg[8] = {g0[0], g0[1], g0[2], g0[3], g1[0], g1[1], g1[2], g1[3]}, vu[8] = {u0[0], u0[1], u0[2], u0[3], u1[0], u1[1], u1[2], u1[3]};
                    E.apply_pair(u, r, c, vg, vu, in[m]); } }
            else if constexpr (HasRowJ<Epi>::value) {
#pragma unroll
                for (int mp = 0; mp < 4; mp += 2) { typename Epi::In in[2][2];
#pragma unroll
                    for (int m = 0; m < 2; ++m)
#pragma unroll
                        for (int bj = 0; bj < 2; ++bj) in[m][bj] = E.load(u, ai * HALF + wr * 64 + (mp + m) * 16 + fr, bj * HALF + c);
#pragma unroll
                    for (int m = 0; m < 2; ++m) { const int r = ai * HALF + wr * 64 + (mp + m) * 16 + fr; const f32x4 a0 = acc[ai][0][mp + m][0], a1 = acc[ai][0][mp + m][1], b0 = acc[ai][1][mp + m][0], b1 = acc[ai][1][mp + m][1];
                        const float v0[8] = {a0[0], a0[1], a0[2], a0[3], a1[0], a1[1], a1[2], a1[3]}, v1[8] = {b0[0], b0[1], b0[2], b0[3], b1[0], b1[1], b1[2], b1[3]};
                        E.apply2(u, r, c, v0, v1, in[m][0], in[m][1]); } } }
            else { typename Epi::In in[4][2];
#pragma unroll
                for (int m = 0; m < 4; ++m)
#pragma unroll
                    for (int bj = 0; bj < 2; ++bj) in[m][bj] = E.load(u, ai * HALF + wr * 64 + m * 16 + fr, bj * HALF + c);
#pragma unroll
                for (int m = 0; m < 4; ++m)
#pragma unroll
                    for (int bj = 0; bj < 2; ++bj) { const int r = ai * HALF + wr * 64 + m * 16 + fr; const f32x4 a0 = acc[ai][bj][m][0], a1 = acc[ai][bj][m][1];
                        const float v[8] = {a0[0], a0[1], a0[2], a0[3], a1[0], a1[1], a1[2], a1[3]}; E.apply(u, r, bj * HALF + c, v, in[m][bj]); } } }
    }
};

template <class Epi, class Sched, bool ALIGN_EPI, bool SP2>
__device__ __forceinline__ void gemm_phase(LAS unsigned char* lds, const GemmDims d, const Sched& S, const Epi& E, const int G, const int cidx) {
    int tid = threadIdx.x; asm volatile("" : "+v"(tid));
    const int wid = __builtin_amdgcn_readfirstlane(tid >> 6), lane = tid & 63, wr = wid >> 2, wc = wid & 3, fr = lane & 15, fq = lane >> 4;
    const int K = d.K, nt = K / BK;
    unsigned voffB[2]; int RA[2], CA2[2];
#pragma unroll
    for (int i = 0; i < 2; ++i) { int R, C; stage_rc(tid * 16 + i * 8192, R, C); const int Rb = Epi::PERM ? ((R & ~31) + perm32(R & 31)) : R;
        RA[i] = R; CA2[i] = C * 2; voffB[i] = (unsigned)(Rb * d.ldb + C) * 2u; }
    const size_t kstep = (size_t)(BK * 2);
    const size_t hstepB = (size_t)HALF * d.ldb * 2;
#define PG8_AOFF(dst, unit) do { _Pragma("unroll") for (int h_ = 0; h_ < 2; ++h_) _Pragma("unroll") for (int i_ = 0; i_ < 2; ++i_) { \
        if constexpr (Sched::GATHER) dst[h_][i_] = S.rowoff(unit, h_ * HALF + RA[i_]) + (unsigned)CA2[i_]; else dst[h_][i_] = (unsigned)((h_ * HALF + RA[i_]) * d.lda) * 2u + (unsigned)CA2[i_]; } } while (0)
    const unsigned ldsw = (unsigned)wid * 1024u;
    const int aoff = lds_byte(wr * 64 + fr, fq * 8), boff = lds_byte(wc * 32 + fr, fq * 8);
#define PG8_SA(b, h) (((b) * 2 + (h)) * HTB)
#define PG8_SB(b, h) ((4 + (b) * 2 + (h)) * HTB)
#define PG8_STAGE(bufoff, gbase, voff) do { _Pragma("unroll") for (int _i = 0; _i < 2; ++_i) \
        __builtin_amdgcn_global_load_lds((const unsigned*)((const char*)(gbase) + (voff)[_i]), (LAS unsigned*)(lds + (bufoff) + ldsw + _i * 8192), 16, 0, 0); } while (0)
#define PG8_LDA(dst, b, h) do { _Pragma("unroll") for (int m = 0; m < 4; ++m) _Pragma("unroll") for (int k = 0; k < 2; ++k) dst[m][k] = *(const LAS bf16x8*)(lds + PG8_SA(b, h) + aoff + m * 2048 + k * 1024); } while (0)
#define PG8_LDB(dst, b, h) do { _Pragma("unroll") for (int n = 0; n < 2; ++n) _Pragma("unroll") for (int k = 0; k < 2; ++k) dst[n][k] = *(const LAS bf16x8*)(lds + PG8_SB(b, h) + boff + n * 2048 + k * 1024); } while (0)
#define PG8_MMA(ai, bj, At, Bt) do { __builtin_amdgcn_s_setprio(1); _Pragma("unroll") for (int m = 0; m < 4; ++m) _Pragma("unroll") for (int n = 0; n < 2; ++n) _Pragma("unroll") for (int k = 0; k < 2; ++k) \
        acc[ai][bj][m][n] = __builtin_amdgcn_mfma_f32_16x16x32_bf16(Bt[n][k], At[m][k], acc[ai][bj][m][n], 0, 0, 0); __builtin_amdgcn_s_setprio(0); } while (0)
#define PG8_WAIT_V(n) asm volatile("s_waitcnt vmcnt(" #n ")" ::: "memory")
#define PG8_WAIT_L(n) asm volatile("s_waitcnt lgkmcnt(" #n ")" ::: "memory")
#define PG8_BAR __builtin_amdgcn_s_barrier()
#define PG8_SCHED __builtin_amdgcn_sched_barrier(0)
    UnitX cur, nxt; int ui = 0;
    if (!S.get(cidx, cur)) return;
    f32x4 acc[2][2][4][2];
#pragma unroll
    for (int a = 0; a < 2; ++a)
#pragma unroll
        for (int b = 0; b < 2; ++b)
#pragma unroll
            for (int m = 0; m < 4; ++m)
#pragma unroll
                for (int n = 0; n < 2; ++n) acc[a][b][m][n] = (f32x4){0.f, 0.f, 0.f, 0.f};
    bf16x8 At[4][2], B0[2][2], B1[2][2];
    const char* cA = cur.A; const char* cB = cur.B;
    constexpr bool NHALF = HasNHalf<Sched>::value;
    constexpr int KS = Sched::KSPLIT;
    const char* cA2 = KS < 1024 ? cur.A2 : cA; const char* cB2 = KS < 1024 ? cur.B2 : cB;
    unsigned vA[2][2], nvA[2][2]; PG8_AOFF(vA, cur);
    static_assert(SP2, "this port keeps the SP2 loop only");
    {
        PG8_STAGE(PG8_SB(0, 0), cB, voffB); PG8_STAGE(PG8_SB(0, 1), cB + hstepB, voffB); PG8_STAGE(PG8_SA(0, 0), cA, vA[0]); PG8_STAGE(PG8_SA(0, 1), cA, vA[1]);
        if (wr == 1) PG8_BAR;
        PG8_WAIT_V(2); PG8_BAR;
        PG8_STAGE(PG8_SB(1, 0), cB + kstep, voffB); PG8_STAGE(PG8_SA(1, 0), cA + kstep, vA[0]); PG8_STAGE(PG8_SB(1, 1), cB + hstepB + kstep, voffB);
        PG8_WAIT_V(6); PG8_BAR;
    }
    for (;;) {
        const bool has_next = S.get((ui + 1) * G + cidx, nxt);
        const char* nA = has_next ? nxt.A : cA; const char* nB = has_next ? nxt.B : cB;
        if (has_next) { PG8_AOFF(nvA, nxt); } else {
#pragma unroll
            for (int h_ = 0; h_ < 2; ++h_)
#pragma unroll
                for (int i_ = 0; i_ < 2; ++i_) nvA[h_][i_] = vA[h_][i_]; }
        for (int t = 0; t < nt; t += 2) {
            const bool last = (t == nt - 2);
            if constexpr (Epi::MID) { if (t == KS) E.mid(acc, cur, wr, wc, fr, fq); }
            const char* a1 = ((t + 1 >= KS) ? cA2 : cA) + (size_t)(t + 1) * kstep;
            const char* a2 = last ? nA : ((t + 2 >= KS) ? cA2 : cA) + (size_t)(t + 2) * kstep; const char* b2 = last ? nB : ((t + 2 >= KS) ? cB2 : cB) + (size_t)(t + 2) * kstep;
            const char* a3 = a2 + kstep; const char* b3 = b2 + kstep;
            unsigned wA0[2], wA1[2];
#pragma unroll
            for (int i_ = 0; i_ < 2; ++i_) { wA0[i_] = last ? nvA[0][i_] : vA[0][i_]; wA1[i_] = last ? nvA[1][i_] : vA[1][i_]; }
            PG8_LDB(B0, 0, 0); PG8_LDB(B1, 0, 1); PG8_SCHED; PG8_LDA(At, 0, 0); PG8_STAGE(PG8_SA(1, 1), a1, vA[1]);
            PG8_WAIT_V(8); PG8_WAIT_L(0); PG8_BAR; PG8_MMA(0, 0, At, B0); if constexpr (!NHALF) PG8_MMA(0, 1, At, B1); PG8_BAR; PG8_SCHED;
            PG8_LDA(At, 0, 1); PG8_STAGE(PG8_SB(0, 0), b2, voffB); PG8_STAGE(PG8_SB(0, 1), b2 + hstepB, voffB); PG8_STAGE(PG8_SA(0, 0), a2, wA0);
            PG8_WAIT_V(8); PG8_WAIT_L(0); PG8_BAR; PG8_MMA(1, 0, At, B0); if constexpr (!NHALF) PG8_MMA(1, 1, At, B1); PG8_BAR; PG8_SCHED;
            PG8_LDB(B0, 1, 0); PG8_LDB(B1, 1, 1); PG8_SCHED; PG8_LDA(At, 1, 0); PG8_STAGE(PG8_SA(0, 1), a2, wA1);
            PG8_WAIT_V(8); PG8_WAIT_L(0); PG8_BAR; PG8_MMA(0, 0, At, B0); if constexpr (!NHALF) PG8_MMA(0, 1, At, B1); PG8_BAR; PG8_SCHED;
            PG8_LDA(At, 1, 1); PG8_STAGE(PG8_SB(1, 0), b3, voffB); PG8_STAGE(PG8_SB(1, 1), b3 + hstepB, voffB); PG8_STAGE(PG8_SA(1, 0), a3, wA0);
            PG8_WAIT_V(8); PG8_WAIT_L(0); PG8_BAR; PG8_MMA(1, 0, At, B0); if constexpr (!NHALF) PG8_MMA(1, 1, At, B1); PG8_BAR; PG8_SCHED;
        }
        if constexpr (ALIGN_EPI) { if (wr == 0) PG8_BAR; }
        E(acc, cur, wr, wc, fr, fq);
        if (!has_next) break;
#pragma unroll
        for (int a = 0; a < 2; ++a)
#pragma unroll
            for (int b = 0; b < 2; ++b)
#pragma unroll
                for (int m = 0; m < 4; ++m)
#pragma unroll
                    for (int n = 0; n < 2; ++n) acc[a][b][m][n] = (f32x4){0.f, 0.f, 0.f, 0.f};
        cur = nxt; cA = nA; cB = nB; ++ui; if constexpr (KS < 1024) { cA2 = cur.A2; cB2 = cur.B2; }
#pragma unroll
        for (int h_ = 0; h_ < 2; ++h_)
#pragma unroll
            for (int i_ = 0; i_ < 2; ++i_) vA[h_][i_] = nvA[h_][i_];
        if constexpr (ALIGN_EPI) { if (wr == 1) PG8_BAR; }
    }
    PG8_WAIT_V(0);
    if constexpr (!ALIGN_EPI) { if (wr == 0) PG8_BAR; }
    PG8_BAR;
#undef PG8_SA
#undef PG8_SB
#undef PG8_STAGE
#undef PG8_LDA
#undef PG8_LDB
#undef PG8_MMA
#undef PG8_WAIT_V
#undef PG8_WAIT_L
#undef PG8_BAR
#undef PG8_SCHED
#undef PG8_AOFF
}
}
template <class Sched, class Epi> __device__ __forceinline__ void run_gemm(LAS unsigned char* lds, const GemmDims d, const Sched& S, const Epi& E) {
    pg8::EpiAdapt<Epi> EA{E};
    pg8::gemm_phase<pg8::EpiAdapt<Epi>, Sched, true, true>(lds, d, S, EA, (int)gridDim.x, (int)blockIdx.x);
}

constexpr int NWAVES = 8, NTHR = 512;
constexpr int LDS_BYTES = 163840;
constexpr int RING_BYTES = 131072;
constexpr int CW_GCNT = 9216;
constexpr int BIAS_OFF = 139264;
constexpr int RT_OFF = RING_BYTES + 4096;
static_assert(RT_OFF + 40 * RT_ROWB <= LDS_BYTES, "router table fits");
constexpr int TT_OFF = RING_BYTES + 1024;

struct Frame { LAS unsigned char* lds; int tid, lane, wave, vcu, G; };
#define LAUNDER(F) do { (F).tid = (int)threadIdx.x; (F).lane = (int)threadIdx.x & 63; asm volatile("" : "+v"((F).tid), "+v"((F).lane)); } while (0)

__device__ __forceinline__ void transpose_item(const float* W, int ldw, int k0, int scol0, bf16* WT, int ldd, int drow0, int dcol0, LAS float* scr, int lane, bf16* WT2 = nullptr, int dcol2 = 0, bf16* WT3 = nullptr, int dcol3 = 0, const float* ks = nullptr) {
    { f32x4 t[8];
#pragma unroll
        for (int i = 0; i < 8; ++i) t[i] = *(const f32x4*)(W + (size_t)(k0 + 8 * i + (lane >> 3)) * ldw + scol0 + (lane & 7) * 4);
        if (ks) { float sc[8];
#pragma unroll
            for (int i = 0; i < 8; ++i) sc[i] = ks[k0 + 8 * i + (lane >> 3)];
#pragma unroll
            for (int i = 0; i < 8; ++i) t[i] = t[i] * sc[i]; }
#pragma unroll
        for (int i = 0; i < 8; ++i) { LAS float* d = scr + (8 * i + (lane >> 3)) * 33 + (lane & 7) * 4; d[0] = t[i].x; d[1] = t[i].y; d[2] = t[i].z; d[3] = t[i].w; } }
    asm volatile("s_waitcnt lgkmcnt(0)" ::: "memory");
    const int c = lane & 7;
#pragma unroll
    for (int j = 0; j < 4; ++j) { const int n = (lane >> 3) + 8 * j; const LAS float* s = scr + (8 * c) * 33 + n;
        u32x4 o; o.x = pk2(s[0 * 33], s[1 * 33]); o.y = pk2(s[2 * 33], s[3 * 33]); o.z = pk2(s[4 * 33], s[5 * 33]); o.w = pk2(s[6 * 33], s[7 * 33]);
        *(u32x4*)(WT + (size_t)(drow0 + n) * ldd + dcol0 + k0 + 8 * c) = o;
        if (WT2) *(u32x4*)(WT2 + (size_t)(drow0 + n) * ldd + dcol2 + k0 + 8 * c) = o;
        if (WT3) *(u32x4*)(WT3 + (size_t)(drow0 + n) * ldd + dcol3 + k0 + 8 * c) = o; }
    asm volatile("s_waitcnt lgkmcnt(0)" ::: "memory");
}

__device__ __forceinline__ void p0_weights(const Frame& Fin_, const Params& P, const int part) {
    Frame F = Fin_; LAUNDER(F);
    LAS float* scr = (LAS float*)(F.lds + F.wave * 16384);
    unsigned char* ws = P.ws;
    constexpr int I_IN = 16 * 128, I_OA = 8 * 32, I_GLU = 8 * 16, I_OB = 8 * 32, I_O = 16 * 32, I_G = 16 * 16 * 8, I_U = I_G, I_D = 16 * 4 * 32;
    constexpr int NEARLY = I_IN + I_OA + I_GLU + I_OB + I_O, NITEMS = NEARLY + I_G + I_U + I_D;
    const int gw = part == 0 ? F.vcu * NWAVES + F.wave : ((int)blockIdx.x - 128) * NWAVES + F.wave, NGW = part == 0 ? F.G * NWAVES : (F.G - 128) * NWAVES;
    for (int it = (part == 0 ? 0 : NEARLY) + gw; it < (part == 0 ? NEARLY : NITEMS); it += NGW) {
        int r = it;
        if (r < I_IN) { const int kb = r / 128, nb = r % 128, n0 = nb * 32; transpose_item(P.in[2], WIN_LD, kb * 64, n0 + (n0 >= 1536 ? 8 : 0), (bf16*)(ws + WS_WIN), 1024, n0, 0, scr, F.lane); continue; } r -= I_IN;
        if (r < I_OA) { const int kb = r / 32, nb = r % 32; transpose_item(P.in[5], 1024, kb * 64, nb * 32, (bf16*)(ws + WS_WOA), 512, nb * 32, 0, scr, F.lane); continue; } r -= I_OA;
        if (r < I_GLU) { const int kb = r / 16, nb = r % 16; transpose_item(P.in[14], 512, kb * 64, nb * 32, (bf16*)(ws + WS_WGLU), 512, nb * 32, 0, scr, F.lane); continue; } r -= I_GLU;
        if (r < I_OB) { const int kb = r / 32, nb = r % 32; transpose_item(P.in[16], 1024, kb * 64, nb * 32, (bf16*)(ws + WS_WOB), 512, nb * 32, 0, scr, F.lane); continue; } r -= I_OB;
        if (r < I_O) { const int kb = r / 32, nb = r % 32; transpose_item(P.in[17], 1024, kb * 64, nb * 32, (bf16*)(ws + WS_WO), 1024, nb * 32, 0, scr, F.lane); continue; } r -= I_O;
        if (r < I_G + I_U) { const int isup = r >= I_G; if (isup) r -= I_G; const int e = r / 128, rr = r % 128, kb = rr / 8, nb = rr % 8, j0 = nb * 32;
            const float* W = (isup ? P.in[24] : P.in[23]) + (size_t)e * 1024 * 256;
            transpose_item(W, 256, kb * 64, j0, (bf16*)(ws + WS_WGU) + (size_t)e * 512 * 1024, 1024, (j0 >> 7) * 256 + isup * 128 + (j0 & 127), 0, scr, F.lane, nullptr, 0, nullptr, 0, P.in[18]); continue; } r -= I_G + I_U;
        { const int e = r / 128, r2 = r % 128, kb = r2 / 32, nb = r2 % 32; const int grp = e >> 2, j = e & 3;
            bf16* dst[3]; int dcol[3]; int nd = 0;
#pragma unroll
            for (int o = 0; o < 4; ++o) if (o != j) { const int a = o < j ? o : j, b = o < j ? j : o; dst[nd] = (bf16*)(ws + WS_WD) + (size_t)(grp * 6 + pair_idx(a, b)) * 1024 * 512; dcol[nd] = (j == a) ? 0 : 256; ++nd; }
            transpose_item(P.in[25] + (size_t)e * 256 * 1024, 1024, kb * 64, nb * 32, dst[0], 512, nb * 32, dcol[0], scr, F.lane, dst[1], dcol[1], dst[2], dcol[2]); }
    }
}

__device__ __forceinline__ void p0_stage_wf(const Frame& Fin_, const Params& P) {
    Frame F = Fin_; LAUNDER(F);
    LAS float* WfT = (LAS float*)F.lds; const float* win = P.in[2];
    for (int k = F.tid; k < DM; k += NTHR) { const float* wr = win + (size_t)k * WIN_LD + 1536; const f32x4 w0 = *(const f32x4*)wr, w1 = *(const f32x4*)(wr + 4);
        WfT[0 * DM + k] = w0.x; WfT[1 * DM + k] = w0.y; WfT[2 * DM + k] = w0.z; WfT[3 * DM + k] = w0.w; WfT[4 * DM + k] = w1.x; WfT[5 * DM + k] = w1.y; WfT[6 * DM + k] = w1.z; WfT[7 * DM + k] = w1.w; }
    __syncthreads();
}
__device__ __forceinline__ void p0_row2(const Frame& F, const Params& P, int m0, int m1, f32x4 (&v)[2][4]) {
    const float* gmix = P.in[1]; const float* bf = P.in[3];
    const LAS f32x4* WfT = (const LAS f32x4*)F.lds;
    float rs[2]; const int mm[2] = {m0, m1};
#pragma unroll
    for (int q = 0; q < 2; ++q) { float ss = 0.f;
#pragma unroll
        for (int j = 0; j < 4; ++j) ss += (v[q][j].x * v[q][j].x + v[q][j].y * v[q][j].y) + (v[q][j].z * v[q][j].z + v[q][j].w * v[q][j].w);
        rs[q] = 1.0f / sqrtf(wave_sum(ss) * (1.0f / DM) + EPS); }
    float f[2][8];
#pragma unroll
    for (int q = 0; q < 2; ++q)
#pragma unroll
        for (int h = 0; h < 8; ++h) f[q][h] = 0.f;
#pragma unroll
    for (int j = 0; j < 4; ++j) { const f32x4 g = ((const f32x4*)gmix)[F.lane + 64 * j];
#pragma unroll
        for (int q = 0; q < 2; ++q) { v[q][j] = v[q][j] * rs[q] * g; u32x2 w; w.x = pk2(v[q][j].x, v[q][j].y); w.y = pk2(v[q][j].z, v[q][j].w);
            ((u32x2*)((bf16*)(P.ws + WS_XN) + (size_t)mm[q] * DM) + F.lane)[64 * j] = w; }
#pragma unroll
        for (int h = 0; h < 8; ++h) { const f32x4 wv = WfT[h * (DM / 4) + 64 * j + F.lane];
#pragma unroll
            for (int q = 0; q < 2; ++q) f[q][h] += (v[q][j].x * wv.x + v[q][j].y * wv.y) + (v[q][j].z * wv.z + v[q][j].w * wv.w); } }
    const bool b5 = (F.lane & 32) != 0, b4 = (F.lane & 16) != 0, b3 = (F.lane & 8) != 0;
#pragma unroll
    for (int q = 0; q < 2; ++q) { float r4[4], r2[2], r1;
#pragma unroll
        for (int i = 0; i < 4; ++i) { const float keep = b5 ? f[q][i + 4] : f[q][i], send = b5 ? f[q][i] : f[q][i + 4]; r4[i] = keep + __shfl_xor(send, 32); }
#pragma unroll
        for (int i = 0; i < 2; ++i) { const float keep = b4 ? r4[i + 2] : r4[i], send = b4 ? r4[i] : r4[i + 2]; r2[i] = keep + __shfl_xor(send, 16); }
        { const float keep = b3 ? r2[1] : r2[0], send = b3 ? r2[0] : r2[1]; r1 = keep + __shfl_xor(send, 8); }
        r1 += __shfl_xor(r1, 4); r1 += __shfl_xor(r1, 2); r1 += __shfl_xor(r1, 1);
        if ((F.lane & 7) == 0) { const int h = (b5 ? 4 : 0) + (b4 ? 2 : 0) + (b3 ? 1 : 0); const float val = r1 + bf[h]; const float xe = __expf(-fabsf(val)); const float ls = fminf(val, 0.f) - (xe < 1e-3f ? xe * (1.0f - 0.5f * xe) : __logf(1.0f + xe));
            const int b = mm[q] / SEQ, s = mm[q] % SEQ; ((float*)(P.ws + WS_LF))[((size_t)b * NH + h) * SEQ + s] = ls * LOG2E; } }
}

__device__ __forceinline__ void p0_ssm_group(const Frame& Fin_, const Params& P, int g, int part) {
    Frame F = Fin_; LAUNDER(F);
    typedef float f32x2 __attribute__((ext_vector_type(2)));
    constexpr int CMS = 65;
    LAS f32x2* AP = (LAS f32x2*)(F.lds);
    LAS f32x2* CM = (LAS f32x2*)(F.lds + 33 * 64 * 8);
    LAS f32x2* BB = (LAS f32x2*)(F.lds + 33 * 64 * 8 + 16 * CMS * 8);
    LAS float* KT = (LAS float*)(F.lds + 33 * 64 * 8 + 16 * CMS * 8 + 8192);
    const float* lre = P.in[6]; const float* lim = P.in[7]; const float* lstep = P.in[8]; const float* bre = P.in[9]; const float* bim = P.in[10];
    const float* cre = P.in[11]; const float* cim = P.in[12]; const float* dsk = P.in[13];
    const float dtf = expf(lstep[g]);
    if (F.tid < 64) { const int p = F.tid; const double dt = (double)dtf, lr = (double)lre[g * 64 + p], li = (double)lim[g * 64 + p];
        const double mg = exp(lr * dt), ph = li * dt; const double a1r = mg * cos(ph), a1i = mg * sin(ph); double ar = 1.0, ai = 0.0;
        for (int d = 0; d <= LCH; ++d) { AP[d * 64 + p] = (f32x2){(float)ar, (float)ai}; const double nr = ar * a1r - ai * a1i, ni = ar * a1i + ai * a1r; ar = nr; ai = ni; } }
    for (int idx = F.tid; idx < 1024; idx += NTHR) { { const int o = idx >> 6, p = idx & 63; CM[o * CMS + p] = (f32x2){cre[(g * 16 + o) * 64 + p], cim[(g * 16 + o) * 64 + p]}; }
        { const int p = idx >> 4, c = idx & 15; const float lr = lre[g * 64 + p], li = lim[g * 64 + p];
          const float mag = expf(lr * dtf); float sn, cs; sincosf(li * dtf, &sn, &cs); const float are = mag * cs, aim = mag * sn, den = lr * lr + li * li, nre = are - 1.0f;
          const float zre = (nre * lr + aim * li) / den, zim = (aim * lr - nre * li) / den; const float br = bre[(g * 64 + p) * 16 + c], bi = bim[(g * 64 + p) * 16 + c];
          BB[idx] = (f32x2){zre * br - zim * bi, zre * bi + zim * br}; } }
    __syncthreads();
    { const int d = F.tid >> 4, o = F.tid & 15; float acc[16];
#pragma unroll
        for (int c = 0; c < 16; ++c) acc[c] = 0.f;
#pragma unroll 4
        for (int p = 0; p < 64; ++p) { const f32x2 a = AP[d * 64 + p], cm = CM[o * CMS + p]; const float car = cm.x * a.x - cm.y * a.y, cai = cm.x * a.y + cm.y * a.x;
#pragma unroll
            for (int c = 0; c < 16; ++c) { const f32x2 bb = BB[p * 16 + c]; acc[c] += car * bb.x - cai * bb.y; } }
        if (d == 0) acc[o] += dsk[g * 16 + o];
#pragma unroll
        for (int c = 0; c < 16; ++c) KT[(d * 16 + o) * 16 + c] = acc[c]; }
    __syncthreads();
    bf16* Mx = (bf16*)(P.ws + WS_MX) + (size_t)g * 512 * KY;
    for (int idx = F.tid; idx < 64 * 80; idx += NTHR) { const int n = part * 64 + idx / 80, k0 = (idx % 80) * 8, j = n >> 4, o = n & 15; float v[8];
        if (k0 < 512) { const int i = k0 >> 4, c0 = k0 & 15;
#pragma unroll
            for (int e = 0; e < 8; ++e) v[e] = (i <= j) ? KT[((j - i) * 16 + o) * 16 + c0 + e] : 0.f; }
        else { const int kk = k0 - 512, ri = kk >> 6, p0 = kk & 63;
#pragma unroll
            for (int e = 0; e < 8; ++e) { const f32x2 a = AP[(j + 1) * 64 + p0 + e], cm = CM[o * CMS + p0 + e]; v[e] = ri == 0 ? (cm.x * a.x - cm.y * a.y) : -(cm.x * a.y + cm.y * a.x); } }
        store8(Mx + (size_t)n * KY + k0, v); }
    bf16* Ws = (bf16*)(P.ws + WS_WS) + (size_t)g * 128 * 512;
    for (int idx = F.tid; idx < 16 * 64; idx += NTHR) { const int n = part * 16 + (idx >> 6), k0 = (idx & 63) * 8, ri = n >> 6, p = n & 63, i = k0 >> 4, c0 = k0 & 15; float v[8]; const f32x2 a = AP[(LCH - 1 - i) * 64 + p];
#pragma unroll
        for (int e = 0; e < 8; ++e) { const f32x2 bb = BB[p * 16 + c0 + e]; v[e] = ri == 0 ? (a.x * bb.x - a.y * bb.y) : (a.x * bb.y + a.y * bb.x); }
        store8(Ws + (size_t)n * 512 + k0, v); }
    if (part == 0 && F.tid < 64) { const f32x2 a = AP[LCH * 64 + F.tid]; float* AL = (float*)(P.ws + WS_AL) + (g * 64 + F.tid) * 2; AL[0] = a.x; AL[1] = a.y; }
    __syncthreads();
}

constexpr unsigned REP_PRO = 0u;
__device__ __forceinline__ void p0_prologue(const Frame& Fin_, const Params& P) {
    Frame F = Fin_; LAUNDER(F);
    for (int r_ = 0; r_ < 1 + (int)(REP_PRO & 1u); ++r_) p0_ssm_group(F, P, F.vcu >> 3, F.vcu & 7);
    for (int r_ = 0; r_ < 1 + (int)((REP_PRO >> 1) & 1u); ++r_) { p0_weights(F, P, 0); __syncthreads(); }
    p0_stage_wf(F, P);
    const int gw = F.vcu * NWAVES + F.wave, NGW = F.G * NWAVES;
    for (int r_ = 0; r_ < 1 + (int)((REP_PRO >> 2) & 1u); ++r_) {
        f32x4 nv[2][4];
#pragma unroll
        for (int q = 0; q < 2; ++q)
#pragma unroll
            for (int j = 0; j < 4; ++j) nv[q][j] = ((const f32x4*)(P.in[0] + (size_t)(gw + q * NGW) * DM) + F.lane)[64 * j];
        for (int m = gw; m < T; m += 2 * NGW) { f32x4 v[2][4];
#pragma unroll
            for (int q = 0; q < 2; ++q)
#pragma unroll
                for (int j = 0; j < 4; ++j) v[q][j] = nv[q][j];
            if (m + 2 * NGW < T) {
#pragma unroll
                for (int q = 0; q < 2; ++q)
#pragma unroll
                    for (int j = 0; j < 4; ++j) nv[q][j] = ((const f32x4*)(P.in[0] + (size_t)(m + (2 + q) * NGW) * DM) + F.lane)[64 * j]; }
            p0_row2(F, P, m, m + NGW, v); } }
}

__device__ __forceinline__ void p_cumsum(const Frame& Fin_, const Params& P) {
    Frame F = Fin_; LAUNDER(F);
    LAS float* part = (LAS float*)F.lds;
    for (int seq = (int)blockIdx.x - 128; seq < BATCH * NH; seq += 32) {
        const float* src = (const float*)(P.ws + WS_LF) + (size_t)seq * SEQ + F.tid * 16; float* dst = (float*)(P.ws + WS_CK2) + (size_t)seq * SEQ + F.tid * 16;
        float v[16]; float s = 0.f;
#pragma unroll
        for (int j = 0; j < 4; ++j) { const f32x4 t = ((const f32x4*)src)[j]; v[4 * j] = t.x; v[4 * j + 1] = t.y; v[4 * j + 2] = t.z; v[4 * j + 3] = t.w; }
#pragma unroll
        for (int j = 0; j < 16; ++j) { s += v[j]; v[j] = s; }
        __syncthreads();
        part[F.tid] = s; __syncthreads();
        if (F.tid == 0) { float run = 0.f; for (int i = 0; i < NTHR; ++i) { const float t = part[i]; part[i] = run; run += t; } }
        __syncthreads();
        const float base = part[F.tid];
#pragma unroll
        for (int j = 0; j < 4; ++j) ((f32x4*)dst)[j] = (f32x4){v[4 * j] + base, v[4 * j + 1] + base, v[4 * j + 2] + base, v[4 * j + 3] + base};
    }
}

constexpr int CARRY_WGS = BATCH * SG;
__device__ __forceinline__ void p_carry(const Frame& Fin_, const Params& P) {
    Frame F = Fin_; LAUNDER(F);
    const int cb = (int)blockIdx.x; if (cb >= CARRY_WGS) return;
    typedef float f32x2 __attribute__((ext_vector_type(2)));
    const int b = cb & 3, g = cb >> 2, p = F.lane, seg = F.wave;
    const float* AL = (const float*)(P.ws + WS_AL) + (g * 64 + p) * 2; const float ar = AL[0], ai = AL[1];
    const float* S = (const float*)(P.ws + WS_S) + ((size_t)g * NCH + b * NCHB + seg * 32) * 128 + p;
    bf16* UH = (bf16*)(P.ws + WS_UH) + ((size_t)g * NCH + b * NCHB + seg * 32) * KY + 512 + p;
    float sr[32], si[32];
#pragma unroll
    for (int n = 0; n < 32; ++n) { sr[n] = S[(size_t)n * 128]; si[n] = S[(size_t)n * 128 + 64]; }
    float a32r = ar, a32i = ai;
#pragma unroll
    for (int k = 0; k < 5; ++k) { const float nr = a32r * a32r - a32i * a32i, ni = 2.0f * a32r * a32i; a32r = nr; a32i = ni; }
    float er = 0.f, ei = 0.f;
#pragma unroll
    for (int n = 0; n < 32; ++n) { const float nr = ar * er - ai * ei + sr[n], ni = ar * ei + ai * er + si[n]; er = nr; ei = ni; }
    LAS f32x2* EX = (LAS f32x2*)F.lds;
    EX[seg * 64 + p] = (f32x2){er, ei};
    __syncthreads();
    float hr = 0.f, hi = 0.f;
    for (int s = 0; s < seg; ++s) { const f32x2 e = EX[s * 64 + p]; const float nr = a32r * hr - a32i * hi + e.x, ni = a32r * hi + a32i * hr + e.y; hr = nr; hi = ni; }
#pragma unroll
    for (int n = 0; n < 32; ++n) { UH[(size_t)n * KY] = (bf16)f2bf(hr); UH[(size_t)n * KY + 64] = (bf16)f2bf(hi);
        const float nr = ar * hr - ai * hi + sr[n], ni = ar * hi + ai * hr + si[n]; hr = nr; hi = ni; }
    __syncthreads();
}

__device__ __forceinline__ void p_router(const Frame& Fin_, const Params& P, const bool publish = true) {
    Frame F = Fin_; LAUNDER(F);
    const float* brg = P.in[20]; const float* bre_ = P.in[22];
    LAS f32x4* LOG = (LAS f32x4*)F.lds;
    LAS int* hist = (LAS int*)(F.lds + 4 * 128 * 96);
    LAS int* tcl = hist + 64;
    LAS int* tlr = tcl + 128;
    LAS float* twa = (LAS float*)(tlr + 128);
    if (F.tid < NCLS) hist[F.tid] = 0;
    const int tok0 = F.vcu * (T / 256);
    { const int t = F.tid & 127, qt = F.tid >> 7;
      const f32x4* pp = (const f32x4*)(P.ws + WS_PART) + ((size_t)(qt * 4 * 6) * T + tok0 + t);
      f32x4 v[4][6];
#pragma unroll
      for (int q = 0; q < 4; ++q)
#pragma unroll
          for (int j = 0; j < 6; ++j) v[q][j] = pp[(size_t)(q * 6 + j) * T];
#pragma unroll
      for (int j = 0; j < 6; ++j) LOG[(qt * 128 + t) * 6 + j] = (v[0][j] + v[1][j]) + (v[2][j] + v[3][j]); }
    __syncthreads();
    if (F.tid < T / 256) { const int t = F.tid;
        float lgt[24];
#pragma unroll
        for (int j = 0; j < 6; ++j) { const f32x4 a = (LOG[t * 6 + j] + LOG[(128 + t) * 6 + j]) + (LOG[(256 + t) * 6 + j] + LOG[(384 + t) * 6 + j]); lgt[4 * j] = a.x; lgt[4 * j + 1] = a.y; lgt[4 * j + 2] = a.z; lgt[4 * j + 3] = a.w; }
        const float rs = 1.0f / sqrtf(lgt[20] * (1.0f / DM) + EPS);
#pragma unroll
        for (int e = 0; e < 20; ++e) lgt[e] *= rs;
        const float l0 = lgt[0] + brg[0], l1 = lgt[1] + brg[1], l2 = lgt[2] + brg[2], l3 = lgt[3] + brg[3];
        int gi = 0; float mx = l0; if (l1 > mx) { mx = l1; gi = 1; } if (l2 > mx) { mx = l2; gi = 2; } if (l3 > mx) { mx = l3; gi = 3; }
        const float psel = 1.0f / (expf(l0 - mx) + expf(l1 - mx) + expf(l2 - mx) + expf(l3 - mx));
        float le[4];
#pragma unroll
        for (int k = 0; k < 4; ++k) { const float c0 = lgt[4 + k] + bre_[k], c1 = lgt[8 + k] + bre_[4 + k], c2 = lgt[12 + k] + bre_[8 + k], c3 = lgt[16 + k] + bre_[12 + k]; le[k] = gi == 0 ? c0 : (gi == 1 ? c1 : (gi == 2 ? c2 : c3)); }
        int i0 = 0; float v0 = le[0]; if (le[1] > v0) { v0 = le[1]; i0 = 1; } if (le[2] > v0) { v0 = le[2]; i0 = 2; } if (le[3] > v0) { v0 = le[3]; i0 = 3; }
        int i1 = -1; float v1 = -INFINITY;
#pragma unroll
        for (int k = 0; k < 4; ++k) if (k != i0 && le[k] > v1) { v1 = le[k]; i1 = k; }
        const float e1 = expf(v1 - v0), w0 = psel / (1.0f + e1), w1 = psel * e1 / (1.0f + e1);
        const int a = i0 < i1 ? i0 : i1, bb = i0 < i1 ? i1 : i0; const float wa = i0 < i1 ? w0 : w1, wb = i0 < i1 ? w1 : w0;
        const int cls = gi * 6 + pair_idx(a, bb);
        tcl[t] = cls; twa[4 * t] = wa; twa[4 * t + 1] = wb; twa[4 * t + 2] = rs; tlr[t] = atomicAdd((int*)&hist[cls], 1); }
    __syncthreads();
    if (!publish) return;
    if (F.tid < NCLS) hist[32 + F.tid] = (int)__hip_atomic_fetch_add((unsigned*)(P.ws + WS_CTL) + CW_GCNT + F.tid, (unsigned)hist[F.tid], __ATOMIC_RELAXED, __HIP_MEMORY_SCOPE_AGENT);
    __syncthreads();
    if (F.tid < T / 256) { const int cls = tcl[F.tid], pos = hist[32 + cls] + tlr[F.tid]; const size_t li = (size_t)cls * T + pos;
        ((int*)(P.ws + WS_LIST))[li] = tok0 + F.tid; ((int*)(P.ws + WS_TPOS))[tok0 + F.tid] = (cls << 16) | pos; *((f32x4*)(P.ws + WS_LPW) + li) = (f32x4){twa[4 * F.tid], twa[4 * F.tid + 1], twa[4 * F.tid + 2], 0.f}; }
    __syncthreads();
}

__device__ __forceinline__ void stage_router_table(const Frame& Fin_, const Params& P, const int pn) {
    Frame F = Fin_; LAUNDER(F);
    const float* gffn = P.in[18]; const float* wrg = P.in[19]; const float* wre = P.in[21];
    LAS unsigned char* TH = F.lds + RT_OFF; LAS unsigned char* TL = TH + 20 * RT_ROWB;
    for (int idx = F.tid; idx < 20 * 256; idx += NTHR) { const int n = idx >> 8, kc = idx & 255, k = pn * 256 + kc; const float w = (n < 4 ? wrg[(size_t)k * 4 + n] : wre[(size_t)k * 16 + (n - 4)]) * gffn[k];
        const unsigned h = f2bf(w); const unsigned l = f2bf(w - bf2f(h)); *(LAS bf16*)(TH + n * RT_ROWB + kc * 2) = (bf16)h; *(LAS bf16*)(TL + n * RT_ROWB + kc * 2) = (bf16)l; }
    __syncthreads();
}

__device__ __forceinline__ void moe_tile_table(const Frame& Fin_, const Params& P) {
    Frame F = Fin_; LAUNDER(F);
    LAS int* tt = (LAS int*)(F.lds + TT_OFF);
    if (F.tid < NCLS) tt[512 + F.tid] = (int)__hip_atomic_load((unsigned*)(P.ws + WS_CTL) + CW_GCNT + F.tid, __ATOMIC_RELAXED, __HIP_MEMORY_SCOPE_AGENT);
    __syncthreads();
    if (F.tid < MAXTILES) { int base = 0, cls = -1, tic = 0;
        for (int c = 0; c < NCLS; ++c) { const int nt = (tt[512 + c] + 255) >> 8; if (F.tid == 0) tt[544 + c] = base; if (cls < 0 && F.tid < base + nt) { cls = c; tic = F.tid - base; } base += nt; }
        if (F.tid == 0) tt[568] = base;
        tt[2 * F.tid] = cls; tt[2 * F.tid + 1] = tic; }
    __syncthreads();
}


__device__ __forceinline__ void p_final(const Frame& Fin_, const Params& P) {
    Frame F = Fin_; LAUNDER(F);
    const float* gf = P.in[26]; const bf16* Y = (const bf16*)(P.ws + WS_Y); const bf16* X1B = (const bf16*)(P.ws + WS_H2); const int* TPOS = (const int*)(P.ws + WS_TPOS); const LAS int* tt = (const LAS int*)(F.lds + TT_OFF);
    const int gw = F.vcu * NWAVES + F.wave, NGW = F.G * NWAVES;
    u32x2 nx[4], ny[4]; int tp1 = TPOS[gw], tp2 = (gw + NGW < T) ? TPOS[gw + NGW] : 0;
    { const size_t yr = (size_t)tt[544 + (tp1 >> 16)] * 256 + (tp1 & 0xffff);
#pragma unroll
      for (int j = 0; j < 4; ++j) { nx[j] = ((const u32x2*)(X1B + (size_t)gw * DM) + F.lane)[64 * j]; ny[j] = ((const u32x2*)(Y + yr * DM) + F.lane)[64 * j]; } }
    for (int m = gw; m < T; m += NGW) { f32x4* xr = (f32x4*)(P.out + (size_t)m * DM) + F.lane; f32x4 v[4]; float ss = 0.f;
#pragma unroll
        for (int j = 0; j < 4; ++j) { const u32x2 x = nx[j], y = ny[j]; v[j] = (f32x4){bf2f(x.x & 0xffffu), bf2f(x.x >> 16), bf2f(x.y & 0xffffu), bf2f(x.y >> 16)} + (f32x4){bf2f(y.x & 0xffffu), bf2f(y.x >> 16), bf2f(y.y & 0xffffu), bf2f(y.y >> 16)};
            ss += (v[j].x * v[j].x + v[j].y * v[j].y) + (v[j].z * v[j].z + v[j].w * v[j].w); }
        tp1 = tp2; if (m + 2 * NGW < T) tp2 = TPOS[m + 2 * NGW];
        if (m + NGW < T) { const size_t yr = (size_t)tt[544 + (tp1 >> 16)] * 256 + (tp1 & 0xffff);
#pragma unroll
            for (int j = 0; j < 4; ++j) { nx[j] = ((const u32x2*)(X1B + (size_t)(m + NGW) * DM) + F.lane)[64 * j]; ny[j] = ((const u32x2*)(Y + yr * DM) + F.lane)[64 * j]; } }
        const float rs = 1.0f / sqrtf(wave_sum(ss) * (1.0f / DM) + EPS);
#pragma unroll
        for (int j = 0; j < 4; ++j) { const f32x4 g = ((const f32x4*)gf)[F.lane + 64 * j]; xr[64 * j] = v[j] * rs * g; } }
}

namespace fox {
using bf16x8=__attribute__((ext_vector_type(8)))short;
using s16x4=__attribute__((ext_vector_type(4)))short;
using f32x16=__attribute__((ext_vector_type(16)))float;
using u32x4_=__attribute__((ext_vector_type(4)))unsigned;
using f32x4_=__attribute__((ext_vector_type(4)))float;
constexpr int D=64,DMP=512;
constexpr int NW=8,QBLK=32,QB=QBLK*NW,KVBLK=64;
__device__ __forceinline__ int crow(int r,int hi){return (r&3)+8*(r>>2)+4*hi;}
#define SBAR() __builtin_amdgcn_sched_barrier(0)
__device__ __forceinline__ void cmask(f32x16&p0,f32x16&p1,int jb,int qrel,int hi){
  const float NEG=-INFINITY; int d=qrel-64*jb-4*hi; asm volatile("":"+v"(d));
  #pragma unroll
  for(int r=0;r<16;++r){const int c=(r&3)+8*(r>>2); if(c>d)p0[r]=NEG; if(c+32>d)p1[r]=NEG;}
}
constexpr int NSLOT=3, SLOTB=8192;
constexpr int LDS_K=0, LDS_V=NSLOT*SLOTB, LDS_WS=2*NSLOT*SLOTB, LDS_OST=LDS_WS+NW*64*4, LDS_CK=LDS_OST+NW*4096, LDS_BYTES=LDS_CK+32768;
constexpr float PRUNE_X=40.0f;
__device__ __forceinline__ void glds16(const void*sbase,unsigned voff,unsigned lds_dst){unsigned keep;
  asm volatile("s_mov_b32 %0, m0\n\ts_mov_b32 m0, %3\n\ts_nop 0\n\tglobal_load_lds_dwordx4 %1, %2\n\ts_mov_b32 m0, %0":"=&s"(keep):"v"(voff),"s"(sbase),"s"(lds_dst):"memory");}
__device__ __forceinline__ float max3f(float a,float b,float c){float r;asm("v_max3_f32 %0, %1, %2, %3":"=v"(r):"v"(a),"v"(b),"v"(c));return r;}
__device__ __forceinline__ float max2f(float a,float b){float r;asm("v_max_f32_e32 %0, %1, %2":"=v"(r):"v"(a),"v"(b));return r;}
__device__ __forceinline__ float fadd_s(float a,float b){float r;asm("v_add_f32_e32 %0, %1, %2":"=v"(r):"v"(a),"v"(b));return r;}
__device__ __forceinline__ float fsub_s(float a,float b){float r;asm("v_sub_f32_e32 %0, %1, %2":"=v"(r):"v"(a),"v"(b));return r;}
typedef float f32x2_t __attribute__((ext_vector_type(2))); typedef __bf16 bf16x2_t __attribute__((ext_vector_type(2)));
__device__ __forceinline__ unsigned cvtpk_s(float lo,float hi){f32x2_t v={lo,hi};bf16x2_t b=__builtin_convertvector(v,bf16x2_t);return __builtin_bit_cast(unsigned,b);}
#define WAIT_BAR(N) asm volatile("s_waitcnt vmcnt(" #N ") lgkmcnt(0)\n\ts_barrier":::"memory")
typedef __attribute__((address_space(3))) const char* lds_cptr;
typedef short v4i16_t __attribute__((ext_vector_type(4)));
__device__ __forceinline__ void cinit(f32x16&p0,f32x16&p1,lds_cptr ckp,float nb){
  #pragma unroll
  for(int g=0;g<4;++g){ const f32x4_ a=*(const __attribute__((address_space(3))) f32x4_*)(ckp+g*32); const f32x4_ c=*(const __attribute__((address_space(3))) f32x4_*)(ckp+128+g*32);
    #pragma unroll
    for(int e=0;e<4;++e){p0[4*g+e]=nb-a[e];p1[4*g+e]=nb-c[e];} }
}
__device__ __forceinline__ void qkt(f32x16&p0,f32x16&p1,const char*Kslot,const bf16x8*qr,int r32,int hi){
  const char*kb=Kslot+hi*1024+r32*16;
  #pragma unroll
  for(int d0=0;d0<4;++d0){
    const bf16x8 b0=*reinterpret_cast<const bf16x8*>(kb+d0*2048);
    const bf16x8 b1=*reinterpret_cast<const bf16x8*>(kb+d0*2048+512);
    p0=__builtin_amdgcn_mfma_f32_32x32x16_bf16(b0,qr[d0],p0,0,0,0);p1=__builtin_amdgcn_mfma_f32_32x32x16_bf16(b1,qr[d0],p1,0,0,0);}
}
__device__ __forceinline__ void kload8(bf16x8*kf,lds_cptr kp){
  kf[0]=*(const __attribute__((address_space(3))) bf16x8*)(kp);      kf[1]=*(const __attribute__((address_space(3))) bf16x8*)(kp+512);
  kf[2]=*(const __attribute__((address_space(3))) bf16x8*)(kp+2048); kf[3]=*(const __attribute__((address_space(3))) bf16x8*)(kp+2560);
  kf[4]=*(const __attribute__((address_space(3))) bf16x8*)(kp+4096); kf[5]=*(const __attribute__((address_space(3))) bf16x8*)(kp+4608);
  kf[6]=*(const __attribute__((address_space(3))) bf16x8*)(kp+6144); kf[7]=*(const __attribute__((address_space(3))) bf16x8*)(kp+6656);
}
__device__ __forceinline__ void kload2(bf16x8*kf,lds_cptr kp,int j){ kf[2*j]=*(const __attribute__((address_space(3))) bf16x8*)(kp+j*2048); kf[2*j+1]=*(const __attribute__((address_space(3))) bf16x8*)(kp+j*2048+512); }
__device__ __forceinline__ s16x4 vtr(lds_cptr p){ return __builtin_bit_cast(s16x4,__builtin_amdgcn_ds_read_tr16_b64_v4i16((__attribute__((address_space(3))) v4i16_t*)p)); }
__device__ __forceinline__ float rowmax(const f32x16&p0,const f32x16&p1){
  float a=max3f(p0[0],p0[1],p1[0]),b=max3f(p0[2],p0[3],p1[1]);a=max3f(a,p1[2],p1[3]);
  #pragma unroll
  for(int r=4;r<16;r+=4){a=max3f(a,p0[r],p0[r+1]);b=max3f(b,p0[r+2],p0[r+3]);a=max3f(a,p1[r],p1[r+1]);b=max3f(b,p1[r+2],p1[r+3]);}
  const float m=max2f(a,b);
  auto rr=__builtin_amdgcn_permlane32_swap(__float_as_uint(m),__float_as_uint(m),false,false);
  return max2f(__uint_as_float(rr[0]),__uint_as_float(rr[1]));
}
__device__ __forceinline__ void pv(f32x16*o,int vb,bf16x8 pa0,bf16x8 pa1,bf16x8 pa2,bf16x8 pa3){
  #pragma unroll
  for(int d0=0;d0<2;++d0){s16x4 lo[4],hi[4];
    #pragma unroll
    for(int ks=0;ks<4;++ks){
      asm volatile("ds_read_b64_tr_b16 %0,%1 offset:%c2":"=&v"(lo[ks]):"v"(vb),"i"(d0*4096+ks*1024):"memory");
      asm volatile("ds_read_b64_tr_b16 %0,%1 offset:%c2":"=&v"(hi[ks]):"v"(vb),"i"(d0*4096+ks*1024+512):"memory");}
    asm volatile("s_waitcnt lgkmcnt(0)":::"memory");SBAR();
    #define PK(k) (bf16x8){lo[k][0],lo[k][1],lo[k][2],lo[k][3],hi[k][0],hi[k][1],hi[k][2],hi[k][3]}
    o[d0]=__builtin_amdgcn_mfma_f32_32x32x16_bf16(pa0,PK(0),o[d0],0,0,0);
    o[d0]=__builtin_amdgcn_mfma_f32_32x32x16_bf16(pa1,PK(1),o[d0],0,0,0);
    o[d0]=__builtin_amdgcn_mfma_f32_32x32x16_bf16(pa2,PK(2),o[d0],0,0,0);
    o[d0]=__builtin_amdgcn_mfma_f32_32x32x16_bf16(pa3,PK(3),o[d0],0,0,0);
    #undef PK
  }
}
struct Tensors { const bf16* Q; const bf16* K; const bf16* V; bf16* O; const float* CK2; const float* QN; const float* KN; };

template<int THRL> __device__ __forceinline__ void attn_unit(int b,int h,int qb,const Tensors&TT,char*shm){
  const bf16*Q=TT.Q; const bf16*__restrict__ K=TT.K; const bf16*__restrict__ V=TT.V; bf16*O=TT.O;
  int tid=threadIdx.x; asm volatile("":"+v"(tid));
  const int lane=tid&63,r32=lane&31,hi=lane>>5; const int wid=__builtin_amdgcn_readfirstlane(tid>>6);
  const long rowbase=(long)b*SEQ; const int q0=qb*QB; const int bh=b*NH+h;
  const float*ck=TT.CK2+(size_t)bh*SEQ;
  const int NTF=(q0+QB)/KVBLK;
  const bf16*Qw=Q+(rowbase+q0+wid*QBLK)*DMP+h*D;
  const bf16*Kh=K+rowbase*DMP+h*D,*Vh=V+rowbase*DMP+h*D;
  const unsigned lds0=(unsigned)(uintptr_t)shm;
  const unsigned koff=(unsigned)(lane*DMP+wid*8)*2u;
  const unsigned voff=(unsigned)((16*(wid&3)+(lane>>2))*DMP+(wid>>2)*32+(lane&3)*8)*2u;
  const unsigned kdst=lds0+LDS_K+wid*1024, vdst=lds0+LDS_V+wid*1024;
  #define TJ(t) (NTF-1-(t))
  #define DMA_K(t,slot) glds16(Kh+(long)TJ(t)*KVBLK*DMP,koff,(unsigned)__builtin_amdgcn_readfirstlane(kdst+(slot)))
  #define DMA_V(t,slot) glds16(Vh+(long)TJ(t)*KVBLK*DMP,voff,(unsigned)__builtin_amdgcn_readfirstlane(vdst+(slot)))
  DMA_K(0,0);DMA_V(0,0);DMA_K(1,SLOTB);DMA_K(2,2*SLOTB);
  float Bq; int jmin;
  { float qn=(lane<4)?TT.QN[bh*128+4*qb+lane]:0.f; float kn=0.f; if(lane<NTF)kn=TT.KN[bh*128+lane]; if(lane+64<NTF)kn=fmaxf(kn,TT.KN[bh*128+64+lane]);
    const float cq0=ck[q0]; const float c0=(lane<NTF)?ck[64*lane+63]:0.f, c1=(lane+64<NTF)?ck[64*(lane+64)+63]:0.f;
    #pragma unroll
    for(int o_=1;o_<64;o_<<=1){qn=fmaxf(qn,__shfl_xor(qn,o_));kn=fmaxf(kn,__shfl_xor(kn,o_));}
    Bq=sqrtf(qn*kn)*1.001f+1e-3f;
    const float lim=2.0f*Bq+PRUNE_X;
    const bool n0=(lane>=NTF)||((c0-cq0)<=lim), n1=(lane+64>=NTF)||((c1-cq0)<=lim);
    const unsigned long long m0=__ballot(n0), m1=__ballot(n1);
    jmin=m0?(int)__builtin_ctzll(m0):(64+(m1?(int)__builtin_ctzll(m1):63));
    jmin=__builtin_amdgcn_readfirstlane(jmin)&~1; if(jmin>NTF-4)jmin=NTF-4; }
  const int NT=NTF-jmin;
  float*wsf=(float*)(shm+LDS_WS)+wid*64;
  const int vb0=(int)(lds0+LDS_V)+((lane>>4)&1)*32+(lane&3)*8+(4*hi+((lane&15)>>2))*64;
  const char*Kbase=shm+LDS_K; bf16x8 kf[8];
  const lds_cptr shm3=(lds_cptr)shm; const lds_cptr kp0=shm3+LDS_K+hi*1024+r32*16; const lds_cptr vp0=shm3+LDS_V+((lane>>4)&1)*32+(lane&3)*8+(4*hi+((lane&15)>>2))*64;
  const lds_cptr ckp0=shm3+LDS_CK+hi*16;
  #define CKP(t) (ckp0+(t)*256)
  bf16x8 qr[4];
  #pragma unroll
  for(int d0=0;d0<4;++d0)qr[d0]=*reinterpret_cast<const bf16x8*>(&Qw[(long)r32*DMP+d0*16+hi*8]);
  const float cq=ck[q0+wid*QBLK+r32];
  { const int n4=NT*16; const f32x4_*src=(const f32x4_*)ck; __attribute__((address_space(3))) f32x4_*dst=(__attribute__((address_space(3))) f32x4_*)(shm3+LDS_CK);
    for(int i=tid;i<n4;i+=NW*64)dst[i]=src[(NTF-1-(i>>4))*16+(i&15)]; }
  float mhat=0.f,l_reg=0.f;f32x16 o[2];o[0]=f32x16{};o[1]=f32x16{};
  const int qrel=wid*QBLK+r32;
  #define CMASK(P0,P1,t) do{int jb_=3-(t); if(jb_>=0)cmask(P0,P1,jb_,qrel,hi);}while(0)
  bool resc=false;
  #define START(P0,P1) do{ const float rm=fmaxf(rowmax(P0,P1),-Bq); resc=false; \
    { const float dl=rm; mhat=fadd_s(mhat,dl); \
      _Pragma("unroll") for(int r=0;r<16;++r){P0[r]=fsub_s(P0[r],dl);P1[r]=fsub_s(P1[r],dl);} } \
    _Pragma("unroll") for(int r=0;r<16;++r)P0[r]=__builtin_amdgcn_exp2f(P0[r]); }while(0)
  #define RESC() do{ if(resc){ asm volatile("s_waitcnt lgkmcnt(0)":::"memory"); \
      _Pragma("unroll") for(int d_=0;d_<2;++d_) _Pragma("unroll") for(int r=0;r<16;++r)o[d_][r]*=wsf[crow(r,hi)]; } }while(0)
  f32x16 pA0,pA1,pB0,pB1;
  int sl_prev=0,sl_cur=0,sl_next=SLOTB;
  #define ROT() do{sl_prev=sl_cur;sl_cur=sl_next;sl_next=(sl_next==(NSLOT-1)*SLOTB)?0:sl_next+SLOTB;}while(0)
  WAIT_BAR(0);
  asm volatile("":::"memory");
  cinit(pA0,pA1,CKP(0),cq);
  qkt(pA0,pA1,Kbase,qr,r32,hi);asm volatile("s_nop 15\n\ts_nop 7":"+v"(pA0),"+v"(pA1));CMASK(pA0,pA1,0);
  START(pA0,pA1);
  _Pragma("unroll") for(int r=0;r<16;++r)pA1[r]=__builtin_amdgcn_exp2f(pA1[r]);
  WAIT_BAR(0);
  DMA_K(3,0);DMA_V(1,SLOTB);
  ROT();
  kload8(kf,kp0+sl_cur);
  WAIT_BAR(2);
  s16x4 vlo[8],vhi[8]; u32x4_ pw0,pw1,pw2,pw3;
  #define PKW(P,B) cvtpk_s(P[B],P[B+1])
  #define PAF(k) __builtin_bit_cast(bf16x8,pw##k)
  #define VFR(i) (bf16x8){vlo[i][0],vlo[i][1],vlo[i][2],vlo[i][3],vhi[i][0],vhi[i][1],vhi[i][2],vhi[i][3]}
  #define PIN(x) asm volatile("":"+v"(x))
  #define MX3(a,b,c) __builtin_fmaxf(__builtin_fmaxf((a),(b)),(c))
  #define GAPA(MF,A0,A1,A2,A3,W0,W1,PW) do{ MF; sacc+=A0; sacc+=A1; sacc+=A2; sacc+=A3; PIN(sacc); W0; W1; PIN(PW); SBAR(); }while(0)
  #define EX(v) __builtin_amdgcn_exp2f(v)
  #define GAPB(MF,X,B) do{ MF; X[B]=EX(X[B]); X[B+1]=EX(X[B+1]); X[B+2]=EX(X[B+2]); X[B+3]=EX(X[B+3]); PIN(X); SBAR(); }while(0)
  #define VRD(i) do{ vlo[i]=vtr(vp_+(((i)>>2)*4096+((i)&3)*1024)); vhi[i]=vtr(vp_+(((i)>>2)*4096+((i)&3)*1024+512)); }while(0)
  #define KRD(G,j) do{ if(G){ kload2(kf,kp0+sl_next,j); SBAR(); } }while(0)
  #define STEP(C0,C1,P0,P1,t,GK,GV,GL) do{ SBAR(); \
    const lds_cptr vp_=vp0+sl_prev; \
    cinit(C0,C1,CKP(t),cq-mhat); SBAR(); \
    VRD(0); SBAR(); float sacc=(P0[0]+P0[1]); \
    GAPA(C0=__builtin_amdgcn_mfma_f32_32x32x16_bf16(kf[0],qr[0],C0,0,0,0), P0[2],P0[3],P0[4],P0[5],     pw0[0]=PKW(P0,0), pw0[1]=PKW(P0,2), pw0); \
    VRD(4); SBAR(); GAPA(C1=__builtin_amdgcn_mfma_f32_32x32x16_bf16(kf[1],qr[0],C1,0,0,0), P0[6],P0[7],P0[8],P0[9],     pw0[2]=PKW(P0,4), pw0[3]=PKW(P0,6), pw0); \
    VRD(1); SBAR(); GAPA(C0=__builtin_amdgcn_mfma_f32_32x32x16_bf16(kf[2],qr[1],C0,0,0,0),   P0[10],P0[11],P0[12],P0[13], pw1[0]=PKW(P0,8), pw1[1]=PKW(P0,10), pw1); \
    VRD(5); SBAR(); GAPA(C1=__builtin_amdgcn_mfma_f32_32x32x16_bf16(kf[3],qr[1],C1,0,0,0),   P0[14],P0[15],P1[0],P1[1],   pw1[2]=PKW(P0,12),pw1[3]=PKW(P0,14), pw1); \
    VRD(2); SBAR(); GAPA(C0=__builtin_amdgcn_mfma_f32_32x32x16_bf16(kf[4],qr[2],C0,0,0,0),   P1[2],P1[3],P1[4],P1[5],     pw2[0]=PKW(P1,0), pw2[1]=PKW(P1,2), pw2); \
    VRD(6); SBAR(); GAPA(C1=__builtin_amdgcn_mfma_f32_32x32x16_bf16(kf[5],qr[2],C1,0,0,0),   P1[6],P1[7],P1[8],P1[9],     pw2[2]=PKW(P1,4), pw2[3]=PKW(P1,6), pw2); \
    VRD(3); SBAR(); GAPA(C0=__builtin_amdgcn_mfma_f32_32x32x16_bf16(kf[6],qr[3],C0,0,0,0),   P1[10],P1[11],P1[12],P1[13], pw3[0]=PKW(P1,8), pw3[1]=PKW(P1,10), pw3); \
    VRD(7); SBAR(); GAPA(C1=__builtin_amdgcn_mfma_f32_32x32x16_bf16(kf[7],qr[3],C1,0,0,0),   P1[14],P1[15],0.f,0.f,       pw3[2]=PKW(P1,12),pw3[3]=PKW(P1,14), pw3); \
    l_reg+=sacc; \
    if(GK){DMA_K((t)+3,sl_cur);} if(GV){DMA_V((t)+1,sl_next);} \
    CMASK(C0,C1,t); \
    { float a=MX3(C0[0],C0[1],C1[0]),b=MX3(C0[2],C0[3],C1[1]); a=MX3(a,C1[2],C1[3]); \
      _Pragma("unroll") for(int r=4;r<16;r+=4){a=MX3(a,C0[r],C0[r+1]);b=MX3(b,C0[r+2],C0[r+3]);a=MX3(a,C1[r],C1[r+1]);b=MX3(b,C1[r+2],C1[r+3]);} \
      float rm=__builtin_fmaxf(a,b); { auto rr=__builtin_amdgcn_permlane32_swap(__float_as_uint(rm),__float_as_uint(rm),false,false); rm=__builtin_fmaxf(__uint_as_float(rr[0]),__uint_as_float(rr[1])); } \
      resc=false; \
      if(__builtin_expect(__any(rm>(float)THRL),0)){ const float dl=__builtin_fmaxf(rm,0.f); mhat+=dl; \
        _Pragma("unroll") for(int r=0;r<16;++r){C0[r]-=dl;C1[r]-=dl;} \
        const float f=__builtin_amdgcn_exp2f(-dl); l_reg*=f; if(hi==0)wsf[r32]=f; resc=true; } } \
    SBAR(); \
    GAPB(o[0]=__builtin_amdgcn_mfma_f32_32x32x16_bf16(PAF(0),VFR(0),o[0],0,0,0), C0,0); \
    GAPB(o[1]=__builtin_amdgcn_mfma_f32_32x32x16_bf16(PAF(0),VFR(4),o[1],0,0,0), C0,4); \
    KRD(GL,0); GAPB(o[0]=__builtin_amdgcn_mfma_f32_32x32x16_bf16(PAF(1),VFR(1),o[0],0,0,0), C0,8); \
    KRD(GL,1); GAPB(o[1]=__builtin_amdgcn_mfma_f32_32x32x16_bf16(PAF(1),VFR(5),o[1],0,0,0), C0,12); \
    KRD(GL,2); GAPB(o[0]=__builtin_amdgcn_mfma_f32_32x32x16_bf16(PAF(2),VFR(2),o[0],0,0,0), C1,0); \
    KRD(GL,3); GAPB(o[1]=__builtin_amdgcn_mfma_f32_32x32x16_bf16(PAF(2),VFR(6),o[1],0,0,0), C1,4); \
    GAPB(o[0]=__builtin_amdgcn_mfma_f32_32x32x16_bf16(PAF(3),VFR(3),o[0],0,0,0), C1,8); \
    GAPB(o[1]=__builtin_amdgcn_mfma_f32_32x32x16_bf16(PAF(3),VFR(7),o[1],0,0,0), C1,12); \
    }while(0)
  #define ENDW(tt) do{ if((tt)+3<NT){WAIT_BAR(2);} else if((tt)+2<NT){WAIT_BAR(1);} else {WAIT_BAR(0);} }while(0)
  int t=1;
  for(;t+1<NT&&t<5;t+=2){
    STEP(pB0,pB1,pA0,pA1,t,(t+3<NT),(t+1<NT),(t+1<NT));       ENDW(t);   RESC(); ROT();
    STEP(pA0,pA1,pB0,pB1,t+1,(t+4<NT),(t+2<NT),(t+2<NT));     ENDW(t+1); RESC(); ROT();
  }
  #undef CMASK
  #define CMASK(P0,P1,t) do{}while(0)
  for(;t+5<NT;t+=2){
    STEP(pB0,pB1,pA0,pA1,t,true,true,true);     WAIT_BAR(2); RESC(); ROT();
    STEP(pA0,pA1,pB0,pB1,t+1,true,true,true);   WAIT_BAR(2); RESC(); ROT();
  }
  for(;t+1<NT;t+=2){
    STEP(pB0,pB1,pA0,pA1,t,(t+3<NT),(t+1<NT),(t+1<NT));       ENDW(t);   RESC(); ROT();
    STEP(pA0,pA1,pB0,pB1,t+1,(t+4<NT),(t+2<NT),(t+2<NT));     ENDW(t+1); RESC(); ROT();
  }
  #undef CMASK
  #define CMASK(P0,P1,t) do{int jb_=3-(t); if(jb_>=0)cmask(P0,P1,jb_,qrel,hi);}while(0)
  STEP(pB0,pB1,pA0,pA1,NT-1,false,false,false); RESC();
  { float sacc=pB0[0]+pB0[1]; _Pragma("unroll") for(int r=2;r<16;++r)sacc+=pB0[r]; _Pragma("unroll") for(int r=0;r<16;++r)sacc+=pB1[r]; l_reg+=sacc;
    pw0=(u32x4_){PKW(pB0,0),PKW(pB0,2),PKW(pB0,4),PKW(pB0,6)};pw1=(u32x4_){PKW(pB0,8),PKW(pB0,10),PKW(pB0,12),PKW(pB0,14)};pw2=(u32x4_){PKW(pB1,0),PKW(pB1,2),PKW(pB1,4),PKW(pB1,6)};pw3=(u32x4_){PKW(pB1,8),PKW(pB1,10),PKW(pB1,12),PKW(pB1,14)};
    SBAR(); pv(o,vb0+sl_cur,PAF(0),PAF(1),PAF(2),PAF(3)); }
  #undef PKW
  #undef PAF
  #undef VFR
  #undef PIN
  #undef MX3
  #undef GAPA
  #undef GAPB
  #undef EX
  #undef VRD
  #undef KRD
  #undef STEP
  #undef ENDW
  {auto rr=__builtin_amdgcn_permlane32_swap(__float_as_uint(l_reg),__float_as_uint(l_reg),false,false);l_reg=__uint_as_float(rr[0])+__uint_as_float(rr[1]);}
  if(hi==0)wsf[32+r32]=l_reg;asm volatile("s_waitcnt lgkmcnt(0)":::"memory");
  float rli[16];
  #pragma unroll
  for(int r=0;r<16;++r)rli[r]=__builtin_amdgcn_rcpf(wsf[32+crow(r,hi)]);
  bf16*Ow=O+(rowbase+q0+wid*QBLK)*DMP+h*D;
  { bf16*stg=(bf16*)(shm+LDS_OST)+wid*2048;
    #pragma unroll
    for(int r=0;r<16;++r){const int orow=crow(r,hi);
      #pragma unroll
      for(int d0=0;d0<2;++d0)stg[orow*64+d0*32+r32]=(bf16)f2bf(o[d0][r]*rli[r]);}
    asm volatile("s_waitcnt lgkmcnt(0)":::"memory");
    #pragma unroll
    for(int i=0;i<4;++i){const int row=i*8+(lane>>3),ch=lane&7; const u32x4_ v=*(const u32x4_*)(stg+row*64+ch*8); *(u32x4_*)(Ow+(long)row*DMP+ch*8)=v;} }
  asm volatile("s_waitcnt lgkmcnt(0)\n\ts_barrier":::"memory");
  #undef DMA_K
  #undef DMA_V
  #undef CMASK
  #undef START
  #undef RESC
  #undef ROT
  #undef TJ
  #undef CKP
}
#undef SBAR
#undef WAIT_BAR
}

__device__ __forceinline__ void p_norms(const Frame& Fin_, const Params& P) {
    Frame F = Fin_; LAUNDER(F);
    const float* NP = (const float*)(P.ws + WS_NP); float* QN = (float*)(P.ws + WS_QN); float* KN = (float*)(P.ws + WS_KN);
    const int gw = ((int)blockIdx.x - 160) * NWAVES + F.wave, NGW = (F.G - 160) * NWAVES;
    for (int it = gw; it < T / 64; it += NGW) { const int b = it >> 7, tile = it & 127; const float* p = NP + ((size_t)b * SEQ + tile * 64) * 32 + F.lane;
        float v[32];
#pragma unroll
        for (int i = 0; i < 32; ++i) v[i] = p[i * 64];
        float m = 0.f;
#pragma unroll
        for (int i = 0; i < 32; ++i) m = fmaxf(m, v[i] + __shfl_xor(v[i], 1));
        m = fmaxf(m, __shfl_xor(m, 32)) * (1.0f + 1.0f / 64.0f);
        const int seg = F.lane & 31;
        if (F.lane < 32 && (seg & 1) == 0) { if (seg < 16) QN[(b * NH + (seg >> 1)) * 128 + tile] = m; else KN[(b * NH + ((seg - 16) >> 1)) * 128 + tile] = m; } }
}


#define XB_TMO      128
#define XB_XCNT(j)  (256  + 64 * (j))
#define XB_XSUB(j)  (1280 + 64 * (j))
#define XB_XGEN(j)  (2304 + 64 * (j))
#define XB_TOP      3328
#define XB_TOPGEN   3392
#define XCD_BAR_WORDS 3456
#define XB_SPIN_CAP (1u << 18)
constexpr int CW_BAR = 4096;
constexpr size_t CTL_ZERO_BYTES = 65536;
constexpr unsigned REP_MASK = 0u;
constexpr int CW_ATTNQ = 8192;
constexpr int LDSCTL_OFF = RING_BYTES, MISC_OFF = LDSCTL_OFF + 320;
__device__ __forceinline__ unsigned xb_ld(unsigned* p)              { return __hip_atomic_load(p, __ATOMIC_RELAXED, __HIP_MEMORY_SCOPE_AGENT); }
__device__ __forceinline__ unsigned xb_add(unsigned* p, unsigned v) { return __hip_atomic_fetch_add(p, v, __ATOMIC_RELAXED, __HIP_MEMORY_SCOPE_AGENT); }
__device__ __forceinline__ unsigned xb_xcc_id() { return (unsigned)__builtin_amdgcn_s_getreg((3 << 11) | 20) & 0xFu; }
#define XB_SPIN(cond, bar) do { unsigned _sp = 0; while (cond) { __builtin_amdgcn_s_sleep(1); \
    if ((++_sp & 255u) == 0u) { if (xb_ld(&(bar)[XB_TMO])) break; if (_sp > XB_SPIN_CAP) { atomicAdd(&(bar)[XB_TMO], 1u); break; } } } } while (0)
struct XcdBarrier { unsigned* bar; unsigned x; volatile LAS unsigned* st; };
__device__ __forceinline__ XcdBarrier xcd_barrier_post(unsigned* bar, volatile LAS unsigned* st) {
    XcdBarrier b; b.bar = bar; b.x = xb_xcc_id(); b.st = st;
    if (threadIdx.x == 0) (void)xb_add(&bar[XB_XCNT(b.x)], 1u);
    return b;
}
__device__ __forceinline__ void xcd_barrier_complete(unsigned* bar, unsigned x, unsigned& nloc, unsigned& nx) {
    const unsigned G = gridDim.x * gridDim.y * gridDim.z;
    unsigned sum, cnt, mine, sp = 0u;
    for (;;) {
        sum = 0u; cnt = 0u; mine = 0u;
#pragma unroll
        for (unsigned j = 0; j < 16; ++j) { const unsigned c = xb_ld(&bar[XB_XCNT(j)]); sum += c; cnt += (c > 0u) ? 1u : 0u; mine = (j == x) ? c : mine; }
        if (sum == G) break;
        __builtin_amdgcn_s_sleep(1);
        if ((++sp & 255u) == 0u) { if (xb_ld(&bar[XB_TMO])) break; if (sp > XB_SPIN_CAP) { atomicAdd(&bar[XB_TMO], 1u); break; } }
    }
    nloc = mine > 0u ? mine : 1u; nx = cnt > 0u ? cnt : 1u;
}
__device__ __forceinline__ void xcd_barrier(const XcdBarrier& b) {
    asm volatile("s_waitcnt vmcnt(0)" ::: "memory");
    __syncthreads();
    if (threadIdx.x == 0) {
        unsigned* bar = b.bar;
        __builtin_amdgcn_s_waitcnt(0);
        unsigned nloc = b.st[0], nx = b.st[1];
        if (nloc == 0u) { xcd_barrier_complete(bar, b.x, nloc, nx); b.st[0] = nloc; b.st[1] = nx; }
        const unsigned old = xb_add(&bar[XB_XSUB(b.x)], 1u);
        const unsigned gen = old / nloc;
        if (old + 1u == (gen + 1u) * nloc) {
            __builtin_amdgcn_fence(__ATOMIC_RELEASE, "agent");
            asm volatile("s_waitcnt vmcnt(0)" ::: "memory");
            const unsigned og = xb_add(&bar[XB_TOP], 1u);
            const unsigned tg = og / nx;
            if (og + 1u == (tg + 1u) * nx) xb_add(&bar[XB_TOPGEN], 1u);
            else XB_SPIN(xb_ld(&bar[XB_TOPGEN]) == tg, bar);
            __builtin_amdgcn_fence(__ATOMIC_ACQUIRE, "agent");
            xb_add(&bar[XB_XGEN(b.x)], 1u);
            asm volatile("s_waitcnt vmcnt(0)" ::: "memory");
        } else {
            XB_SPIN(xb_ld(&bar[XB_XGEN(b.x)]) == gen, bar);
            __builtin_amdgcn_fence(__ATOMIC_ACQUIRE, "agent");
            asm volatile("s_waitcnt vmcnt(0)" ::: "memory");
        }
    }
    __syncthreads();
}


__device__ __forceinline__ void attn_only_phase(const fox::Tensors& TT, char* lds, unsigned* ctr, volatile LAS int* qw) {
    if (threadIdx.x == 0) qw[0] = (int)__hip_atomic_fetch_add(ctr, 1u, __ATOMIC_RELAXED, __HIP_MEMORY_SCOPE_AGENT);
    __syncthreads();
    for (int slot = 0;; slot ^= 1) { const int u = qw[slot]; if (u >= 32 * 32) break;
        int nxt = 0; if (threadIdx.x == 0) nxt = (int)__hip_atomic_fetch_add(ctr, 1u, __ATOMIC_RELAXED, __HIP_MEMORY_SCOPE_AGENT);
        const int qb = 31 - (u >> 5), bh = u & 31; fox::attn_unit<8>(bh / NH, bh % NH, qb, TT, lds);
        if (threadIdx.x == 0) qw[slot ^ 1] = nxt; __syncthreads(); }
}

enum Phase { PH_PRO = 0, PH_PROJ, PH_CUMSUM, PH_SSMS, PH_CARRY, PH_SSMY, PH_ATTN, PH_GLU, PH_OUTA, PH_OUTB, PH_WOUT, PH_ROUTER, PH_POS, PH_MOEGU, PH_MOEMIX, PH_MOEDN, PH_FINAL, PH_N };

__global__ void __launch_bounds__(NTHR, 2) mega(Params P) {
    extern __shared__ __attribute__((aligned(16))) unsigned char lds_raw[];
    Frame F; F.lds = (LAS unsigned char*)lds_raw; F.tid = threadIdx.x; F.lane = F.tid & 63; F.wave = __builtin_amdgcn_readfirstlane(F.tid >> 6);
    F.G = gridDim.x; { const int bx = blockIdx.x; F.vcu = (F.G % 8 == 0) ? (bx % 8) * (F.G / 8) + bx / 8 : bx; }
    const int lo = P.ph_lo, hi = P.ph_hi;
    unsigned char* ws = P.ws;
    for (int u = F.tid; u < (LDS_BYTES - LDSCTL_OFF) / 4; u += NTHR) ((LAS unsigned*)(F.lds + LDSCTL_OFF))[u] = 0u;
    __syncthreads();
    XcdBarrier bar; bar.bar = (unsigned*)(ws + WS_CTL) + CW_BAR; bar.x = 0; bar.st = nullptr;
    if (hi - lo > 1) bar = xcd_barrier_post((unsigned*)(ws + WS_CTL) + CW_BAR, (volatile LAS unsigned*)(F.lds + MISC_OFF) + 8);
#define IN(k) (lo <= (k) && (k) < hi)
#define SEAM(k) do { if (IN(k) && IN((k) + 1)) xcd_barrier(bar); } while (0)
#define REPEAT(i) for (int rep_ = 0; rep_ < 1 + (int)((REP_MASK >> (i)) & 1u); ++rep_)
    REPEAT(0) { if (IN(PH_PRO)) p0_prologue(F, P);
    SEAM(PH_PRO); }
    REPEAT(1) { if (IN(PH_PROJ)) { for (int i = F.tid; i < 2048; i += NTHR) ((LAS float*)(F.lds + BIAS_OFF))[i] = P.in[4][i] * -LOG2E; __syncthreads();
        SchedPlain S{(const bf16*)(ws + WS_XN), (const bf16*)(ws + WS_WIN), T / 256, NPROJ / 256, {1024, 1024, 1024}};
        EpiProj E{(bf16*)(ws + WS_Q), (bf16*)(ws + WS_K), (bf16*)(ws + WS_V), (bf16*)(ws + WS_UH), (bf16*)(ws + WS_GATES), (const LAS float*)(F.lds + BIAS_OFF), (float*)(ws + WS_NP)}; run_gemm(F.lds, S.d, S, E); }
    SEAM(PH_PROJ); }
    REPEAT(2) { if (IN(PH_CUMSUM)) { if (blockIdx.x >= 160) p_norms(F, P); else if (blockIdx.x >= 128) p_cumsum(F, P);
        if (blockIdx.x >= 128) { __syncthreads(); p0_weights(F, P, 1); } }
    if (IN(PH_SSMS)) { SchedSsmS S{(const bf16*)(ws + WS_UH), (const bf16*)(ws + WS_WS)}; EpiSsmS E{(float*)(ws + WS_S)}; run_gemm(F.lds, GemmDims{512, KY, 512}, S, E); }
    if (IN(PH_CARRY)) { __syncthreads(); p_carry(F, P); }
    SEAM(PH_CARRY); }
    REPEAT(3) { if (IN(PH_SSMY)) { SchedSsmY S{(const bf16*)(ws + WS_UH), (const bf16*)(ws + WS_MX), F.G}; EpiSsmY E{(bf16*)(ws + WS_Z)}; run_gemm(F.lds, GemmDims{KY, KY, KY}, S, E); __syncthreads(); }
    if (IN(PH_ATTN)) { const fox::Tensors TT{(const bf16*)(ws + WS_Q), (const bf16*)(ws + WS_K), (const bf16*)(ws + WS_V), (bf16*)(ws + WS_OA), (const float*)(ws + WS_CK2), (const float*)(ws + WS_QN), (const float*)(ws + WS_KN)};
        attn_only_phase(TT, (char*)lds_raw, (unsigned*)(ws + WS_CTL) + CW_ATTNQ + 64 * rep_, (volatile LAS int*)(F.lds + MISC_OFF) + 16); }
    SEAM(PH_ATTN); }
    REPEAT(5) { if (IN(PH_GLU)) { for (int i = F.tid; i < 512; i += NTHR) ((LAS float*)(F.lds + BIAS_OFF))[i] = P.in[15][i] * -LOG2E; __syncthreads();
        SchedPlain S{(const bf16*)(ws + WS_Z), (const bf16*)(ws + WS_WGLU), T / 256, 2, {512, 512, 512}}; EpiGlu E{(const bf16*)(ws + WS_Z), (bf16*)(ws + WS_ZZ), (const LAS float*)(F.lds + BIAS_OFF)}; run_gemm(F.lds, S.d, S, E); }
    SEAM(PH_GLU); }
    REPEAT(6) { if (IN(PH_OUTB)) { SchedOutAB S{(const bf16*)(ws + WS_OA), (const bf16*)(ws + WS_ZZ), (const bf16*)(ws + WS_WOA), (const bf16*)(ws + WS_WOB)}; EpiOutAB E{(const unsigned char*)(ws + WS_GATES), (bf16*)(ws + WS_MERGED)};
        run_gemm(F.lds, GemmDims{1024, 512, 512}, S, E); }
    SEAM(PH_OUTB); }
    REPEAT(7) { if (IN(PH_WOUT)) { SchedPlain S{(const bf16*)(ws + WS_MERGED), (const bf16*)(ws + WS_WO), T / 256, 4, {1024, 1024, 1024}};
        { UnitX u0; u0.pn = 0; S.get((int)blockIdx.x, u0); stage_router_table(F, P, u0.pn); }
        EpiWout E{P.in[0], (bf16*)(ws + WS_H2), (float*)(ws + WS_PART), (const LAS unsigned char*)(F.lds + RT_OFF)}; run_gemm(F.lds, S.d, S, E); }
    SEAM(PH_WOUT); }
    REPEAT(8) { if (IN(PH_ROUTER)) p_router(F, P, rep_ == 0);
    SEAM(PH_ROUTER); }
    REPEAT(10) { if (IN(PH_MOEGU)) { moe_tile_table(F, P);
        SchedMoeGU S{(const bf16*)(ws + WS_H2), (const bf16*)(ws + WS_WGU), (const int*)(ws + WS_LIST), (const LAS int*)(F.lds + TT_OFF), MoeRange{0, 512, 0, 0, F.G}}; EpiMoeGU E{(bf16*)(ws + WS_HACT), (const float*)(ws + WS_LPW)}; run_gemm(F.lds, GemmDims{1024, 1024, 1024}, S, E); }
    SEAM(PH_MOEGU); }
    REPEAT(11) { if (IN(PH_MOEMIX)) { const LAS int* tt = (const LAS int*)(F.lds + TT_OFF); const int nu = 4 * tt[568]; int L = nu - 512; L = L < 0 ? 0 : (L > F.G ? F.G : L);
        { SchedMoeGU S{(const bf16*)(ws + WS_H2), (const bf16*)(ws + WS_WGU), (const int*)(ws + WS_LIST), tt, MoeRange{512, nu, 1, 0, F.G}}; EpiMoeGU E{(bf16*)(ws + WS_HACT), (const float*)(ws + WS_LPW)}; run_gemm(F.lds, GemmDims{1024, 1024, 1024}, S, E); }
        { const int dn_b = nu < 512 ? nu : 512;
          SchedMoeDN S{(const bf16*)(ws + WS_HACT), (const bf16*)(ws + WS_WD), tt, MoeRange{0, dn_b, 2, L, F.G}}; EpiMoeDN E{(bf16*)(ws + WS_Y)}; run_gemm(F.lds, GemmDims{512, 512, 512}, S, E); } }
    SEAM(PH_MOEMIX); }
    REPEAT(13) { if (IN(PH_MOEDN)) { const LAS int* tt = (const LAS int*)(F.lds + TT_OFF); const int nu = 4 * tt[568]; int L = nu - 512; L = L < 0 ? 0 : (L > F.G ? F.G : L);
        int d0 = 2 * (F.G - L); { const int dn_b = nu < 512 ? nu : 512; d0 = d0 < dn_b ? d0 : dn_b; }
        SchedMoeDN S{(const bf16*)(ws + WS_HACT), (const bf16*)(ws + WS_WD), tt, MoeRange{d0, nu, 0, 0, F.G}}; EpiMoeDN E{(bf16*)(ws + WS_Y)}; run_gemm(F.lds, GemmDims{512, 512, 512}, S, E); }
    SEAM(PH_MOEDN); }
    REPEAT(12) { if (IN(PH_FINAL)) p_final(F, P); }
#undef REPEAT
#undef SEAM
#undef IN
}

static void launch_mega(const Params& base, int lo, int hi, int grid, hipStream_t stream) {
    Params p = base; p.ph_lo = lo; p.ph_hi = hi;
    hipLaunchKernelGGL(mega, dim3(grid), dim3(NTHR), LDS_BYTES, stream, p);
}

extern "C" void kernel_launch(void* const* d_in, const int* in_sizes, int n_in, void* d_out, int out_size, void* d_ws, size_t ws_size, hipStream_t stream) {
    static int grid = 0;
    if (grid == 0) {
        if (n_in != 27 || out_size != T * DM || ws_size < WS_END) { fprintf(stderr, "kernel_launch: unexpected shapes (n_in %d out %d ws %zu)\n", n_in, out_size, ws_size); grid = -1; return; }
        if (hipFuncSetAttribute((const void*)mega, hipFuncAttributeMaxDynamicSharedMemorySize, LDS_BYTES) != hipSuccess) { fprintf(stderr, "hipFuncSetAttribute failed\n"); grid = -1; return; }
        int dev = 0, cus = 0, per_cu = 0; hipGetDevice(&dev); hipDeviceGetAttribute(&cus, hipDeviceAttributeMultiprocessorCount, dev);
        hipOccupancyMaxActiveBlocksPerMultiprocessor(&per_cu, (const void*)mega, NTHR, LDS_BYTES);
        (void)hipGetLastError();
        grid = cus * (per_cu < 1 ? 1 : 1);
    }
    if (grid < 0) return;
    Params P{};
    for (int i = 0; i < 27; ++i) P.in[i] = (const float*)d_in[i];
    P.out = (float*)d_out; P.ws = (unsigned char*)d_ws;
    if (hipMemsetAsync((char*)d_ws + WS_CTL, 0, CTL_ZERO_BYTES, stream) != hipSuccess) { fprintf(stderr, "kernel_launch: memset failed\n"); return; }
    P.ph_lo = 0; P.ph_hi = PH_N;
    void* args[] = {&P};
    const hipError_t le = hipLaunchCooperativeKernel((const void*)mega, dim3(grid), dim3(NTHR), args, LDS_BYTES, stream);
    if (le != hipSuccess) fprintf(stderr, "kernel_launch: cooperative launch failed: %s (grid %d)\n", hipGetErrorString(le), grid);
}
```

```cpp
#include <hip/hip_runtime.h>
#include <cstdint>
#include <cstdio>

#ifndef FAST_SSM
#define FAST_SSM 1
#endif
#ifndef FAST_ATTN
#define FAST_ATTN 1
#endif
#ifndef FAST_GEMM
#define FAST_GEMM 1
#endif
constexpr int BATCH = 4, SEQ = 8192, DM = 1024, T = BATCH * SEQ;
constexpr int NH = 8, HD = 64, FW = 512;
constexpr int SG = 32, SC = 16, SP = 64, SW = 512, LCH = 32, NCHB = SEQ / LCH, NCH = T / LCH;
constexpr int KY = 640;
constexpr int NPROJ = 4096;
constexpr int WIN_LD = 4104;
constexpr int NE = 16, FF = 256, NCLS = 24;
constexpr int MAXTILES = T / 256 + NCLS;
constexpr float EPS = 1e-6f;
constexpr float LOG2E = 1.4426950408889634f;
constexpr float C2 = 0.125f * LOG2E;

constexpr size_t MiB = 1u << 20;
constexpr size_t WS_CTL = 0;
constexpr size_t WS_WIN = 1 * MiB;
constexpr size_t WS_WOA = 9 * MiB;
constexpr size_t WS_WGLU = 10 * MiB;
constexpr size_t WS_WOB = 11 * MiB;
constexpr size_t WS_WO = 12 * MiB;
constexpr size_t WS_WGU = 14 * MiB;
constexpr size_t WS_WD = 30 * MiB;
constexpr size_t WS_MX = 54 * MiB;
constexpr size_t WS_WS = 74 * MiB;
constexpr size_t WS_AL = 79 * MiB;
constexpr size_t WS_CK2 = 80 * MiB;
constexpr size_t WS_LF = 81 * MiB;
constexpr size_t WS_CLS = 82 * MiB;
constexpr size_t WS_WAB = WS_CLS + 128 * 1024;
constexpr size_t WS_CNT = WS_WAB + 256 * 1024;
constexpr size_t WS_P2T = WS_CNT + 32 * 1024;
constexpr size_t WS_PW = WS_P2T + 160 * 1024;
constexpr size_t WS_TCLS = WS_PW + 320 * 1024;
constexpr size_t WS_QN = 83 * MiB;
constexpr size_t WS_KN = 83 * MiB + 65536;
constexpr size_t WS_NP = 84 * MiB;
constexpr size_t WS_XN = 96 * MiB;
constexpr size_t WS_T1 = WS_XN, WS_H2 = WS_XN;
constexpr size_t WS_Q = 160 * MiB, WS_K = 192 * MiB, WS_V = 224 * MiB;
constexpr size_t WS_MERGED = WS_Q;
constexpr size_t WS_HACT = WS_Q;
constexpr size_t WS_ZZ = WS_V;
constexpr size_t WS_UH = 256 * MiB;
constexpr size_t WS_S = 296 * MiB;
constexpr size_t WS_GATES = 312 * MiB;
constexpr size_t WS_XG = WS_GATES;
constexpr size_t WS_LIST = WS_UH;
constexpr size_t WS_LPW = WS_UH + 4 * MiB;
constexpr size_t WS_Y = WS_GATES;
constexpr size_t WS_TPOS = WS_UH + 20 * MiB;
constexpr size_t WS_PART = 392 * MiB;
constexpr size_t WS_OA = 440 * MiB;
constexpr size_t WS_Z = 472 * MiB;
constexpr size_t WS_END = 504 * MiB;

#define LAS __attribute__((address_space(3)))
typedef unsigned short bf16;
typedef float f32x4 __attribute__((ext_vector_type(4)));
typedef unsigned u32x4 __attribute__((ext_vector_type(4)));
typedef unsigned u32x2 __attribute__((ext_vector_type(2)));
typedef short bf16x8 __attribute__((ext_vector_type(8)));

typedef float f32x2_cv __attribute__((ext_vector_type(2))); typedef __bf16 bf16x2_cv __attribute__((ext_vector_type(2)));
__device__ __forceinline__ unsigned pk2(float lo, float hi) { const f32x2_cv v = {lo, hi}; const bf16x2_cv b = __builtin_convertvector(v, bf16x2_cv); return __builtin_bit_cast(unsigned, b); }
__device__ __forceinline__ unsigned f2bf(float f) { return pk2(f, 0.f) & 0xffffu; }
__device__ __forceinline__ float bf2f(unsigned b) { return __builtin_bit_cast(float, b << 16); }
__device__ __forceinline__ float wave_sum(float v) {
#pragma unroll
    for (int o = 1; o < 64; o <<= 1) v += __shfl_xor(v, o);
    return v;
}
__device__ __forceinline__ float sigmoidf_(float v) { return __builtin_amdgcn_rcpf(1.0f + __builtin_amdgcn_exp2f(v * -LOG2E)); }
__device__ __forceinline__ float sigmoid_b(float v, float nb) { return __builtin_amdgcn_rcpf(1.0f + __builtin_amdgcn_exp2f(__builtin_fmaf(v, -LOG2E, nb))); }
__device__ __forceinline__ float gelu_tanh(float y) { const float y2 = y * y; const float t = y * __builtin_fmaf(y2, -2.0f * LOG2E * 0.7978845608028654f * 0.044715f, -2.0f * LOG2E * 0.7978845608028654f); return y * __builtin_amdgcn_rcpf(1.0f + __builtin_amdgcn_exp2f(t)); }
__device__ __forceinline__ void store8(bf16* p, const float (&v)[8]) { u32x4 w; w.x = pk2(v[0], v[1]); w.y = pk2(v[2], v[3]); w.z = pk2(v[4], v[5]); w.w = pk2(v[6], v[7]); *(u32x4*)p = w; }
__device__ __forceinline__ void load8(const bf16* p, float (&v)[8]) { const u32x4 w = *(const u32x4*)p; v[0] = bf2f(w.x & 0xffffu); v[1] = bf2f(w.x >> 16); v[2] = bf2f(w.y & 0xffffu); v[3] = bf2f(w.y >> 16); v[4] = bf2f(w.z & 0xffffu); v[5] = bf2f(w.z >> 16); v[6] = bf2f(w.w & 0xffffu); v[7] = bf2f(w.w >> 16); }

__host__ __device__ __forceinline__ int pair_a(int pi) { return (pi >= 3) + (pi >= 5); }
__host__ __device__ __forceinline__ int pair_b(int pi) { return pi < 3 ? pi + 1 : (pi < 5 ? pi - 1 : 3); }
__host__ __device__ __forceinline__ int pair_idx(int a, int b) { return a == 0 ? b - 1 : (a == 1 ? b + 1 : 5); }

struct Params {
    const float* in[27];
    float* out;
    unsigned char* ws;
    int ph_lo, ph_hi;
};

struct UnitX { int pm, pn; const char* A; const char* B; int aux, tic, cnt; const char* A2; const char* B2; };
struct GemmDims { int K, lda, ldb; };
constexpr int RT_ROWB = 528;

struct SchedPlain {
    static constexpr bool GATHER = false;
    static constexpr int KSPLIT = 1 << 20;
    const bf16* A; const bf16* Bt; int nM, nN; GemmDims d;
    __device__ __forceinline__ int count() const { return nM * nN; }
    __device__ __forceinline__ bool get(int idx, UnitX& u) const {
        if (idx >= nM * nN) return false;
        int wgid = idx; { const int nwg = nM * nN, q = nwg / 8, r = nwg % 8, xcd = wgid % 8, off = wgid / 8; wgid = (xcd < r ? xcd * (q + 1) : r * (q + 1) + (xcd - r) * q) + off; }
        const int nig = 8 * nN, gid = wgid / nig, fm = gid * 8, gsz = (nM - fm) < 8 ? (nM - fm) : 8;
        u.pm = fm + ((wgid % nig) % gsz); u.pn = (wgid % nig) / gsz; u.aux = 0;
        u.A = (const char*)A + (size_t)u.pm * 256 * d.lda * 2; u.B = (const char*)Bt + (size_t)u.pn * 256 * d.ldb * 2; return true;
    }
};
struct SchedOutAB {
    static constexpr bool GATHER = false; static constexpr int KSPLIT = 8;
    const bf16* OA; const bf16* ZZ; const bf16* WoaT; const bf16* WobT;
    __device__ __forceinline__ bool get(int idx, UnitX& u) const {
        const int nM = T / 256, nN = 4; if (idx >= nM * nN) return false;
        int wgid = idx; { const int nwg = nM * nN, q = nwg / 8, r = nwg % 8, xcd = wgid % 8, off = wgid / 8; wgid = (xcd < r ? xcd * (q + 1) : r * (q + 1) + (xcd - r) * q) + off; }
        const int nig = 8 * nN, gid = wgid / nig, fm = gid * 8, gsz = (nM - fm) < 8 ? (nM - fm) : 8;
        u.pm = fm + ((wgid % nig) % gsz); u.pn = (wgid % nig) / gsz; u.aux = 0; u.tic = 0; u.cnt = 0;
        u.A = (const char*)(OA + (size_t)u.pm * 256 * 512); u.B = (const char*)(WoaT + (size_t)u.pn * 256 * 512);
        u.A2 = (const char*)(ZZ + (size_t)u.pm * 256 * 512) - (size_t)KSPLIT * 128; u.B2 = (const char*)(WobT + (size_t)u.pn * 256 * 512) - (size_t)KSPLIT * 128; return true;
    }
};
struct SchedSsmS {
    static constexpr bool GATHER = false;
    static constexpr int KSPLIT = 1 << 20;
    const bf16* UH; const bf16* WsT;
    __device__ __forceinline__ int count() const { return SG * 4; }
    __device__ __forceinline__ bool get(int idx, UnitX& u) const {
        if (idx >= SG * 4) return false; const int g = idx >> 2, mt = idx & 3;
        u.pm = g * 4 + mt; u.pn = 0; u.aux = g; u.A = (const char*)(UH + ((size_t)g * NCH + mt * 256) * KY); u.B = (const char*)(WsT + (size_t)g * 128 * 512); return true;
    }
};
struct SchedSsmY {
    static constexpr bool GATHER = false;
    static constexpr int KSPLIT = 1 << 20;
    const bf16* UH; const bf16* MxT; int G;
    __device__ __forceinline__ int count() const { return SG * 8; }
    __device__ __forceinline__ bool get(int idx, UnitX& u) const {
        const int k = idx / G, c = idx - k * G; if (c >= SG * 4 || k >= 2) return false; const int g = c >> 2, mt = c & 3, nt = k;
        u.pm = g * 4 + mt; u.pn = nt; u.aux = g; u.A = (const char*)(UH + ((size_t)g * NCH + mt * 256) * KY); u.B = (const char*)(MxT + ((size_t)g * 512 + nt * 256) * KY); return true;
    }
};
struct MoeRange { int base, end, per, wskip, G;
    __device__ __forceinline__ int unit(int idx) const { int u;
        if (per > 0) { const int k = idx / G, c = idx - k * G - wskip; if (c < 0 || k >= per) return -1; u = base + c * per + k; } else u = base + idx;
        return u < end ? u : -1; } };
struct SchedMoeGU {
    static constexpr bool GATHER = true;
    static constexpr int KSPLIT = 1 << 20;
    const bf16* H2; const bf16* WguT; const int* LIST; const LAS int* tt;
    MoeRange R;
    __device__ __forceinline__ int count() const { return MAXTILES * 4; }
    __device__ __forceinline__ bool get(int idx_, UnitX& u) const {
        const int idx = R.unit(idx_); if (idx < 0) return false; const int tile = idx >> 2, pn = idx & 3; const int cls = tt[2 * tile]; if (cls < 0) return false;
        const int grp = cls / 6, pi = cls % 6, e = grp * 4 + ((pn >> 1) ? pair_b(pi) : pair_a(pi));
        u.pm = tile; u.pn = pn; u.aux = cls; u.tic = tt[2 * tile + 1]; u.cnt = tt[512 + cls]; u.A = (const char*)H2; u.B = (const char*)(WguT + ((size_t)e * 512 + (pn & 1) * 256) * DM); return true;
    }
    __device__ __forceinline__ unsigned rowoff(const UnitX& u, int r) const { const int pos = u.tic * 256 + r; const int tok = pos < u.cnt ? LIST[(size_t)u.aux * T + pos] : 0; return (unsigned)tok * (unsigned)(DM * 2); }
};
struct SchedMoeDN {
    static constexpr bool GATHER = false;
    static constexpr int KSPLIT = 1 << 20;
    const bf16* HACT; const bf16* WdT; const LAS int* tt;
    MoeRange R;
    __device__ __forceinline__ int count() const { return MAXTILES * 4; }
    __device__ __forceinline__ bool get(int idx_, UnitX& u) const {
        const int idx = R.unit(idx_); if (idx < 0) return false; const int tile = idx >> 2, pn = idx & 3; const int cls = tt[2 * tile]; if (cls < 0) return false;
        u.pm = tile; u.pn = pn; u.aux = cls; u.tic = tt[2 * tile + 1]; u.cnt = tt[512 + cls]; u.A = (const char*)(HACT + (size_t)tile * 256 * 512); u.B = (const char*)(WdT + ((size_t)cls * 1024 + pn * 256) * 512); return true;
    }
};

struct NoIn {};
struct EpiProj {
    static constexpr bool PAIR = false;
    bf16 *Q, *K, *V, *UH, *GATES; const LAS float* bgate; float* NP;
    struct In { f32x4 b0, b1; };
    __device__ __forceinline__ In load(const UnitX& u, int r, int c) const { In in; const int pn = __builtin_amdgcn_readfirstlane(u.pn);
        if (pn >= 8) { const LAS float* bp = bgate + (pn - 8) * 256 + c; in.b0 = *(const LAS f32x4*)bp; in.b1 = *(const LAS f32x4*)(bp + 4); } else { in.b0 = (f32x4){0.f, 0.f, 0.f, 0.f}; in.b1 = in.b0; } return in; }
    __device__ __forceinline__ void apply(const UnitX& u, int r, int c, const float (&v)[8], const In& in) const {
        const int pn = __builtin_amdgcn_readfirstlane(u.pn); const unsigned row = (unsigned)(u.pm * 256 + r);
        static_assert(WS_K - WS_Q == 32 * MiB && WS_V - WS_K == 32 * MiB, "q | k | v buffers equally spaced");
        if (pn < 6) { bf16* base = Q + (size_t)(pn >> 1) * (size_t)(16u << 20); const float sc = pn < 2 ? C2 : 1.0f; float w[8];
#pragma unroll
            for (int e = 0; e < 8; ++e) w[e] = v[e] * sc;
            store8(base + (row * 512u + (unsigned)((pn & 1) * 256 + c)), w);
            if (pn < 4) { float ss = ((w[0] * w[0] + w[1] * w[1]) + (w[2] * w[2] + w[3] * w[3])) + ((w[4] * w[4] + w[5] * w[5]) + (w[6] * w[6] + w[7] * w[7]));
                ss += __shfl_xor(ss, 16); ss += __shfl_xor(ss, 32);
                if ((c & 24) == 0) NP[row * 32u + (unsigned)((pn >> 1) * 16 + (pn & 1) * 8 + (c >> 5))] = ss; } }
        else if (pn < 8) { const int cc = (pn - 6) * 256 + c, g = cc >> 4, ch0 = cc & 15; const unsigned n = row >> 5, i = row & 31u; store8(UH + (((unsigned)g * NCH + n) * (unsigned)KY + i * 16u + (unsigned)ch0), v); }
        else { const unsigned cc = (unsigned)((pn - 8) * 256 + c); unsigned q[8]; const float bb[8] = {in.b0.x, in.b0.y, in.b0.z, in.b0.w, in.b1.x, in.b1.y, in.b1.z, in.b1.w};
#pragma unroll
            for (int e = 0; e < 8; ++e) q[e] = (unsigned)__builtin_fmaf(sigmoid_b(v[e], bb[e]), 255.0f, 0.5f);
            u32x2 w; w.x = q[0] | (q[1] << 8) | (q[2] << 16) | (q[3] << 24); w.y = q[4] | (q[5] << 8) | (q[6] << 16) | (q[7] << 24);
            *(u32x2*)((unsigned char*)GATES + (row * 2048u + cc)) = w; }
    }
};
struct EpiSsmS {
    static constexpr bool PAIR = false;
    float* S;
    typedef NoIn In;
    __device__ __forceinline__ In load(const UnitX&, int, int) const { return In{}; }
    __device__ __forceinline__ void apply(const UnitX& u, int r, int c, const float (&v)[8], const In&) const {
        if (c >= 128) return;
        float* p = S + ((size_t)u.pm * 256 + r) * 128 + c;
        *(f32x4*)p = (f32x4){v[0], v[1], v[2], v[3]}; *(f32x4*)(p + 4) = (f32x4){v[4], v[5], v[6], v[7]};
    }
};
struct EpiSsmY {
    static constexpr bool PAIR = false;
    bf16* Z;
    typedef NoIn In;
    __device__ __forceinline__ In load(const UnitX&, int, int) const { return In{}; }
    __device__ __forceinline__ void apply(const UnitX& u, int r, int c, const float (&v)[8], const In&) const {
        const int g = u.aux, chunk = (u.pm & 3) * 256 + r, col = u.pn * 256 + c, j = col >> 4, o0 = col & 15; const int token = chunk * LCH + j; float w[8];
#pragma unroll
        for (int e = 0; e < 8; ++e) w[e] = gelu_tanh(v[e]);
        store8(Z + (size_t)token * SW + g * 16 + o0, w);
    }
};
struct EpiGlu {
    static constexpr bool PAIR = false;
    const bf16* Z; bf16* ZZ; const LAS float* bglu;
    struct In { u32x4 z; f32x4 b0, b1; };
    __device__ __forceinline__ In load(const UnitX& u, int r, int c) const { In in; const int row = u.pm * 256 + r, col = u.pn * 256 + c;
        in.z = *(const u32x4*)(Z + (size_t)row * SW + col); in.b0 = *(const LAS f32x4*)(bglu + col); in.b1 = *(const LAS f32x4*)(bglu + col + 4); return in; }
    __device__ __forceinline__ void apply(const UnitX& u, int r, int c, const float (&v)[8], const In& in) const {
        const int row = u.pm * 256 + r, col = u.pn * 256 + c; float w[8];
        const float z[8] = {bf2f(in.z.x & 0xffffu), bf2f(in.z.x >> 16), bf2f(in.z.y & 0xffffu), bf2f(in.z.y >> 16), bf2f(in.z.z & 0xffffu), bf2f(in.z.z >> 16), bf2f(in.z.w & 0xffffu), bf2f(in.z.w >> 16)};
        const float bb[8] = {in.b0.x, in.b0.y, in.b0.z, in.b0.w, in.b1.x, in.b1.y, in.b1.z, in.b1.w};
#pragma unroll
        for (int e = 0; e < 8; ++e) w[e] = z[e] * sigmoid_b(v[e], bb[e]);
        store8(ZZ + (size_t)row * SW + col, w);
    }
};
__device__ __forceinline__ void unpack_u8(const u32x2 w, float (&v)[8]) { const float s = 1.0f / 255.0f;
    v[0] = (float)(w.x & 0xffu) * s; v[1] = (float)((w.x >> 8) & 0xffu) * s; v[2] = (float)((w.x >> 16) & 0xffu) * s; v[3] = (float)(w.x >> 24) * s;
    v[4] = (float)(w.y & 0xffu) * s; v[5] = (float)((w.y >> 8) & 0xffu) * s; v[6] = (float)((w.y >> 16) & 0xffu) * s; v[7] = (float)(w.y >> 24) * s; }
struct EpiOutA {
    static constexpr bool PAIR = false;
    const bf16* GATES; bf16* T1;
    struct In { u32x2 g; };
    __device__ __forceinline__ In load(const UnitX& u, int r, int c) const { In in; in.g = *(const u32x2*)((const unsigned char*)GATES + (size_t)(u.pm * 256 + r) * 2048 + u.pn * 256 + c); return in; }
    __device__ __forceinline__ void apply(const UnitX& u, int r, int c, const float (&v)[8], const In& in) const {
        const int row = u.pm * 256 + r, col = u.pn * 256 + c; float g[8], w[8]; unpack_u8(in.g, g);
#pragma unroll
        for (int e = 0; e < 8; ++e) w[e] = g[e] * v[e];
        store8(T1 + (size_t)row * DM + col, w);
    }
};
struct EpiOutB {
    static constexpr bool PAIR = false;
    const bf16* GATES; const bf16* T1; bf16* MG;
    struct In { u32x2 g; u32x4 t; };
    __device__ __forceinline__ In load(const UnitX& u, int r, int c) const { In in; const int row = u.pm * 256 + r, col = u.pn * 256 + c;
        in.g = *(const u32x2*)((const unsigned char*)GATES + (size_t)row * 2048 + 1024 + col); in.t = *(const u32x4*)(T1 + (size_t)row * DM + col); return in; }
    __device__ __forceinline__ void apply(const UnitX& u, int r, int c, const float (&v)[8], const In& in) const {
        const int row = u.pm * 256 + r, col = u.pn * 256 + c; float g[8], w[8]; unpack_u8(in.g, g);
        const float t[8] = {bf2f(in.t.x & 0xffffu), bf2f(in.t.x >> 16), bf2f(in.t.y & 0xffffu), bf2f(in.t.y >> 16), bf2f(in.t.z & 0xffffu), bf2f(in.t.z >> 16), bf2f(in.t.w & 0xffffu), bf2f(in.t.w >> 16)};
#pragma unroll
        for (int e = 0; e < 8; ++e) w[e] = t[e] + g[e] * v[e];
        store8(MG + (size_t)row * DM + col, w);
    }
};
struct EpiOutAB {
    static constexpr bool PAIR = false, MID = true;
    const unsigned char* GATES; bf16* MG;
    struct In { u32x2 g; };
    struct MidIn { u32x2 g0, g1; };
    __device__ __forceinline__ MidIn mid_load(const UnitX& u, int r, int c) const { MidIn in; const unsigned char* p = GATES + (size_t)(u.pm * 256 + r) * 2048 + u.pn * 256 + c; in.g0 = *(const u32x2*)p; in.g1 = *(const u32x2*)(p + 1024); return in; }
    __device__ __forceinline__ void mid_apply(float (&v)[8], const MidIn& in) const { float g0[8], g1[8]; unpack_u8(in.g0, g0); unpack_u8(in.g1, g1);
#pragma unroll
        for (int e = 0; e < 8; ++e) v[e] *= g0[e] * __builtin_amdgcn_rcpf(fmaxf(g1[e], 1.0f / 512.0f)); }
    __device__ __forceinline__ In load(const UnitX& u, int r, int c) const { In in; in.g = *(const u32x2*)(GATES + (size_t)(u.pm * 256 + r) * 2048 + 1024 + u.pn * 256 + c); return in; }
    __device__ __forceinline__ void apply(const UnitX& u, int r, int c, const float (&v)[8], const In& in) const {
        float g1[8], w[8]; unpack_u8(in.g, g1);
#pragma unroll
        for (int e = 0; e < 8; ++e) w[e] = v[e] * fmaxf(g1[e], 1.0f / 512.0f);
        store8(MG + (size_t)(u.pm * 256 + r) * DM + u.pn * 256 + c, w);
    }
};
struct EpiWout {
    static constexpr bool PAIR = false, ROWJ = true;
    const float* x; bf16* X1B; float* PART; const LAS unsigned char* TB;
    struct In { f32x4 a, b; };
    __device__ __forceinline__ In load(const UnitX& u, int r, int c) const { In in; const size_t off = (size_t)(u.pm * 256 + r) * DM + u.pn * 256 + c; in.a = *(const f32x4*)(x + off); in.b = *(const f32x4*)(x + off + 4); return in; }
    __device__ __forceinline__ void apply2(const UnitX& u, int r, int c, const float (&v0)[8], const float (&v1)[8], const In& i0, const In& i1) const {
        const int fr = r & 15, fq = (c >> 3) & 3, wc = c >> 5; const unsigned row = (unsigned)(u.pm * 256 + r);
        const float xa[2][8] = {{i0.a.x + v0[0], i0.a.y + v0[1], i0.a.z + v0[2], i0.a.w + v0[3], i0.b.x + v0[4], i0.b.y + v0[5], i0.b.z + v0[6], i0.b.w + v0[7]},
                                {i1.a.x + v1[0], i1.a.y + v1[1], i1.a.z + v1[2], i1.a.w + v1[3], i1.b.x + v1[4], i1.b.y + v1[5], i1.b.z + v1[6], i1.b.w + v1[7]}};
        float ss = 0.f; f32x4 lg0 = {0.f, 0.f, 0.f, 0.f}, lg1 = {0.f, 0.f, 0.f, 0.f};
        const LAS unsigned char* t0 = TB + fr * RT_ROWB + c * 2; const LAS unsigned char* t1 = TB + (16 + (fr & 3)) * RT_ROWB + c * 2;
#pragma unroll
        for (int bj = 0; bj < 2; ++bj) { const float (&xv)[8] = xa[bj];
            const unsigned h0 = pk2(xv[0], xv[1]), h1 = pk2(xv[2], xv[3]), h2 = pk2(xv[4], xv[5]), h3 = pk2(xv[6], xv[7]);
            const unsigned l0 = pk2(xv[0] - bf2f(h0 & 0xffffu), xv[1] - bf2f(h0 >> 16)), l1 = pk2(xv[2] - bf2f(h1 & 0xffffu), xv[3] - bf2f(h1 >> 16)),
                           l2 = pk2(xv[4] - bf2f(h2 & 0xffffu), xv[5] - bf2f(h2 >> 16)), l3 = pk2(xv[6] - bf2f(h3 & 0xffffu), xv[7] - bf2f(h3 >> 16));
            *(u32x4*)(X1B + (row * (unsigned)DM + (unsigned)(u.pn * 256 + bj * 128 + c))) = (u32x4){h0, h1, h2, h3};
            ss += ((xv[0] * xv[0] + xv[1] * xv[1]) + (xv[2] * xv[2] + xv[3] * xv[3])) + ((xv[4] * xv[4] + xv[5] * xv[5]) + (xv[6] * xv[6] + xv[7] * xv[7]));
            const bf16x8 xh = __builtin_bit_cast(bf16x8, (u32x4){h0, h1, h2, h3}), xl = __builtin_bit_cast(bf16x8, (u32x4){l0, l1, l2, l3});
            const bf16x8 th0 = *(const LAS bf16x8*)(t0 + bj * 256), tl0 = *(const LAS bf16x8*)(t0 + bj * 256 + 20 * RT_ROWB), th1 = *(const LAS bf16x8*)(t1 + bj * 256), tl1 = *(const LAS bf16x8*)(t1 + bj * 256 + 20 * RT_ROWB);
            lg0 = __builtin_amdgcn_mfma_f32_16x16x32_bf16(th0, xh, lg0, 0, 0, 0); lg0 = __builtin_amdgcn_mfma_f32_16x16x32_bf16(th0, xl, lg0, 0, 0, 0); lg0 = __builtin_amdgcn_mfma_f32_16x16x32_bf16(tl0, xh, lg0, 0, 0, 0);
            lg1 = __builtin_amdgcn_mfma_f32_16x16x32_bf16(th1, xh, lg1, 0, 0, 0); lg1 = __builtin_amdgcn_mfma_f32_16x16x32_bf16(th1, xl, lg1, 0, 0, 0); lg1 = __builtin_amdgcn_mfma_f32_16x16x32_bf16(tl1, xh, lg1, 0, 0, 0); }
        ss += __shfl_xor(ss, 16); ss += __shfl_xor(ss, 32);
        f32x4* p = (f32x4*)PART + ((unsigned)((u.pn * 4 + wc) * 6) * (unsigned)T + row);
        p[(unsigned)fq * (unsigned)T] = lg0; if (fq == 0) p[4u * (unsigned)T] = lg1; if (fq == 1) p[5u * (unsigned)T] = (f32x4){ss, 0.f, 0.f, 0.f};
    }
};
struct EpiMoeGU {
    static constexpr bool PAIR = true;
    bf16* HACT; const float* LPW;
    struct In { f32x4 pw; };
    __device__ __forceinline__ In load(const UnitX& u, int r, int) const { In in; const int pos = u.tic * 256 + r; in.pw = (f32x4){0.f, 0.f, 0.f, 0.f}; if (pos < u.cnt) in.pw = *((const f32x4*)LPW + (size_t)u.aux * T + pos); return in; }
    __device__ __forceinline__ void apply_pair(const UnitX& u, int r, int c, const float (&vg)[8], const float (&vu)[8], const In& in) const {
        const float w = (u.pn >> 1) ? in.pw.y : in.pw.x, rs = in.pw.z; float o[8];
#pragma unroll
        for (int e = 0; e < 8; ++e) { const float gt = vg[e] * rs; o[e] = gt * sigmoidf_(gt) * (vu[e] * rs) * w; }
        store8(HACT + (size_t)(u.pm * 256 + r) * 512 + (u.pn >> 1) * 256 + (u.pn & 1) * 128 + c, o);
    }
};
struct EpiMoeDN {
    static constexpr bool PAIR = false;
    bf16* Y;
    typedef NoIn In;
    __device__ __forceinline__ In load(const UnitX&, int, int) const { return In{}; }
    __device__ __forceinline__ void apply(const UnitX& u, int r, int c, const float (&v)[8], const In&) const { store8(Y + (size_t)(u.pm * 256 + r) * DM + u.pn * 256 + c, v); }
};

namespace pg8 {
constexpr int BM = 256, BK = 64, HALF = 128, HTB = HALF * BK * 2, STAGE_BYTES = 8 * HTB;
__host__ __device__ __forceinline__ int lds_byte(int r, int c) { const int st = (r >> 4) * 2 + (c >> 5), rr = r & 15, cc = c & 31, ob = rr * 64 + cc * 2; return st * 1024 + (ob ^ (((ob >> 9) & 1) << 5)); }
__host__ __device__ __forceinline__ void stage_rc(int b, int& R, int& C) { const int st = b / 1024, sb = b % 1024, swz = sb ^ (((sb >> 9) & 1) << 5); R = (st >> 1) * 16 + swz / 64; C = (st & 1) * 32 + (swz % 64) / 2; }
__host__ __device__ __forceinline__ int perm32(int rho) { const int n = rho >> 4, i = rho & 15; return 8 * (i >> 2) + 4 * n + (i & 3); }

template <class Epi, class = void> struct HasMid { static constexpr bool value = false; };
template <class Epi> struct HasMid<Epi, decltype((void)Epi::MID)> { static constexpr bool value = Epi::MID; };
template <class Epi, class = void> struct HasRowJ { static constexpr bool value = false; };
template <class Epi> struct HasRowJ<Epi, decltype((void)Epi::ROWJ)> { static constexpr bool value = Epi::ROWJ; };
template <class Epi> struct EpiAdapt {
    static constexpr bool PERM = true, MID = HasMid<Epi>::value;
    Epi E;
    __device__ __forceinline__ void mid(f32x4 (&acc)[2][2][4][2], const UnitX& u, int wr, int wc, int fr, int fq) const {
        if constexpr (MID) { asm volatile("" : "+v"(fr), "+v"(fq));
            const int c = wc * 32 + 8 * fq;
#pragma unroll
            for (int ai = 0; ai < 2; ++ai) { typename Epi::MidIn in[4][2];
#pragma unroll
                for (int m = 0; m < 4; ++m)
#pragma unroll
                    for (int bj = 0; bj < 2; ++bj) in[m][bj] = E.mid_load(u, ai * HALF + wr * 64 + m * 16 + fr, bj * HALF + c);
#pragma unroll
                for (int m = 0; m < 4; ++m)
#pragma unroll
                    for (int bj = 0; bj < 2; ++bj) { f32x4& a0 = acc[ai][bj][m][0]; f32x4& a1 = acc[ai][bj][m][1]; float v[8] = {a0[0], a0[1], a0[2], a0[3], a1[0], a1[1], a1[2], a1[3]};
                        E.mid_apply(v, in[m][bj]); a0 = (f32x4){v[0], v[1], v[2], v[3]}; a1 = (f32x4){v[4], v[5], v[6], v[7]}; } } }
    }
    __device__ __forceinline__ void operator()(const f32x4 (&acc)[2][2][4][2], const UnitX& u, int wr, int wc, int fr, int fq) const {
        asm volatile("" : "+v"(fr), "+v"(fq));
        const int c = wc * 32 + 8 * fq;
#pragma unroll
        for (int ai = 0; ai < 2; ++ai) {
            if constexpr (Epi::PAIR) { typename Epi::In in[4];
#pragma unroll
                for (int m = 0; m < 4; ++m) in[m] = E.load(u, ai * HALF + wr * 64 + m * 16 + fr, c);
#pragma unroll
                for (int m = 0; m < 4; ++m) { const int r = ai * HALF + wr * 64 + m * 16 + fr; const f32x4 g0 = acc[ai][0][m][0], g1 = acc[ai][0][m][1], u0 = acc[ai][1][m][0], u1 = acc[ai][1][m][1];
                    const float vg[8] = {g0[0], g0[1], g0[2], g0[3], g1[0], g1[1], g1[2], g1[3]}, vu[8] = {u0[0], u0[1], u0[2], u0[3], u1[0], u1[1], u1[2], u1[3]};
                    E.apply_pair(u, r, c, vg, vu, in[m]); } }
            else if constexpr (HasRowJ<Epi>::value) {
#pragma unroll
                for (int mp = 0; mp < 4; mp += 2) { typename Epi::In in[2][2];
#pragma unroll
                    for (int m = 0; m < 2; ++m)
#pragma unroll
                        for (int bj = 0; bj < 2; ++bj) in[m][bj] = E.load(u, ai * HALF + wr * 64 + (mp + m) * 16 + fr, bj * HALF + c);
#pragma unroll
                    for (int m = 0; m < 2; ++m) { const int r = ai * HALF + wr * 64 + (mp + m) * 16 + fr; const f32x4 a0 = acc[ai][0][mp + m][0], a1 = acc[ai][0][mp + m][1], b0 = acc[ai][1][mp + m][0], b1 = acc[ai][1][mp + m][1];
                        const float v0[8] = {a0[0], a0[1], a0[2], a0[3], a1[0], a1[1], a1[2], a1[3]}, v1[8] = {b0[0], b0[1], b0[2], b0[3], b1[0], b1[1], b1[2], b1[3]};
                        E.apply2(u, r, c, v0, v1, in[m][0], in[m][1]); } } }
            else { typename Epi::In in[4][2];
#pragma unroll
                for (int m = 0; m < 4; ++m)
#pragma unroll
                    for (int bj = 0; bj < 2; ++bj) in[m][bj] = E.load(u, ai * HALF + wr * 64 + m * 16 + fr, bj * HALF + c);
#pragma unroll
                for (int m = 0; m < 4; ++m)
#pragma unroll
                    for (int bj = 0; bj < 2; ++bj) { const int r = ai * HALF + wr * 64 + m * 16 + fr; const f32x4 a0 = acc[ai][bj][m][0], a1 = acc[ai][bj][m][1];
                        const float v[8] = {a0[0], a0[1], a0[2], a0[3], a1[0], a1[1], a1[2], a1[3]}; E.apply(u, r, bj * HALF + c, v, in[m][bj]); } } }
    }
};

template <class Epi, class Sched, bool ALIGN_EPI, bool SP2>
__device__ __forceinline__ void gemm_phase(LAS unsigned char* lds, const GemmDims d, const Sched& S, const Epi& E, const int G, const int cidx) {
    int tid = threadIdx.x; asm volatile("" : "+v"(tid));
    const int wid = __builtin_amdgcn_readfirstlane(tid >> 6), lane = tid & 63, wr = wid >> 2, wc = wid & 3, fr = lane & 15, fq = lane >> 4;
    const int K = d.K, nt = K / BK;
    unsigned voffB[2]; int RA[2], CA2[2];
#pragma unroll
    for (int i = 0; i < 2; ++i) { int R, C; stage_rc(tid * 16 + i * 8192, R, C); const int Rb = Epi::PERM ? ((R & ~31) + perm32(R & 31)) : R;
        RA[i] = R; CA2[i] = C * 2; voffB[i] = (unsigned)(Rb * d.ldb + C) * 2u; }
    const size_t kstep = (size_t)(BK * 2);
    const size_t hstepB = (size_t)HALF * d.ldb * 2;
#define PG8_AOFF(dst, unit) do { _Pragma("unroll") for (int h_ = 0; h_ < 2; ++h_) _Pragma("unroll") for (int i_ = 0; i_ < 2; ++i_) { \
        if constexpr (Sched::GATHER) dst[h_][i_] = S.rowoff(unit, h_ * HALF + RA[i_]) + (unsigned)CA2[i_]; else dst[h_][i_] = (unsigned)((h_ * HALF + RA[i_]) * d.lda) * 2u + (unsigned)CA2[i_]; } } while (0)
    const unsigned ldsw = (unsigned)wid * 1024u;
    const int aoff = lds_byte(wr * 64 + fr, fq * 8), boff = lds_byte(wc * 32 + fr, fq * 8);
#define PG8_SA(b, h) (((b) * 2 + (h)) * HTB)
#define PG8_SB(b, h) ((4 + (b) * 2 + (h)) * HTB)
#define PG8_STAGE(bufoff, gbase, voff) do { _Pragma("unroll") for (int _i = 0; _i < 2; ++_i) \
        __builtin_amdgcn_global_load_lds((const unsigned*)((const char*)(gbase) + (voff)[_i]), (LAS unsigned*)(lds + (bufoff) + ldsw + _i * 8192), 16, 0, 0); } while (0)
#define PG8_LDA(dst, b, h) do { _Pragma("unroll") for (int m = 0; m < 4; ++m) _Pragma("unroll") for (int k = 0; k < 2; ++k) dst[m][k] = *(const LAS bf16x8*)(lds + PG8_SA(b, h) + aoff + m * 2048 + k * 1024); } while (0)
#define PG8_LDB(dst, b, h) do { _Pragma("unroll") for (int n = 0; n < 2; ++n) _Pragma("unroll") for (int k = 0; k < 2; ++k) dst[n][k] = *(const LAS bf16x8*)(lds + PG8_SB(b, h) + boff + n * 2048 + k * 1024); } while (0)
#define PG8_MMA(ai, bj, At, Bt) do { __builtin_amdgcn_s_setprio(1); _Pragma("unroll") for (int m = 0; m < 4; ++m) _Pragma("unroll") for (int n = 0; n < 2; ++n) _Pragma("unroll") for (int k = 0; k < 2; ++k) \
        acc[ai][bj][m][n] = __builtin_amdgcn_mfma_f32_16x16x32_bf16(Bt[n][k], At[m][k], acc[ai][bj][m][n], 0, 0, 0); __builtin_amdgcn_s_setprio(0); } while (0)
#define PG8_WAIT_V(n) asm volatile("s_waitcnt vmcnt(" #n ")" ::: "memory")
#define PG8_WAIT_L(n) asm volatile("s_waitcnt lgkmcnt(" #n ")" ::: "memory")
#define PG8_BAR __builtin_amdgcn_s_barrier()
#define PG8_SCHED __builtin_amdgcn_sched_barrier(0)
    UnitX cur, nxt; int ui = 0;
    if (!S.get(cidx, cur)) return;
    f32x4 acc[2][2][4][2];
#pragma unroll
    for (int a = 0; a < 2; ++a)
#pragma unroll
        for (int b = 0; b < 2; ++b)
#pragma unroll
            for (int m = 0; m < 4; ++m)
#pragma unroll
                for (int n = 0; n < 2; ++n) acc[a][b][m][n] = (f32x4){0.f, 0.f, 0.f, 0.f};
    bf16x8 At[4][2], B0[2][2], B1[2][2];
    const char* cA = cur.A; const char* cB = cur.B;
    constexpr int KS = Sched::KSPLIT;
    const char* cA2 = KS < 1024 ? cur.A2 : cA; const char* cB2 = KS < 1024 ? cur.B2 : cB;
    unsigned vA[2][2], nvA[2][2]; PG8_AOFF(vA, cur);
    static_assert(SP2, "this port keeps the SP2 loop only");
    {
        PG8_STAGE(PG8_SB(0, 0), cB, voffB); PG8_STAGE(PG8_SB(0, 1), cB + hstepB, voffB); PG8_STAGE(PG8_SA(0, 0), cA, vA[0]); PG8_STAGE(PG8_SA(0, 1), cA, vA[1]);
        if (wr == 1) PG8_BAR;
        PG8_WAIT_V(2); PG8_BAR;
        PG8_STAGE(PG8_SB(1, 0), cB + kstep, voffB); PG8_STAGE(PG8_SA(1, 0), cA + kstep, vA[0]); PG8_STAGE(PG8_SB(1, 1), cB + hstepB + kstep, voffB);
        PG8_WAIT_V(6); PG8_BAR;
    }
    for (;;) {
        const bool has_next = S.get((ui + 1) * G + cidx, nxt);
        const char* nA = has_next ? nxt.A : cA; const char* nB = has_next ? nxt.B : cB;
        if (has_next) { PG8_AOFF(nvA, nxt); } else {
#pragma unroll
            for (int h_ = 0; h_ < 2; ++h_)
#pragma unroll
                for (int i_ = 0; i_ < 2; ++i_) nvA[h_][i_] = vA[h_][i_]; }
        for (int t = 0; t < nt; t += 2) {
            const bool last = (t == nt - 2);
            if constexpr (Epi::MID) { if (t == KS) E.mid(acc, cur, wr, wc, fr, fq); }
            const char* a1 = ((t + 1 >= KS) ? cA2 : cA) + (size_t)(t + 1) * kstep;
            const char* a2 = last ? nA : ((t + 2 >= KS) ? cA2 : cA) + (size_t)(t + 2) * kstep; const char* b2 = last ? nB : ((t + 2 >= KS) ? cB2 : cB) + (size_t)(t + 2) * kstep;
            const char* a3 = a2 + kstep; const char* b3 = b2 + kstep;
            unsigned wA0[2], wA1[2];
#pragma unroll
            for (int i_ = 0; i_ < 2; ++i_) { wA0[i_] = last ? nvA[0][i_] : vA[0][i_]; wA1[i_] = last ? nvA[1][i_] : vA[1][i_]; }
            PG8_LDB(B0, 0, 0); PG8_LDB(B1, 0, 1); PG8_SCHED; PG8_LDA(At, 0, 0); PG8_STAGE(PG8_SA(1, 1), a1, vA[1]);
            PG8_WAIT_V(8); PG8_WAIT_L(0); PG8_BAR; PG8_MMA(0, 0, At, B0); PG8_MMA(0, 1, At, B1); PG8_BAR; PG8_SCHED;
            PG8_LDA(At, 0, 1); PG8_STAGE(PG8_SB(0, 0), b2, voffB); PG8_STAGE(PG8_SB(0, 1), b2 + hstepB, voffB); PG8_STAGE(PG8_SA(0, 0), a2, wA0);
            PG8_WAIT_V(8); PG8_WAIT_L(0); PG8_BAR; PG8_MMA(1, 0, At, B0); PG8_MMA(1, 1, At, B1); PG8_BAR; PG8_SCHED;
            PG8_LDB(B0, 1, 0); PG8_LDB(B1, 1, 1); PG8_SCHED; PG8_LDA(At, 1, 0); PG8_STAGE(PG8_SA(0, 1), a2, wA1);
            PG8_WAIT_V(8); PG8_WAIT_L(0); PG8_BAR; PG8_MMA(0, 0, At, B0); PG8_MMA(0, 1, At, B1); PG8_BAR; PG8_SCHED;
            PG8_LDA(At, 1, 1); PG8_STAGE(PG8_SB(1, 0), b3, voffB); PG8_STAGE(PG8_SB(1, 1), b3 + hstepB, voffB); PG8_STAGE(PG8_SA(1, 0), a3, wA0);
            PG8_WAIT_V(8); PG8_WAIT_L(0); PG8_BAR; PG8_MMA(1, 0, At, B0); PG8_MMA(1, 1, At, B1); PG8_BAR; PG8_SCHED;
        }
        if constexpr (ALIGN_EPI) { if (wr == 0) PG8_BAR; }
        E(acc, cur, wr, wc, fr, fq);
        if (!has_next) break;
#pragma unroll
        for (int a = 0; a < 2; ++a)
#pragma unroll
            for (int b = 0; b < 2; ++b)
#pragma unroll
                for (int m = 0; m < 4; ++m)
#pragma unroll
                    for (int n = 0; n < 2; ++n) acc[a][b][m][n] = (f32x4){0.f, 0.f, 0.f, 0.f};
        cur = nxt; cA = nA; cB = nB; ++ui; if constexpr (KS < 1024) { cA2 = cur.A2; cB2 = cur.B2; }
#pragma unroll
        for (int h_ = 0; h_ < 2; ++h_)
#pragma unroll
            for (int i_ = 0; i_ < 2; ++i_) vA[h_][i_] = nvA[h_][i_];
        if constexpr (ALIGN_EPI) { if (wr == 1) PG8_BAR; }
    }
    PG8_WAIT_V(0);
    if constexpr (!ALIGN_EPI) { if (wr == 0) PG8_BAR; }
    PG8_BAR;
#undef PG8_SA
#undef PG8_SB
#undef PG8_STAGE
#undef PG8_LDA
#undef PG8_LDB
#undef PG8_MMA
#undef PG8_WAIT_V
#undef PG8_WAIT_L
#undef PG8_BAR
#undef PG8_SCHED
#undef PG8_AOFF
}
}
template <class Sched, class Epi> __device__ __forceinline__ void run_gemm(LAS unsigned char* lds, const GemmDims d, const Sched& S, const Epi& E) {
    pg8::EpiAdapt<Epi> EA{E};
    pg8::gemm_phase<pg8::EpiAdapt<Epi>, Sched, true, true>(lds, d, S, EA, (int)gridDim.x, (int)blockIdx.x);
}

constexpr int NWAVES = 8, NTHR = 512;
constexpr int LDS_BYTES = 163840;
constexpr int RING_BYTES = 131072;
constexpr int CW_GCNT = 9216;
constexpr int BIAS_OFF = 139264;
constexpr int RT_OFF = RING_BYTES + 4096;
static_assert(RT_OFF + 40 * RT_ROWB <= LDS_BYTES, "router table fits");
constexpr int TT_OFF = RING_BYTES + 1024;

struct Frame { LAS unsigned char* lds; int tid, lane, wave, vcu, G; };
#define LAUNDER(F) do { (F).tid = (int)threadIdx.x; (F).lane = (int)threadIdx.x & 63; asm volatile("" : "+v"((F).tid), "+v"((F).lane)); } while (0)

__device__ __forceinline__ void transpose_item(const float* W, int ldw, int k0, int scol0, bf16* WT, int ldd, int drow0, int dcol0, LAS float* scr, int lane, bf16* WT2 = nullptr, int dcol2 = 0, bf16* WT3 = nullptr, int dcol3 = 0, const float* ks = nullptr) {
    { f32x4 t[8];
#pragma unroll
        for (int i = 0; i < 8; ++i) t[i] = *(const f32x4*)(W + (size_t)(k0 + 8 * i + (lane >> 3)) * ldw + scol0 + (lane & 7) * 4);
        if (ks) { float sc[8];
#pragma unroll
            for (int i = 0; i < 8; ++i) sc[i] = ks[k0 + 8 * i + (lane >> 3)];
#pragma unroll
            for (int i = 0; i < 8; ++i) t[i] = t[i] * sc[i]; }
#pragma unroll
        for (int i = 0; i < 8; ++i) { LAS float* d = scr + (8 * i + (lane >> 3)) * 33 + (lane & 7) * 4; d[0] = t[i].x; d[1] = t[i].y; d[2] = t[i].z; d[3] = t[i].w; } }
    asm volatile("s_waitcnt lgkmcnt(0)" ::: "memory");
    const int c = lane & 7;
#pragma unroll
    for (int j = 0; j < 4; ++j) { const int n = (lane >> 3) + 8 * j; const LAS float* s = scr + (8 * c) * 33 + n;
        u32x4 o; o.x = pk2(s[0 * 33], s[1 * 33]); o.y = pk2(s[2 * 33], s[3 * 33]); o.z = pk2(s[4 * 33], s[5 * 33]); o.w = pk2(s[6 * 33], s[7 * 33]);
        *(u32x4*)(WT + (size_t)(drow0 + n) * ldd + dcol0 + k0 + 8 * c) = o;
        if (WT2) *(u32x4*)(WT2 + (size_t)(drow0 + n) * ldd + dcol2 + k0 + 8 * c) = o;
        if (WT3) *(u32x4*)(WT3 + (size_t)(drow0 + n) * ldd + dcol3 + k0 + 8 * c) = o; }
    asm volatile("s_waitcnt lgkmcnt(0)" ::: "memory");
}

__device__ __forceinline__ void p0_weights(const Frame& Fin_, const Params& P, const int part) {
    Frame F = Fin_; LAUNDER(F);
    LAS float* scr = (LAS float*)(F.lds + F.wave * 16384);
    unsigned char* ws = P.ws;
    constexpr int I_IN = 16 * 128, I_OA = 8 * 32, I_GLU = 8 * 16, I_OB = 8 * 32, I_O = 16 * 32, I_G = 16 * 16 * 8, I_U = I_G, I_D = 16 * 4 * 32;
    constexpr int NEARLY = I_IN + I_OA + I_GLU + I_OB + I_O, NITEMS = NEARLY + I_G + I_U + I_D;
    const int gw = part == 0 ? F.vcu * NWAVES + F.wave : ((int)blockIdx.x - 128) * NWAVES + F.wave, NGW = part == 0 ? F.G * NWAVES : (F.G - 128) * NWAVES;
    for (int it = (part == 0 ? 0 : NEARLY) + gw; it < (part == 0 ? NEARLY : NITEMS); it += NGW) {
        int r = it;
        if (r < I_IN) { const int kb = r / 128, nb = r % 128, n0 = nb * 32; transpose_item(P.in[2], WIN_LD, kb * 64, n0 + (n0 >= 1536 ? 8 : 0), (bf16*)(ws + WS_WIN), 1024, n0, 0, scr, F.lane); continue; } r -= I_IN;
        if (r < I_OA) { const int kb = r / 32, nb = r % 32; transpose_item(P.in[5], 1024, kb * 64, nb * 32, (bf16*)(ws + WS_WOA), 512, nb * 32, 0, scr, F.lane); continue; } r -= I_OA;
        if (r < I_GLU) { const int kb = r / 16, nb = r % 16; transpose_item(P.in[14], 512, kb * 64, nb * 32, (bf16*)(ws + WS_WGLU), 512, nb * 32, 0, scr, F.lane); continue; } r -= I_GLU;
        if (r < I_OB) { const int kb = r / 32, nb = r % 32; transpose_item(P.in[16], 1024, kb * 64, nb * 32, (bf16*)(ws + WS_WOB), 512, nb * 32, 0, scr, F.lane); continue; } r -= I_OB;
        if (r < I_O) { const int kb = r / 32, nb = r % 32; transpose_item(P.in[17], 1024, kb * 64, nb * 32, (bf16*)(ws + WS_WO), 1024, nb * 32, 0, scr, F.lane); continue; } r -= I_O;
        if (r < I_G + I_U) { const int isup = r >= I_G; if (isup) r -= I_G; const int e = r / 128, rr = r % 128, kb = rr / 8, nb = rr % 8, j0 = nb * 32;
            const float* W = (isup ? P.in[24] : P.in[23]) + (size_t)e * 1024 * 256;
            transpose_item(W, 256, kb * 64, j0, (bf16*)(ws + WS_WGU) + (size_t)e * 512 * 1024, 1024, (j0 >> 7) * 256 + isup * 128 + (j0 & 127), 0, scr, F.lane, nullptr, 0, nullptr, 0, P.in[18]); continue; } r -= I_G + I_U;
        { const int e = r / 128, r2 = r % 128, kb = r2 / 32, nb = r2 % 32; const int grp = e >> 2, j = e & 3;
            bf16* dst[3]; int dcol[3]; int nd = 0;
#pragma unroll
            for (int o = 0; o < 4; ++o) if (o != j) { const int a = o < j ? o : j, b = o < j ? j : o; dst[nd] = (bf16*)(ws + WS_WD) + (size_t)(grp * 6 + pair_idx(a, b)) * 1024 * 512; dcol[nd] = (j == a) ? 0 : 256; ++nd; }
            transpose_item(P.in[25] + (size_t)e * 256 * 1024, 1024, kb * 64, nb * 32, dst[0], 512, nb * 32, dcol[0], scr, F.lane, dst[1], dcol[1], dst[2], dcol[2]); }
    }
}

__device__ __forceinline__ void p0_stage_wf(const Frame& Fin_, const Params& P) {
    Frame F = Fin_; LAUNDER(F);
    LAS float* WfT = (LAS float*)F.lds; const float* win = P.in[2];
    for (int k = F.tid; k < DM; k += NTHR) { const float* wr = win + (size_t)k * WIN_LD + 1536; const f32x4 w0 = *(const f32x4*)wr, w1 = *(const f32x4*)(wr + 4);
        WfT[0 * DM + k] = w0.x; WfT[1 * DM + k] = w0.y; WfT[2 * DM + k] = w0.z; WfT[3 * DM + k] = w0.w; WfT[4 * DM + k] = w1.x; WfT[5 * DM + k] = w1.y; WfT[6 * DM + k] = w1.z; WfT[7 * DM + k] = w1.w; }
    __syncthreads();
}
__device__ __forceinline__ void p0_row2(const Frame& F, const Params& P, int m0, int m1, f32x4 (&v)[2][4]) {
    const float* gmix = P.in[1]; const float* bf = P.in[3];
    const LAS f32x4* WfT = (const LAS f32x4*)F.lds;
    float rs[2]; const int mm[2] = {m0, m1};
#pragma unroll
    for (int q = 0; q < 2; ++q) { float ss = 0.f;
#pragma unroll
        for (int j = 0; j < 4; ++j) ss += (v[q][j].x * v[q][j].x + v[q][j].y * v[q][j].y) + (v[q][j].z * v[q][j].z + v[q][j].w * v[q][j].w);
        rs[q] = 1.0f / sqrtf(wave_sum(ss) * (1.0f / DM) + EPS); }
    float f[2][8];
#pragma unroll
    for (int q = 0; q < 2; ++q)
#pragma unroll
        for (int h = 0; h < 8; ++h) f[q][h] = 0.f;
#pragma unroll
    for (int j = 0; j < 4; ++j) { const f32x4 g = ((const f32x4*)gmix)[F.lane + 64 * j];
#pragma unroll
        for (int q = 0; q < 2; ++q) { v[q][j] = v[q][j] * rs[q] * g; u32x2 w; w.x = pk2(v[q][j].x, v[q][j].y); w.y = pk2(v[q][j].z, v[q][j].w);
            ((u32x2*)((bf16*)(P.ws + WS_XN) + (size_t)mm[q] * DM) + F.lane)[64 * j] = w; }
#pragma unroll
        for (int h = 0; h < 8; ++h) { const f32x4 wv = WfT[h * (DM / 4) + 64 * j + F.lane];
#pragma unroll
            for (int q = 0; q < 2; ++q) f[q][h] += (v[q][j].x * wv.x + v[q][j].y * wv.y) + (v[q][j].z * wv.z + v[q][j].w * wv.w); } }
    const bool b5 = (F.lane & 32) != 0, b4 = (F.lane & 16) != 0, b3 = (F.lane & 8) != 0;
#pragma unroll
    for (int q = 0; q < 2; ++q) { float r4[4], r2[2], r1;
#pragma unroll
        for (int i = 0; i < 4; ++i) { const float keep = b5 ? f[q][i + 4] : f[q][i], send = b5 ? f[q][i] : f[q][i + 4]; r4[i] = keep + __shfl_xor(send, 32); }
#pragma unroll
        for (int i = 0; i < 2; ++i) { const float keep = b4 ? r4[i + 2] : r4[i], send = b4 ? r4[i] : r4[i + 2]; r2[i] = keep + __shfl_xor(send, 16); }
        { const float keep = b3 ? r2[1] : r2[0], send = b3 ? r2[0] : r2[1]; r1 = keep + __shfl_xor(send, 8); }
        r1 += __shfl_xor(r1, 4); r1 += __shfl_xor(r1, 2); r1 += __shfl_xor(r1, 1);
        if ((F.lane & 7) == 0) { const int h = (b5 ? 4 : 0) + (b4 ? 2 : 0) + (b3 ? 1 : 0); const float val = r1 + bf[h]; const float xe = __expf(-fabsf(val)); const float ls = fminf(val, 0.f) - (xe < 1e-3f ? xe * (1.0f - 0.5f * xe) : __logf(1.0f + xe));
            const int b = mm[q] / SEQ, s = mm[q] % SEQ; ((float*)(P.ws + WS_LF))[((size_t)b * NH + h) * SEQ + s] = ls * LOG2E; } }
}

__device__ __forceinline__ void p0_ssm_group(const Frame& Fin_, const Params& P, int g, int part) {
    Frame F = Fin_; LAUNDER(F);
    typedef float f32x2 __attribute__((ext_vector_type(2)));
    constexpr int CMS = 65;
    LAS f32x2* AP = (LAS f32x2*)(F.lds);
    LAS f32x2* CM = (LAS f32x2*)(F.lds + 33 * 64 * 8);
    LAS f32x2* BB = (LAS f32x2*)(F.lds + 33 * 64 * 8 + 16 * CMS * 8);
    LAS float* KT = (LAS float*)(F.lds + 33 * 64 * 8 + 16 * CMS * 8 + 8192);
    const float* lre = P.in[6]; const float* lim = P.in[7]; const float* lstep = P.in[8]; const float* bre = P.in[9]; const float* bim = P.in[10];
    const float* cre = P.in[11]; const float* cim = P.in[12]; const float* dsk = P.in[13];
    const float dtf = expf(lstep[g]);
    if (F.tid < 64) { const int p = F.tid; const double dt = (double)dtf, lr = (double)lre[g * 64 + p], li = (double)lim[g * 64 + p];
        const double mg = exp(lr * dt), ph = li * dt; const double a1r = mg * cos(ph), a1i = mg * sin(ph); double ar = 1.0, ai = 0.0;
        for (int d = 0; d <= LCH; ++d) { AP[d * 64 + p] = (f32x2){(float)ar, (float)ai}; const double nr = ar * a1r - ai * a1i, ni = ar * a1i + ai * a1r; ar = nr; ai = ni; } }
    for (int idx = F.tid; idx < 1024; idx += NTHR) { { const int o = idx >> 6, p = idx & 63; CM[o * CMS + p] = (f32x2){cre[(g * 16 + o) * 64 + p], cim[(g * 16 + o) * 64 + p]}; }
        { const int p = idx >> 4, c = idx & 15; const float lr = lre[g * 64 + p], li = lim[g * 64 + p];
          const float mag = expf(lr * dtf); float sn, cs; sincosf(li * dtf, &sn, &cs); const float are = mag * cs, aim = mag * sn, den = lr * lr + li * li, nre = are - 1.0f;
          const float zre = (nre * lr + aim * li) / den, zim = (aim * lr - nre * li) / den; const float br = bre[(g * 64 + p) * 16 + c], bi = bim[(g * 64 + p) * 16 + c];
          BB[idx] = (f32x2){zre * br - zim * bi, zre * bi + zim * br}; } }
    __syncthreads();
    { const int d = F.tid >> 4, o = F.tid & 15; float acc[16];
#pragma unroll
        for (int c = 0; c < 16; ++c) acc[c] = 0.f;
#pragma unroll 4
        for (int p = 0; p < 64; ++p) { const f32x2 a = AP[d * 64 + p], cm = CM[o * CMS + p]; const float car = cm.x * a.x - cm.y * a.y, cai = cm.x * a.y + cm.y * a.x;
#pragma unroll
            for (int c = 0; c < 16; ++c) { const f32x2 bb = BB[p * 16 + c]; acc[c] += car * bb.x - cai * bb.y; } }
        if (d == 0) acc[o] += dsk[g * 16 + o];
#pragma unroll
        for (int c = 0; c < 16; ++c) KT[(d * 16 + o) * 16 + c] = acc[c]; }
    __syncthreads();
    bf16* Mx = (bf16*)(P.ws + WS_MX) + (size_t)g * 512 * KY;
    for (int idx = F.tid; idx < 64 * 80; idx += NTHR) { const int n = part * 64 + idx / 80, k0 = (idx % 80) * 8, j = n >> 4, o = n & 15; float v[8];
        if (k0 < 512) { const int i = k0 >> 4, c0 = k0 & 15;
#pragma unroll
            for (int e = 0; e < 8; ++e) v[e] = (i <= j) ? KT[((j - i) * 16 + o) * 16 + c0 + e] : 0.f; }
        else { const int kk = k0 - 512, ri = kk >> 6, p0 = kk & 63;
#pragma unroll
            for (int e = 0; e < 8; ++e) { const f32x2 a = AP[(j + 1) * 64 + p0 + e], cm = CM[o * CMS + p0 + e]; v[e] = ri == 0 ? (cm.x * a.x - cm.y * a.y) : -(cm.x * a.y + cm.y * a.x); } }
        store8(Mx + (size_t)n * KY + k0, v); }
    bf16* Ws = (bf16*)(P.ws + WS_WS) + (size_t)g * 128 * 512;
    for (int idx = F.tid; idx < 16 * 64; idx += NTHR) { const int n = part * 16 + (idx >> 6), k0 = (idx & 63) * 8, ri = n >> 6, p = n & 63, i = k0 >> 4, c0 = k0 & 15; float v[8]; const f32x2 a = AP[(LCH - 1 - i) * 64 + p];
#pragma unroll
        for (int e = 0; e < 8; ++e) { const f32x2 bb = BB[p * 16 + c0 + e]; v[e] = ri == 0 ? (a.x * bb.x - a.y * bb.y) : (a.x * bb.y + a.y * bb.x); }
        store8(Ws + (size_t)n * 512 + k0, v); }
    if (part == 0 && F.tid < 64) { const f32x2 a = AP[LCH * 64 + F.tid]; float* AL = (float*)(P.ws + WS_AL) + (g * 64 + F.tid) * 2; AL[0] = a.x; AL[1] = a.y; }
    __syncthreads();
}

constexpr unsigned REP_PRO = 0u;
__device__ __forceinline__ void p0_prologue(const Frame& Fin_, const Params& P) {
    Frame F = Fin_; LAUNDER(F);
    for (int r_ = 0; r_ < 1 + (int)(REP_PRO & 1u); ++r_) p0_ssm_group(F, P, F.vcu >> 3, F.vcu & 7);
    for (int r_ = 0; r_ < 1 + (int)((REP_PRO >> 1) & 1u); ++r_) { p0_weights(F, P, 0); __syncthreads(); }
    p0_stage_wf(F, P);
    const int gw = F.vcu * NWAVES + F.wave, NGW = F.G * NWAVES;
    for (int r_ = 0; r_ < 1 + (int)((REP_PRO >> 2) & 1u); ++r_) {
        f32x4 nv[2][4];
#pragma unroll
        for (int q = 0; q < 2; ++q)
#pragma unroll
            for (int j = 0; j < 4; ++j) nv[q][j] = ((const f32x4*)(P.in[0] + (size_t)(gw + q * NGW) * DM) + F.lane)[64 * j];
        for (int m = gw; m < T; m += 2 * NGW) { f32x4 v[2][4];
#pragma unroll
            for (int q = 0; q < 2; ++q)
#pragma unroll
                for (int j = 0; j < 4; ++j) v[q][j] = nv[q][j];
            if (m + 2 * NGW < T) {
#pragma unroll
                for (int q = 0; q < 2; ++q)
#pragma unroll
                    for (int j = 0; j < 4; ++j) nv[q][j] = ((const f32x4*)(P.in[0] + (size_t)(m + (2 + q) * NGW) * DM) + F.lane)[64 * j]; }
            p0_row2(F, P, m, m + NGW, v); } }
}

__device__ __forceinline__ void p_cumsum(const Frame& Fin_, const Params& P) {
    Frame F = Fin_; LAUNDER(F);
    LAS float* part = (LAS float*)F.lds;
    for (int seq = (int)blockIdx.x - 128; seq < BATCH * NH; seq += 32) {
        const float* src = (const float*)(P.ws + WS_LF) + (size_t)seq * SEQ + F.tid * 16; float* dst = (float*)(P.ws + WS_CK2) + (size_t)seq * SEQ + F.tid * 16;
        float v[16]; float s = 0.f;
#pragma unroll
        for (int j = 0; j < 4; ++j) { const f32x4 t = ((const f32x4*)src)[j]; v[4 * j] = t.x; v[4 * j + 1] = t.y; v[4 * j + 2] = t.z; v[4 * j + 3] = t.w; }
#pragma unroll
        for (int j = 0; j < 16; ++j) { s += v[j]; v[j] = s; }
        __syncthreads();
        part[F.tid] = s; __syncthreads();
        if (F.tid == 0) { float run = 0.f; for (int i = 0; i < NTHR; ++i) { const float t = part[i]; part[i] = run; run += t; } }
        __syncthreads();
        const float base = part[F.tid];
#pragma unroll
        for (int j = 0; j < 4; ++j) ((f32x4*)dst)[j] = (f32x4){v[4 * j] + base, v[4 * j + 1] + base, v[4 * j + 2] + base, v[4 * j + 3] + base};
    }
}

constexpr int CARRY_WGS = BATCH * SG;
__device__ __forceinline__ void p_carry(const Frame& Fin_, const Params& P) {
    Frame F = Fin_; LAUNDER(F);
    const int cb = (int)blockIdx.x; if (cb >= CARRY_WGS) return;
    typedef float f32x2 __attribute__((ext_vector_type(2)));
    const int b = cb & 3, g = cb >> 2, p = F.lane, seg = F.wave;
    const float* AL = (const float*)(P.ws + WS_AL) + (g * 64 + p) * 2; const float ar = AL[0], ai = AL[1];
    const float* S = (const float*)(P.ws + WS_S) + ((size_t)g * NCH + b * NCHB + seg * 32) * 128 + p;
    bf16* UH = (bf16*)(P.ws + WS_UH) + ((size_t)g * NCH + b * NCHB + seg * 32) * KY + 512 + p;
    float sr[32], si[32];
#pragma unroll
    for (int n = 0; n < 32; ++n) { sr[n] = S[(size_t)n * 128]; si[n] = S[(size_t)n * 128 + 64]; }
    float a32r = ar, a32i = ai;
#pragma unroll
    for (int k = 0; k < 5; ++k) { const float nr = a32r * a32r - a32i * a32i, ni = 2.0f * a32r * a32i; a32r = nr; a32i = ni; }
    float er = 0.f, ei = 0.f;
#pragma unroll
    for (int n = 0; n < 32; ++n) { const float nr = ar * er - ai * ei + sr[n], ni = ar * ei + ai * er + si[n]; er = nr; ei = ni; }
    LAS f32x2* EX = (LAS f32x2*)F.lds;
    EX[seg * 64 + p] = (f32x2){er, ei};
    __syncthreads();
    float hr = 0.f, hi = 0.f;
    for (int s = 0; s < seg; ++s) { const f32x2 e = EX[s * 64 + p]; const float nr = a32r * hr - a32i * hi + e.x, ni = a32r * hi + a32i * hr + e.y; hr = nr; hi = ni; }
#pragma unroll
    for (int n = 0; n < 32; ++n) { UH[(size_t)n * KY] = (bf16)f2bf(hr); UH[(size_t)n * KY + 64] = (bf16)f2bf(hi);
        const float nr = ar * hr - ai * hi + sr[n], ni = ar * hi + ai * hr + si[n]; hr = nr; hi = ni; }
    __syncthreads();
}

__device__ __forceinline__ void p_router(const Frame& Fin_, const Params& P, const bool publish = true) {
    Frame F = Fin_; LAUNDER(F);
    const float* brg = P.in[20]; const float* bre_ = P.in[22];
    LAS f32x4* LOG = (LAS f32x4*)F.lds;
    LAS int* hist = (LAS int*)(F.lds + 4 * 128 * 96);
    LAS int* tcl = hist + 64;
    LAS int* tlr = tcl + 128;
    LAS float* twa = (LAS float*)(tlr + 128);
    if (F.tid < NCLS) hist[F.tid] = 0;
    const int tok0 = F.vcu * (T / 256);
    { const int t = F.tid & 127, qt = F.tid >> 7;
      const f32x4* pp = (const f32x4*)(P.ws + WS_PART) + ((size_t)(qt * 4 * 6) * T + tok0 + t);
      f32x4 v[4][6];
#pragma unroll
      for (int q = 0; q < 4; ++q)
#pragma unroll
          for (int j = 0; j < 6; ++j) v[q][j] = pp[(size_t)(q * 6 + j) * T];
#pragma unroll
      for (int j = 0; j < 6; ++j) LOG[(qt * 128 + t) * 6 + j] = (v[0][j] + v[1][j]) + (v[2][j] + v[3][j]); }
    __syncthreads();
    if (F.tid < T / 256) { const int t = F.tid;
        float lgt[24];
#pragma unroll
        for (int j = 0; j < 6; ++j) { const f32x4 a = (LOG[t * 6 + j] + LOG[(128 + t) * 6 + j]) + (LOG[(256 + t) * 6 + j] + LOG[(384 + t) * 6 + j]); lgt[4 * j] = a.x; lgt[4 * j + 1] = a.y; lgt[4 * j + 2] = a.z; lgt[4 * j + 3] = a.w; }
        const float rs = 1.0f / sqrtf(lgt[20] * (1.0f / DM) + EPS);
#pragma unroll
        for (int e = 0; e < 20; ++e) lgt[e] *= rs;
        const float l0 = lgt[0] + brg[0], l1 = lgt[1] + brg[1], l2 = lgt[2] + brg[2], l3 = lgt[3] + brg[3];
        int gi = 0; float mx = l0; if (l1 > mx) { mx = l1; gi = 1; } if (l2 > mx) { mx = l2; gi = 2; } if (l3 > mx) { mx = l3; gi = 3; }
        const float psel = 1.0f / (expf(l0 - mx) + expf(l1 - mx) + expf(l2 - mx) + expf(l3 - mx));
        float le[4];
#pragma unroll
        for (int k = 0; k < 4; ++k) { const float c0 = lgt[4 + k] + bre_[k], c1 = lgt[8 + k] + bre_[4 + k], c2 = lgt[12 + k] + bre_[8 + k], c3 = lgt[16 + k] + bre_[12 + k]; le[k] = gi == 0 ? c0 : (gi == 1 ? c1 : (gi == 2 ? c2 : c3)); }
        int i0 = 0; float v0 = le[0]; if (le[1] > v0) { v0 = le[1]; i0 = 1; } if (le[2] > v0) { v0 = le[2]; i0 = 2; } if (le[3] > v0) { v0 = le[3]; i0 = 3; }
        int i1 = -1; float v1 = -INFINITY;
#pragma unroll
        for (int k = 0; k < 4; ++k) if (k != i0 && le[k] > v1) { v1 = le[k]; i1 = k; }
        const float e1 = expf(v1 - v0), w0 = psel / (1.0f + e1), w1 = psel * e1 / (1.0f + e1);
        const int a = i0 < i1 ? i0 : i1, bb = i0 < i1 ? i1 : i0; const float wa = i0 < i1 ? w0 : w1, wb = i0 < i1 ? w1 : w0;
        const int cls = gi * 6 + pair_idx(a, bb);
        tcl[t] = cls; twa[4 * t] = wa; twa[4 * t + 1] = wb; twa[4 * t + 2] = rs; tlr[t] = atomicAdd((int*)&hist[cls], 1); }
    __syncthreads();
    if (!publish) return;
    if (F.tid < NCLS) hist[32 + F.tid] = (int)__hip_atomic_fetch_add((unsigned*)(P.ws + WS_CTL) + CW_GCNT + F.tid, (unsigned)hist[F.tid], __ATOMIC_RELAXED, __HIP_MEMORY_SCOPE_AGENT);
    __syncthreads();
    if (F.tid < T / 256) { const int cls = tcl[F.tid], pos = hist[32 + cls] + tlr[F.tid]; const size_t li = (size_t)cls * T + pos;
        ((int*)(P.ws + WS_LIST))[li] = tok0 + F.tid; ((int*)(P.ws + WS_TPOS))[tok0 + F.tid] = (cls << 16) | pos; *((f32x4*)(P.ws + WS_LPW) + li) = (f32x4){twa[4 * F.tid], twa[4 * F.tid + 1], twa[4 * F.tid + 2], 0.f}; }
    __syncthreads();
}

__device__ __forceinline__ void stage_router_table(const Frame& Fin_, const Params& P, const int pn) {
    Frame F = Fin_; LAUNDER(F);
    const float* gffn = P.in[18]; const float* wrg = P.in[19]; const float* wre = P.in[21];
    LAS unsigned char* TH = F.lds + RT_OFF; LAS unsigned char* TL = TH + 20 * RT_ROWB;
    for (int idx = F.tid; idx < 20 * 256; idx += NTHR) { const int n = idx >> 8, kc = idx & 255, k = pn * 256 + kc; const float w = (n < 4 ? wrg[(size_t)k * 4 + n] : wre[(size_t)k * 16 + (n - 4)]) * gffn[k];
        const unsigned h = f2bf(w); const unsigned l = f2bf(w - bf2f(h)); *(LAS bf16*)(TH + n * RT_ROWB + kc * 2) = (bf16)h; *(LAS bf16*)(TL + n * RT_ROWB + kc * 2) = (bf16)l; }
    __syncthreads();
}

__device__ __forceinline__ void moe_tile_table(const Frame& Fin_, const Params& P) {
    Frame F = Fin_; LAUNDER(F);
    LAS int* tt = (LAS int*)(F.lds + TT_OFF);
    if (F.tid < NCLS) tt[512 + F.tid] = (int)__hip_atomic_load((unsigned*)(P.ws + WS_CTL) + CW_GCNT + F.tid, __ATOMIC_RELAXED, __HIP_MEMORY_SCOPE_AGENT);
    __syncthreads();
    if (F.tid < MAXTILES) { int base = 0, cls = -1, tic = 0;
        for (int c = 0; c < NCLS; ++c) { const int nt = (tt[512 + c] + 255) >> 8; if (F.tid == 0) tt[544 + c] = base; if (cls < 0 && F.tid < base + nt) { cls = c; tic = F.tid - base; } base += nt; }
        if (F.tid == 0) tt[568] = base;
        tt[2 * F.tid] = cls; tt[2 * F.tid + 1] = tic; }
    __syncthreads();
}


__device__ __forceinline__ void p_final(const Frame& Fin_, const Params& P) {
    Frame F = Fin_; LAUNDER(F);
    const float* gf = P.in[26]; const bf16* Y = (const bf16*)(P.ws + WS_Y); const bf16* X1B = (const bf16*)(P.ws + WS_H2); const int* TPOS = (const int*)(P.ws + WS_TPOS); const LAS int* tt = (const LAS int*)(F.lds + TT_OFF);
    const int gw = F.vcu * NWAVES + F.wave, NGW = F.G * NWAVES;
    u32x2 nx[4], ny[4]; int tp1 = TPOS[gw], tp2 = (gw + NGW < T) ? TPOS[gw + NGW] : 0;
    { const size_t yr = (size_t)tt[544 + (tp1 >> 16)] * 256 + (tp1 & 0xffff);
#pragma unroll
      for (int j = 0; j < 4; ++j) { nx[j] = ((const u32x2*)(X1B + (size_t)gw * DM) + F.lane)[64 * j]; ny[j] = ((const u32x2*)(Y + yr * DM) + F.lane)[64 * j]; } }
    for (int m = gw; m < T; m += NGW) { f32x4* xr = (f32x4*)(P.out + (size_t)m * DM) + F.lane; f32x4 v[4]; float ss = 0.f;
#pragma unroll
        for (int j = 0; j < 4; ++j) { const u32x2 x = nx[j], y = ny[j]; v[j] = (f32x4){bf2f(x.x & 0xffffu), bf2f(x.x >> 16), bf2f(x.y & 0xffffu), bf2f(x.y >> 16)} + (f32x4){bf2f(y.x & 0xffffu), bf2f(y.x >> 16), bf2f(y.y & 0xffffu), bf2f(y.y >> 16)};
            ss += (v[j].x * v[j].x + v[j].y * v[j].y) + (v[j].z * v[j].z + v[j].w * v[j].w); }
        tp1 = tp2; if (m + 2 * NGW < T) tp2 = TPOS[m + 2 * NGW];
        if (m + NGW < T) { const size_t yr = (size_t)tt[544 + (tp1 >> 16)] * 256 + (tp1 & 0xffff);
#pragma unroll
            for (int j = 0; j < 4; ++j) { nx[j] = ((const u32x2*)(X1B + (size_t)(m + NGW) * DM) + F.lane)[64 * j]; ny[j] = ((const u32x2*)(Y + yr * DM) + F.lane)[64 * j]; } }
        const float rs = 1.0f / sqrtf(wave_sum(ss) * (1.0f / DM) + EPS);
#pragma unroll
        for (int j = 0; j < 4; ++j) { const f32x4 g = ((const f32x4*)gf)[F.lane + 64 * j]; xr[64 * j] = v[j] * rs * g; } }
}

namespace fox {
using bf16x8=__attribute__((ext_vector_type(8)))short;
using s16x4=__attribute__((ext_vector_type(4)))short;
using f32x16=__attribute__((ext_vector_type(16)))float;
using u32x4_=__attribute__((ext_vector_type(4)))unsigned;
using f32x4_=__attribute__((ext_vector_type(4)))float;
constexpr int D=64,DMP=512;
constexpr int NW=8,QBLK=32,QB=QBLK*NW,KVBLK=64;
__device__ __forceinline__ int crow(int r,int hi){return (r&3)+8*(r>>2)+4*hi;}
#define SBAR() __builtin_amdgcn_sched_barrier(0)
__device__ __forceinline__ void cmask(f32x16&p0,f32x16&p1,int jb,int qrel,int hi){
  const float NEG=-INFINITY; int d=qrel-64*jb-4*hi; asm volatile("":"+v"(d));
  #pragma unroll
  for(int r=0;r<16;++r){const int c=(r&3)+8*(r>>2); if(c>d)p0[r]=NEG; if(c+32>d)p1[r]=NEG;}
}
constexpr int NSLOT=3, SLOTB=8192;
constexpr int LDS_K=0, LDS_V=NSLOT*SLOTB, LDS_WS=2*NSLOT*SLOTB, LDS_OST=LDS_WS+NW*64*4, LDS_CK=LDS_OST+NW*4096, LDS_BYTES=LDS_CK+32768;
constexpr float PRUNE_X=40.0f;
__device__ __forceinline__ void glds16(const void*sbase,unsigned voff,unsigned lds_dst){unsigned keep;
  asm volatile("s_mov_b32 %0, m0\n\ts_mov_b32 m0, %3\n\ts_nop 0\n\tglobal_load_lds_dwordx4 %1, %2\n\ts_mov_b32 m0, %0":"=&s"(keep):"v"(voff),"s"(sbase),"s"(lds_dst):"memory");}
__device__ __forceinline__ float max3f(float a,float b,float c){float r;asm("v_max3_f32 %0, %1, %2, %3":"=v"(r):"v"(a),"v"(b),"v"(c));return r;}
__device__ __forceinline__ float max2f(float a,float b){float r;asm("v_max_f32_e32 %0, %1, %2":"=v"(r):"v"(a),"v"(b));return r;}
__device__ __forceinline__ float fadd_s(float a,float b){float r;asm("v_add_f32_e32 %0, %1, %2":"=v"(r):"v"(a),"v"(b));return r;}
__device__ __forceinline__ float fsub_s(float a,float b){float r;asm("v_sub_f32_e32 %0, %1, %2":"=v"(r):"v"(a),"v"(b));return r;}
typedef float f32x2_t __attribute__((ext_vector_type(2))); typedef __bf16 bf16x2_t __attribute__((ext_vector_type(2)));
__device__ __forceinline__ unsigned cvtpk_s(float lo,float hi){f32x2_t v={lo,hi};bf16x2_t b=__builtin_convertvector(v,bf16x2_t);return __builtin_bit_cast(unsigned,b);}
#define WAIT_BAR(N) asm volatile("s_waitcnt vmcnt(" #N ") lgkmcnt(0)\n\ts_barrier":::"memory")
typedef __attribute__((address_space(3))) const char* lds_cptr;
typedef short v4i16_t __attribute__((ext_vector_type(4)));
__device__ __forceinline__ void cinit(f32x16&p0,f32x16&p1,lds_cptr ckp,float nb){
  #pragma unroll
  for(int g=0;g<4;++g){ const f32x4_ a=*(const __attribute__((address_space(3))) f32x4_*)(ckp+g*32); const f32x4_ c=*(const __attribute__((address_space(3))) f32x4_*)(ckp+128+g*32);
    #pragma unroll
    for(int e=0;e<4;++e){p0[4*g+e]=nb-a[e];p1[4*g+e]=nb-c[e];} }
}
__device__ __forceinline__ void qkt(f32x16&p0,f32x16&p1,const char*Kslot,const bf16x8*qr,int r32,int hi){
  const char*kb=Kslot+hi*1024+r32*16;
  #pragma unroll
  for(int d0=0;d0<4;++d0){
    const bf16x8 b0=*reinterpret_cast<const bf16x8*>(kb+d0*2048);
    const bf16x8 b1=*reinterpret_cast<const bf16x8*>(kb+d0*2048+512);
    p0=__builtin_amdgcn_mfma_f32_32x32x16_bf16(b0,qr[d0],p0,0,0,0);p1=__builtin_amdgcn_mfma_f32_32x32x16_bf16(b1,qr[d0],p1,0,0,0);}
}
__device__ __forceinline__ void kload8(bf16x8*kf,lds_cptr kp){
  kf[0]=*(const __attribute__((address_space(3))) bf16x8*)(kp);      kf[1]=*(const __attribute__((address_space(3))) bf16x8*)(kp+512);
  kf[2]=*(const __attribute__((address_space(3))) bf16x8*)(kp+2048); kf[3]=*(const __attribute__((address_space(3))) bf16x8*)(kp+2560);
  kf[4]=*(const __attribute__((address_space(3))) bf16x8*)(kp+4096); kf[5]=*(const __attribute__((address_space(3))) bf16x8*)(kp+4608);
  kf[6]=*(const __attribute__((address_space(3))) bf16x8*)(kp+6144); kf[7]=*(const __attribute__((address_space(3))) bf16x8*)(kp+6656);
}
__device__ __forceinline__ void kload2(bf16x8*kf,lds_cptr kp,int j){ kf[2*j]=*(const __attribute__((address_space(3))) bf16x8*)(kp+j*2048); kf[2*j+1]=*(const __attribute__((address_space(3))) bf16x8*)(kp+j*2048+512); }
__device__ __forceinline__ s16x4 vtr(lds_cptr p){ return __builtin_bit_cast(s16x4,__builtin_amdgcn_ds_read_tr16_b64_v4i16((__attribute__((address_space(3))) v4i16_t*)p)); }
__device__ __forceinline__ float rowmax(const f32x16&p0,const f32x16&p1){
  float a=max3f(p0[0],p0[1],p1[0]),b=max3f(p0[2],p0[3],p1[1]);a=max3f(a,p1[2],p1[3]);
  #pragma unroll
  for(int r=4;r<16;r+=4){a=max3f(a,p0[r],p0[r+1]);b=max3f(b,p0[r+2],p0[r+3]);a=max3f(a,p1[r],p1[r+1]);b=max3f(b,p1[r+2],p1[r+3]);}
  const float m=max2f(a,b);
  auto rr=__builtin_amdgcn_permlane32_swap(__float_as_uint(m),__float_as_uint(m),false,false);
  return max2f(__uint_as_float(rr[0]),__uint_as_float(rr[1]));
}
__device__ __forceinline__ void pv(f32x16*o,int vb,bf16x8 pa0,bf16x8 pa1,bf16x8 pa2,bf16x8 pa3){
  #pragma unroll
  for(int d0=0;d0<2;++d0){s16x4 lo[4],hi[4];
    #pragma unroll
    for(int ks=0;ks<4;++ks){
      asm volatile("ds_read_b64_tr_b16 %0,%1 offset:%c2":"=&v"(lo[ks]):"v"(vb),"i"(d0*4096+ks*1024):"memory");
      asm volatile("ds_read_b64_tr_b16 %0,%1 offset:%c2":"=&v"(hi[ks]):"v"(vb),"i"(d0*4096+ks*1024+512):"memory");}
    asm volatile("s_waitcnt lgkmcnt(0)":::"memory");SBAR();
    #define PK(k) (bf16x8){lo[k][0],lo[k][1],lo[k][2],lo[k][3],hi[k][0],hi[k][1],hi[k][2],hi[k][3]}
    o[d0]=__builtin_amdgcn_mfma_f32_32x32x16_bf16(pa0,PK(0),o[d0],0,0,0);
    o[d0]=__builtin_amdgcn_mfma_f32_32x32x16_bf16(pa1,PK(1),o[d0],0,0,0);
    o[d0]=__builtin_amdgcn_mfma_f32_32x32x16_bf16(pa2,PK(2),o[d0],0,0,0);
    o[d0]=__builtin_amdgcn_mfma_f32_32x32x16_bf16(pa3,PK(3),o[d0],0,0,0);
    #undef PK
  }
}
struct Tensors { const bf16* Q; const bf16* K; const bf16* V; bf16* O; const float* CK2; const float* QN; const float* KN; };

template<int THRL> __device__ __forceinline__ void attn_unit(int b,int h,int qb,const Tensors&TT,char*shm){
  const bf16*Q=TT.Q; const bf16*__restrict__ K=TT.K; const bf16*__restrict__ V=TT.V; bf16*O=TT.O;
  int tid=threadIdx.x; asm volatile("":"+v"(tid));
  const int lane=tid&63,r32=lane&31,hi=lane>>5; const int wid=__builtin_amdgcn_readfirstlane(tid>>6);
  const long rowbase=(long)b*SEQ; const int q0=qb*QB; const int bh=b*NH+h;
  const float*ck=TT.CK2+(size_t)bh*SEQ;
  const int NTF=(q0+QB)/KVBLK;
  const bf16*Qw=Q+(rowbase+q0+wid*QBLK)*DMP+h*D;
  const bf16*Kh=K+rowbase*DMP+h*D,*Vh=V+rowbase*DMP+h*D;
  const unsigned lds0=(unsigned)(uintptr_t)shm;
  const unsigned koff=(unsigned)(lane*DMP+wid*8)*2u;
  const unsigned voff=(unsigned)((16*(wid&3)+(lane>>2))*DMP+(wid>>2)*32+(lane&3)*8)*2u;
  const unsigned kdst=lds0+LDS_K+wid*1024, vdst=lds0+LDS_V+wid*1024;
  #define TJ(t) (NTF-1-(t))
  #define DMA_K(t,slot) glds16(Kh+(long)TJ(t)*KVBLK*DMP,koff,(unsigned)__builtin_amdgcn_readfirstlane(kdst+(slot)))
  #define DMA_V(t,slot) glds16(Vh+(long)TJ(t)*KVBLK*DMP,voff,(unsigned)__builtin_amdgcn_readfirstlane(vdst+(slot)))
  DMA_K(0,0);DMA_V(0,0);DMA_K(1,SLOTB);DMA_K(2,2*SLOTB);
  float Bq; int jmin;
  { float qn=(lane<4)?TT.QN[bh*128+4*qb+lane]:0.f; float kn=0.f; if(lane<NTF)kn=TT.KN[bh*128+lane]; if(lane+64<NTF)kn=fmaxf(kn,TT.KN[bh*128+64+lane]);
    const float cq0=ck[q0]; const float c0=(lane<NTF)?ck[64*lane+63]:0.f, c1=(lane+64<NTF)?ck[64*(lane+64)+63]:0.f;
    #pragma unroll
    for(int o_=1;o_<64;o_<<=1){qn=fmaxf(qn,__shfl_xor(qn,o_));kn=fmaxf(kn,__shfl_xor(kn,o_));}
    Bq=sqrtf(qn*kn)*1.001f+1e-3f;
    const float lim=2.0f*Bq+PRUNE_X;
    const bool n0=(lane>=NTF)||((c0-cq0)<=lim), n1=(lane+64>=NTF)||((c1-cq0)<=lim);
    const unsigned long long m0=__ballot(n0), m1=__ballot(n1);
    jmin=m0?(int)__builtin_ctzll(m0):(64+(m1?(int)__builtin_ctzll(m1):63));
    jmin=__builtin_amdgcn_readfirstlane(jmin)&~1; if(jmin>NTF-4)jmin=NTF-4; }
  const int NT=NTF-jmin;
  float*wsf=(float*)(shm+LDS_WS)+wid*64;
  const int vb0=(int)(lds0+LDS_V)+((lane>>4)&1)*32+(lane&3)*8+(4*hi+((lane&15)>>2))*64;
  const char*Kbase=shm+LDS_K; bf16x8 kf[8];
  const lds_cptr shm3=(lds_cptr)shm; const lds_cptr kp0=shm3+LDS_K+hi*1024+r32*16; const lds_cptr vp0=shm3+LDS_V+((lane>>4)&1)*32+(lane&3)*8+(4*hi+((lane&15)>>2))*64;
  const lds_cptr ckp0=shm3+LDS_CK+hi*16;
  #define CKP(t) (ckp0+(t)*256)
  bf16x8 qr[4];
  #pragma unroll
  for(int d0=0;d0<4;++d0)qr[d0]=*reinterpret_cast<const bf16x8*>(&Qw[(long)r32*DMP+d0*16+hi*8]);
  const float cq=ck[q0+wid*QBLK+r32];
  { const int n4=NT*16; const f32x4_*src=(const f32x4_*)ck; __attribute__((address_space(3))) f32x4_*dst=(__attribute__((address_space(3))) f32x4_*)(shm3+LDS_CK);
    for(int i=tid;i<n4;i+=NW*64)dst[i]=src[(NTF-1-(i>>4))*16+(i&15)]; }
  float mhat=0.f,l_reg=0.f;f32x16 o[2];o[0]=f32x16{};o[1]=f32x16{};
  const int qrel=wid*QBLK+r32;
  #define CMASK(P0,P1,t) do{int jb_=3-(t); if(jb_>=0)cmask(P0,P1,jb_,qrel,hi);}while(0)
  bool resc=false;
  #define START(P0,P1) do{ const float rm=fmaxf(rowmax(P0,P1),-Bq); resc=false; \
    { const float dl=rm; mhat=fadd_s(mhat,dl); \
      _Pragma("unroll") for(int r=0;r<16;++r){P0[r]=fsub_s(P0[r],dl);P1[r]=fsub_s(P1[r],dl);} } \
    _Pragma("unroll") for(int r=0;r<16;++r)P0[r]=__builtin_amdgcn_exp2f(P0[r]); }while(0)
  #define RESC() do{ if(resc){ asm volatile("s_waitcnt lgkmcnt(0)":::"memory"); \
      _Pragma("unroll") for(int d_=0;d_<2;++d_) _Pragma("unroll") for(int r=0;r<16;++r)o[d_][r]*=wsf[crow(r,hi)]; } }while(0)
  f32x16 pA0,pA1,pB0,pB1;
  int sl_prev=0,sl_cur=0,sl_next=SLOTB;
  #define ROT() do{sl_prev=sl_cur;sl_cur=sl_next;sl_next=(sl_next==(NSLOT-1)*SLOTB)?0:sl_next+SLOTB;}while(0)
  WAIT_BAR(0);
  asm volatile("":::"memory");
  cinit(pA0,pA1,CKP(0),cq);
  qkt(pA0,pA1,Kbase,qr,r32,hi);asm volatile("s_nop 15\n\ts_nop 7":"+v"(pA0),"+v"(pA1));CMASK(pA0,pA1,0);
  START(pA0,pA1);
  _Pragma("unroll") for(int r=0;r<16;++r)pA1[r]=__builtin_amdgcn_exp2f(pA1[r]);
  WAIT_BAR(0);
  DMA_K(3,0);DMA_V(1,SLOTB);
  ROT();
  kload8(kf,kp0+sl_cur);
  WAIT_BAR(2);
  s16x4 vlo[8],vhi[8]; u32x4_ pw0,pw1,pw2,pw3;
  #define PKW(P,B) cvtpk_s(P[B],P[B+1])
  #define PAF(k) __builtin_bit_cast(bf16x8,pw##k)
  #define VFR(i) (bf16x8){vlo[i][0],vlo[i][1],vlo[i][2],vlo[i][3],vhi[i][0],vhi[i][1],vhi[i][2],vhi[i][3]}
  #define PIN(x) asm volatile("":"+v"(x))
  #define MX3(a,b,c) __builtin_fmaxf(__builtin_fmaxf((a),(b)),(c))
  #define GAPA(MF,A0,A1,A2,A3,W0,W1,PW) do{ MF; sacc+=A0; sacc+=A1; sacc+=A2; sacc+=A3; PIN(sacc); W0; W1; PIN(PW); SBAR(); }while(0)
  #define EX(v) __builtin_amdgcn_exp2f(v)
  #define GAPB(MF,X,B) do{ MF; X[B]=EX(X[B]); X[B+1]=EX(X[B+1]); X[B+2]=EX(X[B+2]); X[B+3]=EX(X[B+3]); PIN(X); SBAR(); }while(0)
  #define VRD(i) do{ vlo[i]=vtr(vp_+(((i)>>2)*4096+((i)&3)*1024)); vhi[i]=vtr(vp_+(((i)>>2)*4096+((i)&3)*1024+512)); }while(0)
  #define KRD(G,j) do{ if(G){ kload2(kf,kp0+sl_next,j); SBAR(); } }while(0)
  #define STEP(C0,C1,P0,P1,t,GK,GV,GL) do{ SBAR(); \
    const lds_cptr vp_=vp0+sl_prev; \
    cinit(C0,C1,CKP(t),cq-mhat); SBAR(); \
    VRD(0); SBAR(); float sacc=(P0[0]+P0[1]); \
    GAPA(C0=__builtin_amdgcn_mfma_f32_32x32x16_bf16(kf[0],qr[0],C0,0,0,0), P0[2],P0[3],P0[4],P0[5],     pw0[0]=PKW(P0,0), pw0[1]=PKW(P0,2), pw0); \
    VRD(4); SBAR(); GAPA(C1=__builtin_amdgcn_mfma_f32_32x32x16_bf16(kf[1],qr[0],C1,0,0,0), P0[6],P0[7],P0[8],P0[9],     pw0[2]=PKW(P0,4), pw0[3]=PKW(P0,6), pw0); \
    VRD(1); SBAR(); GAPA(C0=__builtin_amdgcn_mfma_f32_32x32x16_bf16(kf[2],qr[1],C0,0,0,0),   P0[10],P0[11],P0[12],P0[13], pw1[0]=PKW(P0,8), pw1[1]=PKW(P0,10), pw1); \
    VRD(5); SBAR(); GAPA(C1=__builtin_amdgcn_mfma_f32_32x32x16_bf16(kf[3],qr[1],C1,0,0,0),   P0[14],P0[15],P1[0],P1[1],   pw1[2]=PKW(P0,12),pw1[3]=PKW(P0,14), pw1); \
    VRD(2); SBAR(); GAPA(C0=__builtin_amdgcn_mfma_f32_32x32x16_bf16(kf[4],qr[2],C0,0,0,0),   P1[2],P1[3],P1[4],P1[5],     pw2[0]=PKW(P1,0), pw2[1]=PKW(P1,2), pw2); \
    VRD(6); SBAR(); GAPA(C1=__builtin_amdgcn_mfma_f32_32x32x16_bf16(kf[5],qr[2],C1,0,0,0),   P1[6],P1[7],P1[8],P1[9],     pw2[2]=PKW(P1,4), pw2[3]=PKW(P1,6), pw2); \
    VRD(3); SBAR(); GAPA(C0=__builtin_amdgcn_mfma_f32_32x32x16_bf16(kf[6],qr[3],C0,0,0,0),   P1[10],P1[11],P1[12],P1[13], pw3[0]=PKW(P1,8), pw3[1]=PKW(P1,10), pw3); \
    VRD(7); SBAR(); GAPA(C1=__builtin_amdgcn_mfma_f32_32x32x16_bf16(kf[7],qr[3],C1,0,0,0),   P1[14],P1[15],0.f,0.f,       pw3[2]=PKW(P1,12),pw3[3]=PKW(P1,14), pw3); \
    l_reg+=sacc; \
    if(GK){DMA_K((t)+3,sl_cur);} if(GV){DMA_V((t)+1,sl_next);} \
    CMASK(C0,C1,t); \
    { float a=MX3(C0[0],C0[1],C1[0]),b=MX3(C0[2],C0[3],C1[1]); a=MX3(a,C1[2],C1[3]); \
      _Pragma("unroll") for(int r=4;r<16;r+=4){a=MX3(a,C0[r],C0[r+1]);b=MX3(b,C0[r+2],C0[r+3]);a=MX3(a,C1[r],C1[r+1]);b=MX3(b,C1[r+2],C1[r+3]);} \
      float rm=__builtin_fmaxf(a,b); { auto rr=__builtin_amdgcn_permlane32_swap(__float_as_uint(rm),__float_as_uint(rm),false,false); rm=__builtin_fmaxf(__uint_as_float(rr[0]),__uint_as_float(rr[1])); } \
      resc=false; \
      if(__builtin_expect(__any(rm>(float)THRL),0)){ const float dl=__builtin_fmaxf(rm,0.f); mhat+=dl; \
        _Pragma("unroll") for(int r=0;r<16;++r){C0[r]-=dl;C1[r]-=dl;} \
        const float f=__builtin_amdgcn_exp2f(-dl); l_reg*=f; if(hi==0)wsf[r32]=f; resc=true; } } \
    SBAR(); \
    GAPB(o[0]=__builtin_amdgcn_mfma_f32_32x32x16_bf16(PAF(0),VFR(0),o[0],0,0,0), C0,0); \
    GAPB(o[1]=__builtin_amdgcn_mfma_f32_32x32x16_bf16(PAF(0),VFR(4),o[1],0,0,0), C0,4); \
    KRD(GL,0); GAPB(o[0]=__builtin_amdgcn_mfma_f32_32x32x16_bf16(PAF(1),VFR(1),o[0],0,0,0), C0,8); \
    KRD(GL,1); GAPB(o[1]=__builtin_amdgcn_mfma_f32_32x32x16_bf16(PAF(1),VFR(5),o[1],0,0,0), C0,12); \
    KRD(GL,2); GAPB(o[0]=__builtin_amdgcn_mfma_f32_32x32x16_bf16(PAF(2),VFR(2),o[0],0,0,0), C1,0); \
    KRD(GL,3); GAPB(o[1]=__builtin_amdgcn_mfma_f32_32x32x16_bf16(PAF(2),VFR(6),o[1],0,0,0), C1,4); \
    GAPB(o[0]=__builtin_amdgcn_mfma_f32_32x32x16_bf16(PAF(3),VFR(3),o[0],0,0,0), C1,8); \
    GAPB(o[1]=__builtin_amdgcn_mfma_f32_32x32x16_bf16(PAF(3),VFR(7),o[1],0,0,0), C1,12); \
    }while(0)
  #define ENDW(tt) do{ if((tt)+3<NT){WAIT_BAR(2);} else if((tt)+2<NT){WAIT_BAR(1);} else {WAIT_BAR(0);} }while(0)
  int t=1;
  for(;t+1<NT&&t<5;t+=2){
    STEP(pB0,pB1,pA0,pA1,t,(t+3<NT),(t+1<NT),(t+1<NT));       ENDW(t);   RESC(); ROT();
    STEP(pA0,pA1,pB0,pB1,t+1,(t+4<NT),(t+2<NT),(t+2<NT));     ENDW(t+1); RESC(); ROT();
  }
  #undef CMASK
  #define CMASK(P0,P1,t) do{}while(0)
  for(;t+5<NT;t+=2){
    STEP(pB0,pB1,pA0,pA1,t,true,true,true);     WAIT_BAR(2); RESC(); ROT();
    STEP(pA0,pA1,pB0,pB1,t+1,true,true,true);   WAIT_BAR(2); RESC(); ROT();
  }
  for(;t+1<NT;t+=2){
    STEP(pB0,pB1,pA0,pA1,t,(t+3<NT),(t+1<NT),(t+1<NT));       ENDW(t);   RESC(); ROT();
    STEP(pA0,pA1,pB0,pB1,t+1,(t+4<NT),(t+2<NT),(t+2<NT));     ENDW(t+1); RESC(); ROT();
  }
  #undef CMASK
  #define CMASK(P0,P1,t) do{int jb_=3-(t); if(jb_>=0)cmask(P0,P1,jb_,qrel,hi);}while(0)
  STEP(pB0,pB1,pA0,pA1,NT-1,false,false,false); RESC();
  { float sacc=pB0[0]+pB0[1]; _Pragma("unroll") for(int r=2;r<16;++r)sacc+=pB0[r]; _Pragma("unroll") for(int r=0;r<16;++r)sacc+=pB1[r]; l_reg+=sacc;
    pw0=(u32x4_){PKW(pB0,0),PKW(pB0,2),PKW(pB0,4),PKW(pB0,6)};pw1=(u32x4_){PKW(pB0,8),PKW(pB0,10),PKW(pB0,12),PKW(pB0,14)};pw2=(u32x4_){PKW(pB1,0),PKW(pB1,2),PKW(pB1,4),PKW(pB1,6)};pw3=(u32x4_){PKW(pB1,8),PKW(pB1,10),PKW(pB1,12),PKW(pB1,14)};
    SBAR(); pv(o,vb0+sl_cur,PAF(0),PAF(1),PAF(2),PAF(3)); }
  #undef PKW
  #undef PAF
  #undef VFR
  #undef PIN
  #undef MX3
  #undef GAPA
  #undef GAPB
  #undef EX
  #undef VRD
  #undef KRD
  #undef STEP
  #undef ENDW
  {auto rr=__builtin_amdgcn_permlane32_swap(__float_as_uint(l_reg),__float_as_uint(l_reg),false,false);l_reg=__uint_as_float(rr[0])+__uint_as_float(rr[1]);}
  if(hi==0)wsf[32+r32]=l_reg;asm volatile("s_waitcnt lgkmcnt(0)":::"memory");
  float rli[16];
  #pragma unroll
  for(int r=0;r<16;++r)rli[r]=__builtin_amdgcn_rcpf(wsf[32+crow(r,hi)]);
  bf16*Ow=O+(rowbase+q0+wid*QBLK)*DMP+h*D;
  { bf16*stg=(bf16*)(shm+LDS_OST)+wid*2048;
    #pragma unroll
    for(int r=0;r<16;++r){const int orow=crow(r,hi);
      #pragma unroll
      for(int d0=0;d0<2;++d0)stg[orow*64+d0*32+r32]=(bf16)f2bf(o[d0][r]*rli[r]);}
    asm volatile("s_waitcnt lgkmcnt(0)":::"memory");
    #pragma unroll
    for(int i=0;i<4;++i){const int row=i*8+(lane>>3),ch=lane&7; const u32x4_ v=*(const u32x4_*)(stg+row*64+ch*8); *(u32x4_*)(Ow+(long)row*DMP+ch*8)=v;} }
  asm volatile("s_waitcnt lgkmcnt(0)\n\ts_barrier":::"memory");
  #undef DMA_K
  #undef DMA_V
  #undef CMASK
  #undef START
  #undef RESC
  #undef ROT
  #undef TJ
  #undef CKP
}
#undef SBAR
#undef WAIT_BAR
}

__device__ __forceinline__ void p_norms(const Frame& Fin_, const Params& P) {
    Frame F = Fin_; LAUNDER(F);
    const float* NP = (const float*)(P.ws + WS_NP); float* QN = (float*)(P.ws + WS_QN); float* KN = (float*)(P.ws + WS_KN);
    const int gw = ((int)blockIdx.x - 160) * NWAVES + F.wave, NGW = (F.G - 160) * NWAVES;
    for (int it = gw; it < T / 64; it += NGW) { const int b = it >> 7, tile = it & 127; const float* p = NP + ((size_t)b * SEQ + tile * 64) * 32 + F.lane;
        float v[32];
#pragma unroll
        for (int i = 0; i < 32; ++i) v[i] = p[i * 64];
        float m = 0.f;
#pragma unroll
        for (int i = 0; i < 32; ++i) m = fmaxf(m, v[i] + __shfl_xor(v[i], 1));
        m = fmaxf(m, __shfl_xor(m, 32)) * (1.0f + 1.0f / 64.0f);
        const int seg = F.lane & 31;
        if (F.lane < 32 && (seg & 1) == 0) { if (seg < 16) QN[(b * NH + (seg >> 1)) * 128 + tile] = m; else KN[(b * NH + ((seg - 16) >> 1)) * 128 + tile] = m; } }
}


#define XB_TMO      128
#define XB_XCNT(j)  (256  + 64 * (j))
#define XB_XSUB(j)  (1280 + 64 * (j))
#define XB_XGEN(j)  (2304 + 64 * (j))
#define XB_TOP      3328
#define XB_TOPGEN   3392
#define XCD_BAR_WORDS 3456
#define XB_SPIN_CAP (1u << 18)
constexpr int CW_BAR = 4096;
constexpr size_t CTL_ZERO_BYTES = 65536;
constexpr unsigned REP_MASK = 0u;
constexpr int CW_ATTNQ = 8192;
constexpr int LDSCTL_OFF = RING_BYTES, MISC_OFF = LDSCTL_OFF + 320;
__device__ __forceinline__ unsigned xb_ld(unsigned* p)              { return __hip_atomic_load(p, __ATOMIC_RELAXED, __HIP_MEMORY_SCOPE_AGENT); }
__device__ __forceinline__ unsigned xb_add(unsigned* p, unsigned v) { return __hip_atomic_fetch_add(p, v, __ATOMIC_RELAXED, __HIP_MEMORY_SCOPE_AGENT); }
__device__ __forceinline__ unsigned xb_xcc_id() { return (unsigned)__builtin_amdgcn_s_getreg((3 << 11) | 20) & 0xFu; }
#define XB_SPIN(cond, bar) do { unsigned _sp = 0; while (cond) { __builtin_amdgcn_s_sleep(1); \
    if ((++_sp & 255u) == 0u) { if (xb_ld(&(bar)[XB_TMO])) break; if (_sp > XB_SPIN_CAP) { atomicAdd(&(bar)[XB_TMO], 1u); break; } } } } while (0)
struct XcdBarrier { unsigned* bar; unsigned x; volatile LAS unsigned* st; };
__device__ __forceinline__ XcdBarrier xcd_barrier_post(unsigned* bar, volatile LAS unsigned* st) {
    XcdBarrier b; b.bar = bar; b.x = xb_xcc_id(); b.st = st;
    if (threadIdx.x == 0) (void)xb_add(&bar[XB_XCNT(b.x)], 1u);
    return b;
}
__device__ __forceinline__ void xcd_barrier_complete(unsigned* bar, unsigned x, unsigned& nloc, unsigned& nx) {
    const unsigned G = gridDim.x * gridDim.y * gridDim.z;
    unsigned sum, cnt, mine, sp = 0u;
    for (;;) {
        sum = 0u; cnt = 0u; mine = 0u;
#pragma unroll
        for (unsigned j = 0; j < 16; ++j) { const unsigned c = xb_ld(&bar[XB_XCNT(j)]); sum += c; cnt += (c > 0u) ? 1u : 0u; mine = (j == x) ? c : mine; }
        if (sum == G) break;
        __builtin_amdgcn_s_sleep(1);
        if ((++sp & 255u) == 0u) { if (xb_ld(&bar[XB_TMO])) break; if (sp > XB_SPIN_CAP) { atomicAdd(&bar[XB_TMO], 1u); break; } }
    }
    nloc = mine > 0u ? mine : 1u; nx = cnt > 0u ? cnt : 1u;
}
__device__ __forceinline__ void xcd_barrier(const XcdBarrier& b) {
    asm volatile("s_waitcnt vmcnt(0)" ::: "memory");
    __syncthreads();
    if (threadIdx.x == 0) {
        unsigned* bar = b.bar;
        __builtin_amdgcn_s_waitcnt(0);
        unsigned nloc = b.st[0], nx = b.st[1];
        if (nloc == 0u) { xcd_barrier_complete(bar, b.x, nloc, nx); b.st[0] = nloc; b.st[1] = nx; }
        const unsigned old = xb_add(&bar[XB_XSUB(b.x)], 1u);
        const unsigned gen = old / nloc;
        if (old + 1u == (gen + 1u) * nloc) {
            __builtin_amdgcn_fence(__ATOMIC_RELEASE, "agent");
            asm volatile("s_waitcnt vmcnt(0)" ::: "memory");
            const unsigned og = xb_add(&bar[XB_TOP], 1u);
            const unsigned tg = og / nx;
            if (og + 1u == (tg + 1u) * nx) xb_add(&bar[XB_TOPGEN], 1u);
            else XB_SPIN(xb_ld(&bar[XB_TOPGEN]) == tg, bar);
            __builtin_amdgcn_fence(__ATOMIC_ACQUIRE, "agent");
            xb_add(&bar[XB_XGEN(b.x)], 1u);
            asm volatile("s_waitcnt vmcnt(0)" ::: "memory");
        } else {
            XB_SPIN(xb_ld(&bar[XB_XGEN(b.x)]) == gen, bar);
            __builtin_amdgcn_fence(__ATOMIC_ACQUIRE, "agent");
            asm volatile("s_waitcnt vmcnt(0)" ::: "memory");
        }
    }
    __syncthreads();
}


__device__ __forceinline__ void attn_only_phase(const fox::Tensors& TT, char* lds, unsigned* ctr, volatile LAS int* qw) {
    if (threadIdx.x == 0) qw[0] = (int)__hip_atomic_fetch_add(ctr, 1u, __ATOMIC_RELAXED, __HIP_MEMORY_SCOPE_AGENT);
    __syncthreads();
    for (int slot = 0;; slot ^= 1) { const int u = qw[slot]; if (u >= 32 * 32) break;
        int nxt = 0; if (threadIdx.x == 0) nxt = (int)__hip_atomic_fetch_add(ctr, 1u, __ATOMIC_RELAXED, __HIP_MEMORY_SCOPE_AGENT);
        const int qb = 31 - (u >> 5), bh = u & 31; fox::attn_unit<8>(bh / NH, bh % NH, qb, TT, lds);
        if (threadIdx.x == 0) qw[slot ^ 1] = nxt; __syncthreads(); }
}

enum Phase { PH_PRO = 0, PH_PROJ, PH_CUMSUM, PH_SSMS, PH_CARRY, PH_SSMY, PH_ATTN, PH_GLU, PH_OUTA, PH_OUTB, PH_WOUT, PH_ROUTER, PH_POS, PH_MOEGU, PH_MOEMIX, PH_MOEDN, PH_FINAL, PH_N };

__global__ void __launch_bounds__(NTHR, 2) mega(Params P) {
    extern __shared__ __attribute__((aligned(16))) unsigned char lds_raw[];
    Frame F; F.lds = (LAS unsigned char*)lds_raw; F.tid = threadIdx.x; F.lane = F.tid & 63; F.wave = __builtin_amdgcn_readfirstlane(F.tid >> 6);
    F.G = gridDim.x; { const int bx = blockIdx.x; F.vcu = (F.G % 8 == 0) ? (bx % 8) * (F.G / 8) + bx / 8 : bx; }
    const int lo = P.ph_lo, hi = P.ph_hi;
    unsigned char* ws = P.ws;
    for (int u = F.tid; u < (LDS_BYTES - LDSCTL_OFF) / 4; u += NTHR) ((LAS unsigned*)(F.lds + LDSCTL_OFF))[u] = 0u;
    __syncthreads();
    XcdBarrier bar; bar.bar = (unsigned*)(ws + WS_CTL) + CW_BAR; bar.x = 0; bar.st = nullptr;
    if (hi - lo > 1) bar = xcd_barrier_post((unsigned*)(ws + WS_CTL) + CW_BAR, (volatile LAS unsigned*)(F.lds + MISC_OFF) + 8);
#define IN(k) (lo <= (k) && (k) < hi)
#define SEAM(k) do { if (IN(k) && IN((k) + 1)) xcd_barrier(bar); } while (0)
#define REPEAT(i) for (int rep_ = 0; rep_ < 1 + (int)((REP_MASK >> (i)) & 1u); ++rep_)
    REPEAT(0) { if (IN(PH_PRO)) p0_prologue(F, P);
    SEAM(PH_PRO); }
    REPEAT(1) { if (IN(PH_PROJ)) { for (int i = F.tid; i < 2048; i += NTHR) ((LAS float*)(F.lds + BIAS_OFF))[i] = P.in[4][i] * -LOG2E; __syncthreads();
        SchedPlain S{(const bf16*)(ws + WS_XN), (const bf16*)(ws + WS_WIN), T / 256, NPROJ / 256, {1024, 1024, 1024}};
        EpiProj E{(bf16*)(ws + WS_Q), (bf16*)(ws + WS_K), (bf16*)(ws + WS_V), (bf16*)(ws + WS_UH), (bf16*)(ws + WS_GATES), (const LAS float*)(F.lds + BIAS_OFF), (float*)(ws + WS_NP)}; run_gemm(F.lds, S.d, S, E); }
    SEAM(PH_PROJ); }
    REPEAT(2) { if (IN(PH_CUMSUM)) { if (blockIdx.x >= 160) p_norms(F, P); else if (blockIdx.x >= 128) p_cumsum(F, P);
        if (blockIdx.x >= 128) { __syncthreads(); p0_weights(F, P, 1); } }
    if (IN(PH_SSMS)) { SchedSsmS S{(const bf16*)(ws + WS_UH), (const bf16*)(ws + WS_WS)}; EpiSsmS E{(float*)(ws + WS_S)}; run_gemm(F.lds, GemmDims{512, KY, 512}, S, E); }
    if (IN(PH_CARRY)) { __syncthreads(); p_carry(F, P); }
    SEAM(PH_CARRY); }
    REPEAT(3) { if (IN(PH_SSMY)) { SchedSsmY S{(const bf16*)(ws + WS_UH), (const bf16*)(ws + WS_MX), F.G}; EpiSsmY E{(bf16*)(ws + WS_Z)}; run_gemm(F.lds, GemmDims{KY, KY, KY}, S, E); __syncthreads(); }
    if (IN(PH_ATTN)) { const fox::Tensors TT{(const bf16*)(ws + WS_Q), (const bf16*)(ws + WS_K), (const bf16*)(ws + WS_V), (bf16*)(ws + WS_OA), (const float*)(ws + WS_CK2), (const float*)(ws + WS_QN), (const float*)(ws + WS_KN)};
        attn_only_phase(TT, (char*)lds_raw, (unsigned*)(ws + WS_CTL) + CW_ATTNQ + 64 * rep_, (volatile LAS int*)(F.lds + MISC_OFF) + 16); }
    SEAM(PH_ATTN); }
    REPEAT(5) { if (IN(PH_GLU)) { for (int i = F.tid; i < 512; i += NTHR) ((LAS float*)(F.lds + BIAS_OFF))[i] = P.in[15][i] * -LOG2E; __syncthreads();
        SchedPlain S{(const bf16*)(ws + WS_Z), (const bf16*)(ws + WS_WGLU), T / 256, 2, {512, 512, 512}}; EpiGlu E{(const bf16*)(ws + WS_Z), (bf16*)(ws + WS_ZZ), (const LAS float*)(F.lds + BIAS_OFF)}; run_gemm(F.lds, S.d, S, E); }
    SEAM(PH_GLU); }
    REPEAT(6) { if (IN(PH_OUTB)) { SchedOutAB S{(const bf16*)(ws + WS_OA), (const bf16*)(ws + WS_ZZ), (const bf16*)(ws + WS_WOA), (const bf16*)(ws + WS_WOB)}; EpiOutAB E{(const unsigned char*)(ws + WS_GATES), (bf16*)(ws + WS_MERGED)};
        run_gemm(F.lds, GemmDims{1024, 512, 512}, S, E); }
    SEAM(PH_OUTB); }
    REPEAT(7) { if (IN(PH_WOUT)) { SchedPlain S{(const bf16*)(ws + WS_MERGED), (const bf16*)(ws + WS_WO), T / 256, 4, {1024, 1024, 1024}};
        { UnitX u0; u0.pn = 0; S.get((int)blockIdx.x, u0); stage_router_table(F, P, u0.pn); }
        EpiWout E{P.in[0], (bf16*)(ws + WS_H2), (float*)(ws + WS_PART), (const LAS unsigned char*)(F.lds + RT_OFF)}; run_gemm(F.lds, S.d, S, E); }
    SEAM(PH_WOUT); }
    REPEAT(8) { if (IN(PH_ROUTER)) p_router(F, P, rep_ == 0);
    SEAM(PH_ROUTER); }
    REPEAT(10) { if (IN(PH_MOEGU)) { moe_tile_table(F, P);
        SchedMoeGU S{(const bf16*)(ws + WS_H2), (const bf16*)(ws + WS_WGU), (const int*)(ws + WS_LIST), (const LAS int*)(F.lds + TT_OFF), MoeRange{0, 512, 0, 0, F.G}}; EpiMoeGU E{(bf16*)(ws + WS_HACT), (const float*)(ws + WS_LPW)}; run_gemm(F.lds, GemmDims{1024, 1024, 1024}, S, E); }
    SEAM(PH_MOEGU); }
    REPEAT(11) { if (IN(PH_MOEMIX)) { const LAS int* tt = (const LAS int*)(F.lds + TT_OFF); const int nu = 4 * tt[568]; int L = nu - 512; L = L < 0 ? 0 : (L > F.G ? F.G : L);
        { SchedMoeGU S{(const bf16*)(ws + WS_H2), (const bf16*)(ws + WS_WGU), (const int*)(ws + WS_LIST), tt, MoeRange{512, nu, 1, 0, F.G}}; EpiMoeGU E{(bf16*)(ws + WS_HACT), (const float*)(ws + WS_LPW)}; run_gemm(F.lds, GemmDims{1024, 1024, 1024}, S, E); }
        { const int dn_b = nu < 512 ? nu : 512;
          SchedMoeDN S{(const bf16*)(ws + WS_HACT), (const bf16*)(ws + WS_WD), tt, MoeRange{0, dn_b, 2, L, F.G}}; EpiMoeDN E{(bf16*)(ws + WS_Y)}; run_gemm(F.lds, GemmDims{512, 512, 512}, S, E); } }
    SEAM(PH_MOEMIX); }
    REPEAT(13) { if (IN(PH_MOEDN)) { const LAS int* tt = (const LAS int*)(F.lds + TT_OFF); const int nu = 4 * tt[568]; int L = nu - 512; L = L < 0 ? 0 : (L > F.G ? F.G : L);
        int d0 = 2 * (F.G - L); { const int dn_b = nu < 512 ? nu : 512; d0 = d0 < dn_b ? d0 : dn_b; }
        SchedMoeDN S{(const bf16*)(ws + WS_HACT), (const bf16*)(ws + WS_WD), tt, MoeRange{d0, nu, 0, 0, F.G}}; EpiMoeDN E{(bf16*)(ws + WS_Y)}; run_gemm(F.lds, GemmDims{512, 512, 512}, S, E); }
    SEAM(PH_MOEDN); }
    REPEAT(12) { if (IN(PH_FINAL)) p_final(F, P); }
#undef REPEAT
#undef SEAM
#undef IN
}

static void launch_mega(const Params& base, int lo, int hi, int grid, hipStream_t stream) {
    Params p = base; p.ph_lo = lo; p.ph_hi = hi;
    hipLaunchKernelGGL(mega, dim3(grid), dim3(NTHR), LDS_BYTES, stream, p);
}

extern "C" void kernel_launch(void* const* d_in, const int* in_sizes, int n_in, void* d_out, int out_size, void* d_ws, size_t ws_size, hipStream_t stream) {
    static int grid = 0;
    if (grid == 0) {
        if (n_in != 27 || out_size != T * DM || ws_size < WS_END) { fprintf(stderr, "kernel_launch: unexpected shapes (n_in %d out %d ws %zu)\n", n_in, out_size, ws_size); grid = -1; return; }
        if (hipFuncSetAttribute((const void*)mega, hipFuncAttributeMaxDynamicSharedMemorySize, LDS_BYTES) != hipSuccess) { fprintf(stderr, "hipFuncSetAttribute failed\n"); grid = -1; return; }
        int dev = 0, cus = 0, per_cu = 0; hipGetDevice(&dev); hipDeviceGetAttribute(&cus, hipDeviceAttributeMultiprocessorCount, dev);
        hipOccupancyMaxActiveBlocksPerMultiprocessor(&per_cu, (const void*)mega, NTHR, LDS_BYTES);
        (void)hipGetLastError();
        grid = cus * (per_cu < 1 ? 1 : 1);
    }
    if (grid < 0) return;
    Params P{};
    for (int i = 0; i < 27; ++i) P.in[i] = (const float*)d_in[i];
    P.out = (float*)d_out; P.ws = (unsigned char*)d_ws;
    if (hipMemsetAsync((char*)d_ws + WS_CTL, 0, CTL_ZERO_BYTES, stream) != hipSuccess) { fprintf(stderr, "kernel_launch: memset failed\n"); return; }
    P.ph_lo = 0; P.ph_hi = PH_N;
    void* args[] = {&P};
    const hipError_t le = hipLaunchCooperativeKernel((const void*)mega, dim3(grid), dim3(NTHR), args, LDS_BYTES, stream);
    if (le != hipSuccess) fprintf(stderr, "kernel_launch: cooperative launch failed: %s (grid %d)\n", hipGetErrorString(le), grid);
}
```

```cpp
#include <hip/hip_runtime.h>
#include <cstdint>
#include <cstdio>

#ifndef FAST_SSM
#define FAST_SSM 1
#endif
#ifndef FAST_ATTN
#define FAST_ATTN 1
#endif
#ifndef FAST_GEMM
#define FAST_GEMM 1
#endif
constexpr int BATCH = 4, SEQ = 8192, DM = 1024, T = BATCH * SEQ;
constexpr int NH = 8, HD = 64, FW = 512;
constexpr int SG = 32, SC = 16, SP = 64, SW = 512, LCH = 32, NCHB = SEQ / LCH, NCH = T / LCH;
constexpr int KY = 640;
constexpr int NPROJ = 4096;
constexpr int WIN_LD = 4104;
constexpr int NE = 16, FF = 256, NCLS = 24;
constexpr int MAXTILES = T / 256 + NCLS;
constexpr float EPS = 1e-6f;
constexpr float LOG2E = 1.4426950408889634f;
constexpr float C2 = 0.125f * LOG2E;

constexpr size_t MiB = 1u << 20;
constexpr size_t WS_CTL = 0;
constexpr size_t WS_WIN = 1 * MiB;
constexpr size_t WS_WOA = 9 * MiB;
constexpr size_t WS_WGLU = 10 * MiB;
constexpr size_t WS_WOB = 11 * MiB;
constexpr size_t WS_WO = 12 * MiB;
constexpr size_t WS_WGU = 14 * MiB;
constexpr size_t WS_WD = 30 * MiB;
constexpr size_t WS_MX = 54 * MiB;
constexpr size_t WS_WS = 74 * MiB;
constexpr size_t WS_AL = 79 * MiB;
constexpr size_t WS_CK2 = 80 * MiB;
constexpr size_t WS_LF = 81 * MiB;
constexpr size_t WS_CLS = 82 * MiB;
constexpr size_t WS_WAB = WS_CLS + 128 * 1024;
constexpr size_t WS_CNT = WS_WAB + 256 * 1024;
constexpr size_t WS_P2T = WS_CNT + 32 * 1024;
constexpr size_t WS_PW = WS_P2T + 160 * 1024;
constexpr size_t WS_TCLS = WS_PW + 320 * 1024;
constexpr size_t WS_QN = 83 * MiB;
constexpr size_t WS_KN = 83 * MiB + 65536;
constexpr size_t WS_NP = 84 * MiB;
constexpr size_t WS_XN = 96 * MiB;
constexpr size_t WS_T1 = WS_XN, WS_H2 = WS_XN;
constexpr size_t WS_Q = 160 * MiB, WS_K = 192 * MiB, WS_V = 224 * MiB;
constexpr size_t WS_MERGED = WS_Q;
constexpr size_t WS_HACT = WS_Q;
constexpr size_t WS_ZZ = WS_V;
constexpr size_t WS_UH = 256 * MiB;
constexpr size_t WS_S = 296 * MiB;
constexpr size_t WS_GATES = 312 * MiB;
constexpr size_t WS_XG = WS_GATES;
constexpr size_t WS_LIST = WS_UH;
constexpr size_t WS_LPW = WS_UH + 4 * MiB;
constexpr size_t WS_Y = WS_GATES;
constexpr size_t WS_TPOS = WS_UH + 20 * MiB;
constexpr size_t WS_PART = 392 * MiB;
constexpr size_t WS_OA = 440 * MiB;
constexpr size_t WS_Z = 472 * MiB;
constexpr size_t WS_END = 504 * MiB;

#define LAS __attribute__((address_space(3)))
typedef unsigned short bf16;
typedef float f32x4 __attribute__((ext_vector_type(4)));
typedef unsigned u32x4 __attribute__((ext_vector_type(4)));
typedef unsigned u32x2 __attribute__((ext_vector_type(2)));
typedef short bf16x8 __attribute__((ext_vector_type(8)));

typedef float f32x2_cv __attribute__((ext_vector_type(2))); typedef __bf16 bf16x2_cv __attribute__((ext_vector_type(2)));
__device__ __forceinline__ unsigned pk2(float lo, float hi) { const f32x2_cv v = {lo, hi}; const bf16x2_cv b = __builtin_convertvector(v, bf16x2_cv); return __builtin_bit_cast(unsigned, b); }
__device__ __forceinline__ unsigned f2bf(float f) { return pk2(f, 0.f) & 0xffffu; }
__device__ __forceinline__ float bf2f(unsigned b) { return __builtin_bit_cast(float, b << 16); }
__device__ __forceinline__ float wave_sum(float v) {
#pragma unroll
    for (int o = 1; o < 64; o <<= 1) v += __shfl_xor(v, o);
    return v;
}
__device__ __forceinline__ float sigmoidf_(float v) { return __builtin_amdgcn_rcpf(1.0f + __builtin_amdgcn_exp2f(v * -LOG2E)); }
__device__ __forceinline__ float sigmoid_b(float v, float nb) { return __builtin_amdgcn_rcpf(1.0f + __builtin_amdgcn_exp2f(__builtin_fmaf(v, -LOG2E, nb))); }
__device__ __forceinline__ float gelu_tanh(float y) { const float y2 = y * y; const float t = y * __builtin_fmaf(y2, -2.0f * LOG2E * 0.7978845608028654f * 0.044715f, -2.0f * LOG2E * 0.7978845608028654f); return y * __builtin_amdgcn_rcpf(1.0f + __builtin_amdgcn_exp2f(t)); }
__device__ __forceinline__ void store8(bf16* p, const float (&v)[8]) { u32x4 w; w.x = pk2(v[0], v[1]); w.y = pk2(v[2], v[3]); w.z = pk2(v[4], v[5]); w.w = pk2(v[6], v[7]); *(u32x4*)p = w; }
__device__ __forceinline__ void load8(const bf16* p, float (&v)[8]) { const u32x4 w = *(const u32x4*)p; v[0] = bf2f(w.x & 0xffffu); v[1] = bf2f(w.x >> 16); v[2] = bf2f(w.y & 0xffffu); v[3] = bf2f(w.y >> 16); v[4] = bf2f(w.z & 0xffffu); v[5] = bf2f(w.z >> 16); v[6] = bf2f(w.w & 0xffffu); v[7] = bf2f(w.w >> 16); }

__host__ __device__ __forceinline__ int pair_a(int pi) { return (pi >= 3) + (pi >= 5); }
__host__ __device__ __forceinline__ int pair_b(int pi) { return pi < 3 ? pi + 1 : (pi < 5 ? pi - 1 : 3); }
__host__ __device__ __forceinline__ int pair_idx(int a, int b) { return a == 0 ? b - 1 : (a == 1 ? b + 1 : 5); }

struct Params {
    const float* in[27];
    float* out;
    unsigned char* ws;
    int ph_lo, ph_hi;
};

struct UnitX { int pm, pn; const char* A; const char* B; int aux, tic, cnt; const char* A2; const char* B2; };
struct GemmDims { int K, lda, ldb; };
constexpr int RT_ROWB = 528;

struct SchedPlain {
    static constexpr bool GATHER = false;
    static constexpr int KSPLIT = 1 << 20;
    const bf16* A; const bf16* Bt; int nM, nN; GemmDims d;
    __device__ __forceinline__ int count() const { return nM * nN; }
    __device__ __forceinline__ bool get(int idx, UnitX& u) const {
        if (idx >= nM * nN) return false;
        int wgid = idx; { const int nwg = nM * nN, q = nwg / 8, r = nwg % 8, xcd = wgid % 8, off = wgid / 8; wgid = (xcd < r ? xcd * (q + 1) : r * (q + 1) + (xcd - r) * q) + off; }
        const int nig = 8 * nN, gid = wgid / nig, fm = gid * 8, gsz = (nM - fm) < 8 ? (nM - fm) : 8;
        u.pm = fm + ((wgid % nig) % gsz); u.pn = (wgid % nig) / gsz; u.aux = 0;
        u.A = (const char*)A + (size_t)u.pm * 256 * d.lda * 2; u.B = (const char*)Bt + (size_t)u.pn * 256 * d.ldb * 2; return true;
    }
};
struct SchedOutAB {
    static constexpr bool GATHER = false; static constexpr int KSPLIT = 8;
    const bf16* OA; const bf16* ZZ; const bf16* WoaT; const bf16* WobT;
    __device__ __forceinline__ bool get(int idx, UnitX& u) const {
        const int nM = T / 256, nN = 4; if (idx >= nM * nN) return false;
        int wgid = idx; { const int nwg = nM * nN, q = nwg / 8, r = nwg % 8, xcd = wgid % 8, off = wgid / 8; wgid = (xcd < r ? xcd * (q + 1) : r * (q + 1) + (xcd - r) * q) + off; }
        const int nig = 8 * nN, gid = wgid / nig, fm = gid * 8, gsz = (nM - fm) < 8 ? (nM - fm) : 8;
        u.pm = fm + ((wgid % nig) % gsz); u.pn = (wgid % nig) / gsz; u.aux = 0; u.tic = 0; u.cnt = 0;
        u.A = (const char*)(OA + (size_t)u.pm * 256 * 512); u.B = (const char*)(WoaT + (size_t)u.pn * 256 * 512);
        u.A2 = (const char*)(ZZ + (size_t)u.pm * 256 * 512) - (size_t)KSPLIT * 128; u.B2 = (const char*)(WobT + (size_t)u.pn * 256 * 512) - (size_t)KSPLIT * 128; return true;
    }
};
struct SchedSsmS {
    static constexpr bool GATHER = false;
    static constexpr int KSPLIT = 1 << 20;
    const bf16* UH; const bf16* WsT;
    __device__ __forceinline__ int count() const { return SG * 4; }
    __device__ __forceinline__ bool get(int idx, UnitX& u) const {
        if (idx >= SG * 4) return false; const int g = idx >> 2, mt = idx & 3;
        u.pm = g * 4 + mt; u.pn = 0; u.aux = g; u.A = (const char*)(UH + ((size_t)g * NCH + mt * 256) * KY); u.B = (const char*)(WsT + (size_t)g * 128 * 512); return true;
    }
};
struct SchedSsmY {
    static constexpr bool GATHER = false;
    static constexpr int KSPLIT = 1 << 20;
    const bf16* UH; const bf16* MxT; int G;
    __device__ __forceinline__ int count() const { return SG * 8; }
    __device__ __forceinline__ bool get(int idx, UnitX& u) const {
        const int k = idx / G, c = idx - k * G; if (c >= SG * 4 || k >= 2) return false; const int g = c >> 2, mt = c & 3, nt = k;
        u.pm = g * 4 + mt; u.pn = nt; u.aux = g; u.A = (const char*)(UH + ((size_t)g * NCH + mt * 256) * KY); u.B = (const char*)(MxT + ((size_t)g * 512 + nt * 256) * KY); return true;
    }
};
struct MoeRange { int base, end, per, wskip, G;
    __device__ __forceinline__ int unit(int idx) const { int u;
        if (per > 0) { const int k = idx / G, c = idx - k * G - wskip; if (c < 0 || k >= per) return -1; u = base + c * per + k; } else u = base + idx;
        return u < end ? u : -1; } };
struct SchedMoeGU {
    static constexpr bool GATHER = true;
    static constexpr int KSPLIT = 1 << 20;
    const bf16* H2; const bf16* WguT; const int* LIST; const LAS int* tt;
    MoeRange R;
    __device__ __forceinline__ int count() const { return MAXTILES * 4; }
    __device__ __forceinline__ bool get(int idx_, UnitX& u) const {
        const int idx = R.unit(idx_); if (idx < 0) return false; const int tile = idx >> 2, pn = idx & 3; const int cls = tt[2 * tile]; if (cls < 0) return false;
        const int grp = cls / 6, pi = cls % 6, e = grp * 4 + ((pn >> 1) ? pair_b(pi) : pair_a(pi));
        u.pm = tile; u.pn = pn; u.aux = cls; u.tic = tt[2 * tile + 1]; u.cnt = tt[512 + cls]; u.A = (const char*)H2; u.B = (const char*)(WguT + ((size_t)e * 512 + (pn & 1) * 256) * DM); return true;
    }
    __device__ __forceinline__ unsigned rowoff(const UnitX& u, int r) const { const int pos = u.tic * 256 + r; const int tok = pos < u.cnt ? LIST[(size_t)u.aux * T + pos] : 0; return (unsigned)tok * (unsigned)(DM * 2); }
};
struct SchedMoeDN {
    static constexpr bool GATHER = false;
    static constexpr int KSPLIT = 1 << 20;
    const bf16* HACT; const bf16* WdT; const LAS int* tt;
    MoeRange R;
    __device__ __forceinline__ int count() const { return MAXTILES * 4; }
    __device__ __forceinline__ bool get(int idx_, UnitX& u) const {
        const int idx = R.unit(idx_); if (idx < 0) return false; const int tile = idx >> 2, pn = idx & 3; const int cls = tt[2 * tile]; if (cls < 0) return false;
        u.pm = tile; u.pn = pn; u.aux = cls; u.tic = tt[2 * tile + 1]; u.cnt = tt[512 + cls]; u.A = (const char*)(HACT + (size_t)tile * 256 * 512); u.B = (const char*)(WdT + ((size_t)cls * 1024 + pn * 256) * 512); return true;
    }
};

struct NoIn {};
struct EpiProj {
    static constexpr bool PAIR = false;
    bf16 *Q, *K, *V, *UH, *GATES; const LAS float* bgate; float* NP;
    struct In { f32x4 b0, b1; };
    __device__ __forceinline__ In load(const UnitX& u, int r, int c) const { In in; const int pn = __builtin_amdgcn_readfirstlane(u.pn);
        if (pn >= 8) { const LAS float* bp = bgate + (pn - 8) * 256 + c; in.b0 = *(const LAS f32x4*)bp; in.b1 = *(const LAS f32x4*)(bp + 4); } else { in.b0 = (f32x4){0.f, 0.f, 0.f, 0.f}; in.b1 = in.b0; } return in; }
    __device__ __forceinline__ void apply(const UnitX& u, int r, int c, const float (&v)[8], const In& in) const {
        const int pn = __builtin_amdgcn_readfirstlane(u.pn); const unsigned row = (unsigned)(u.pm * 256 + r);
        static_assert(WS_K - WS_Q == 32 * MiB && WS_V - WS_K == 32 * MiB, "q | k | v buffers equally spaced");
        if (pn < 6) { bf16* base = Q + (size_t)(pn >> 1) * (size_t)(16u << 20); const float sc = pn < 2 ? C2 : 1.0f; float w[8];
#pragma unroll
            for (int e = 0; e < 8; ++e) w[e] = v[e] * sc;
            store8(base + (row * 512u + (unsigned)((pn & 1) * 256 + c)), w);
            if (pn < 4) { float ss = ((w[0] * w[0] + w[1] * w[1]) + (w[2] * w[2] + w[3] * w[3])) + ((w[4] * w[4] + w[5] * w[5]) + (w[6] * w[6] + w[7] * w[7]));
                ss += __shfl_xor(ss, 16); ss += __shfl_xor(ss, 32);
                if ((c & 24) == 0) NP[row * 32u + (unsigned)((pn >> 1) * 16 + (pn & 1) * 8 + (c >> 5))] = ss; } }
        else if (pn < 8) { const int cc = (pn - 6) * 256 + c, g = cc >> 4, ch0 = cc & 15; const unsigned n = row >> 5, i = row & 31u; store8(UH + (((unsigned)g * NCH + n) * (unsigned)KY + i * 16u + (unsigned)ch0), v); }
        else { const unsigned cc = (unsigned)((pn - 8) * 256 + c); unsigned q[8]; const float bb[8] = {in.b0.x, in.b0.y, in.b0.z, in.b0.w, in.b1.x, in.b1.y, in.b1.z, in.b1.w};
#pragma unroll
            for (int e = 0; e < 8; ++e) q[e] = (unsigned)__builtin_fmaf(sigmoid_b(v[e], bb[e]), 255.0f, 0.5f);
            u32x2 w; w.x = q[0] | (q[1] << 8) | (q[2] << 16) | (q[3] << 24); w.y = q[4] | (q[5] << 8) | (q[6] << 16) | (q[7] << 24);
            *(u32x2*)((unsigned char*)GATES + (row * 2048u + cc)) = w; }
    }
};
struct EpiSsmS {
    static constexpr bool PAIR = false;
    float* S;
    typedef NoIn In;
    __device__ __forceinline__ In load(const UnitX&, int, int) const { return In{}; }
    __device__ __forceinline__ void apply(const UnitX& u, int r, int c, const float (&v)[8], const In&) const {
        if (c >= 128) return;
        float* p = S + ((size_t)u.pm * 256 + r) * 128 + c;
        *(f32x4*)p = (f32x4){v[0], v[1], v[2], v[3]}; *(f32x4*)(p + 4) = (f32x4){v[4], v[5], v[6], v[7]};
    }
};
struct EpiSsmY {
    static constexpr bool PAIR = false;
    bf16* Z;
    typedef NoIn In;
    __device__ __forceinline__ In load(const UnitX&, int, int) const { return In{}; }
    __device__ __forceinline__ void apply(const UnitX& u, int r, int c, const float (&v)[8], const In&) const {
        const int g = u.aux, chunk = (u.pm & 3) * 256 + r, col = u.pn * 256 + c, j = col >> 4, o0 = col & 15; const int token = chunk * LCH + j; float w[8];
#pragma unroll
        for (int e = 0; e < 8; ++e) w[e] = gelu_tanh(v[e]);
        store8(Z + (size_t)token * SW + g * 16 + o0, w);
    }
};
struct EpiGlu {
    static constexpr bool PAIR = false;
    const bf16* Z; bf16* ZZ; const LAS float* bglu;
    struct In { u32x4 z; f32x4 b0, b1; };
    __device__ __forceinline__ In load(const UnitX& u, int r, int c) const { In in; const int row = u.pm * 256 + r, col = u.pn * 256 + c;
        in.z = *(const u32x4*)(Z + (size_t)row * SW + col); in.b0 = *(const LAS f32x4*)(bglu + col); in.b1 = *(const LAS f32x4*)(bglu + col + 4); return in; }
    __device__ __forceinline__ void apply(const UnitX& u, int r, int c, const float (&v)[8], const In& in) const {
        const int row = u.pm * 256 + r, col = u.pn * 256 + c; float w[8];
        const float z[8] = {bf2f(in.z.x & 0xffffu), bf2f(in.z.x >> 16), bf2f(in.z.y & 0xffffu), bf2f(in.z.y >> 16), bf2f(in.z.z & 0xffffu), bf2f(in.z.z >> 16), bf2f(in.z.w & 0xffffu), bf2f(in.z.w >> 16)};
        const float bb[8] = {in.b0.x, in.b0.y, in.b0.z, in.b0.w, in.b1.x, in.b1.y, in.b1.z, in.b1.w};
#pragma unroll
        for (int e = 0; e < 8; ++e) w[e] = z[e] * sigmoid_b(v[e], bb[e]);
        store8(ZZ + (size_t)row * SW + col, w);
    }
};
__device__ __forceinline__ void unpack_u8(const u32x2 w, float (&v)[8]) { const float s = 1.0f / 255.0f;
    v[0] = (float)(w.x & 0xffu) * s; v[1] = (float)((w.x >> 8) & 0xffu) * s; v[2] = (float)((w.x >> 16) & 0xffu) * s; v[3] = (float)(w.x >> 24) * s;
    v[4] = (float)(w.y & 0xffu) * s; v[5] = (float)((w.y >> 8) & 0xffu) * s; v[6] = (float)((w.y >> 16) & 0xffu) * s; v[7] = (float)(w.y >> 24) * s; }
struct EpiOutA {
    static constexpr bool PAIR = false;
    const bf16* GATES; bf16* T1;
    struct In { u32x2 g; };
    __device__ __forceinline__ In load(const UnitX& u, int r, int c) const { In in; in.g = *(const u32x2*)((const unsigned char*)GATES + (size_t)(u.pm * 256 + r) * 2048 + u.pn * 256 + c); return in; }
    __device__ __forceinline__ void apply(const UnitX& u, int r, int c, const float (&v)[8], const In& in) const {
        const int row = u.pm * 256 + r, col = u.pn * 256 + c; float g[8], w[8]; unpack_u8(in.g, g);
#pragma unroll
        for (int e = 0; e < 8; ++e) w[e] = g[e] * v[e];
        store8(T1 + (size_t)row * DM + col, w);
    }
};
struct EpiOutB {
    static constexpr bool PAIR = false;
    const bf16* GATES; const bf16* T1; bf16* MG;
    struct In { u32x2 g; u32x4 t; };
    __device__ __forceinline__ In load(const UnitX& u, int r, int c) const { In in; const int row = u.pm * 256 + r, col = u.pn * 256 + c;
        in.g = *(const u32x2*)((const unsigned char*)GATES + (size_t)row * 2048 + 1024 + col); in.t = *(const u32x4*)(T1 + (size_t)row * DM + col); return in; }
    __device__ __forceinline__ void apply(const UnitX& u, int r, int c, const float (&v)[8], const In& in) const {
        const int row = u.pm * 256 + r, col = u.pn * 256 + c; float g[8], w[8]; unpack_u8(in.g, g);
        const float t[8] = {bf2f(in.t.x & 0xffffu), bf2f(in.t.x >> 16), bf2f(in.t.y & 0xffffu), bf2f(in.t.y >> 16), bf2f(in.t.z & 0xffffu), bf2f(in.t.z >> 16), bf2f(in.t.w & 0xffffu), bf2f(in.t.w >> 16)};
#pragma unroll
        for (int e = 0; e < 8; ++e) w[e] = t[e] + g[e] * v[e];
        store8(MG + (size_t)row * DM + col, w);
    }
};
struct EpiOutAB {
    static constexpr bool PAIR = false, MID = true;
    const unsigned char* GATES; bf16* MG;
    struct In { u32x2 g; };
    struct MidIn { u32x2 g0, g1; };
    __device__ __forceinline__ MidIn mid_load(const UnitX& u, int r, int c) const { MidIn in; const unsigned char* p = GATES + (size_t)(u.pm * 256 + r) * 2048 + u.pn * 256 + c; in.g0 = *(const u32x2*)p; in.g1 = *(const u32x2*)(p + 1024); return in; }
    __device__ __forceinline__ void mid_apply(float (&v)[8], const MidIn& in) const { float g0[8], g1[8]; unpack_u8(in.g0, g0); unpack_u8(in.g1, g1);
#pragma unroll
        for (int e = 0; e < 8; ++e) v[e] *= g0[e] * __builtin_amdgcn_rcpf(fmaxf(g1[e], 1.0f / 512.0f)); }
    __device__ __forceinline__ In load(const UnitX& u, int r, int c) const { In in; in.g = *(const u32x2*)(GATES + (size_t)(u.pm * 256 + r) * 2048 + 1024 + u.pn * 256 + c); return in; }
    __device__ __forceinline__ void apply(const UnitX& u, int r, int c, const float (&v)[8], const In& in) const {
        float g1[8], w[8]; unpack_u8(in.g, g1);
#pragma unroll
        for (int e = 0; e < 8; ++e) w[e] = v[e] * fmaxf(g1[e], 1.0f / 512.0f);
        store8(MG + (size_t)(u.pm * 256 + r) * DM + u.pn * 256 + c, w);
    }
};
struct EpiWout {
    static constexpr bool PAIR = false, ROWJ = true;
    const float* x; bf16* X1B; float* PART; const LAS unsigned char* TB;
    struct In { f32x4 a, b; };
    __device__ __forceinline__ In load(const UnitX& u, int r, int c) const { In in; const size_t off = (size_t)(u.pm * 256 + r) * DM + u.pn * 256 + c; in.a = *(const f32x4*)(x + off); in.b = *(const f32x4*)(x + off + 4); return in; }
    __device__ __forceinline__ void apply2(const UnitX& u, int r, int c, const float (&v0)[8], const float (&v1)[8], const In& i0, const In& i1) const {
        const int fr = r & 15, fq = (c >> 3) & 3, wc = c >> 5; const unsigned row = (unsigned)(u.pm * 256 + r);
        const float xa[2][8] = {{i0.a.x + v0[0], i0.a.y + v0[1], i0.a.z + v0[2], i0.a.w + v0[3], i0.b.x + v0[4], i0.b.y + v0[5], i0.b.z + v0[6], i0.b.w + v0[7]},
                                {i1.a.x + v1[0], i1.a.y + v1[1], i1.a.z + v1[2], i1.a.w + v1[3], i1.b.x + v1[4], i1.b.y + v1[5], i1.b.z + v1[6], i1.b.w + v1[7]}};
        float ss = 0.f; f32x4 lg0 = {0.f, 0.f, 0.f, 0.f}, lg1 = {0.f, 0.f, 0.f, 0.f};
        const LAS unsigned char* t0 = TB + fr * RT_ROWB + c * 2; const LAS unsigned char* t1 = TB + (16 + (fr & 3)) * RT_ROWB + c * 2;
#pragma unroll
        for (int bj = 0; bj < 2; ++bj) { const float (&xv)[8] = xa[bj];
            const unsigned h0 = pk2(xv[0], xv[1]), h1 = pk2(xv[2], xv[3]), h2 = pk2(xv[4], xv[5]), h3 = pk2(xv[6], xv[7]);
            const unsigned l0 = pk2(xv[0] - bf2f(h0 & 0xffffu), xv[1] - bf2f(h0 >> 16)), l1 = pk2(xv[2] - bf2f(h1 & 0xffffu), xv[3] - bf2f(h1 >> 16)),
                           l2 = pk2(xv[4] - bf2f(h2 & 0xffffu), xv[5] - bf2f(h2 >> 16)), l3 = pk2(xv[6] - bf2f(h3 & 0xffffu), xv[7] - bf2f(h3 >> 16));
            *(u32x4*)(X1B + (row * (unsigned)DM + (unsigned)(u.pn * 256 + bj * 128 + c))) = (u32x4){h0, h1, h2, h3};
            ss += ((xv[0] * xv[0] + xv[1] * xv[1]) + (xv[2] * xv[2] + xv[3] * xv[3])) + ((xv[4] * xv[4] + xv[5] * xv[5]) + (xv[6] * xv[6] + xv[7] * xv[7]));
            const bf16x8 xh = __builtin_bit_cast(bf16x8, (u32x4){h0, h1, h2, h3}), xl = __builtin_bit_cast(bf16x8, (u32x4){l0, l1, l2, l3});
            const bf16x8 th0 = *(const LAS bf16x8*)(t0 + bj * 256), tl0 = *(const LAS bf16x8*)(t0 + bj * 256 + 20 * RT_ROWB), th1 = *(const LAS bf16x8*)(t1 + bj * 256), tl1 = *(const LAS bf16x8*)(t1 + bj * 256 + 20 * RT_ROWB);
            lg0 = __builtin_amdgcn_mfma_f32_16x16x32_bf16(th0, xh, lg0, 0, 0, 0); lg0 = __builtin_amdgcn_mfma_f32_16x16x32_bf16(th0, xl, lg0, 0, 0, 0); lg0 = __builtin_amdgcn_mfma_f32_16x16x32_bf16(tl0, xh, lg0, 0, 0, 0);
            lg1 = __builtin_amdgcn_mfma_f32_16x16x32_bf16(th1, xh, lg1, 0, 0, 0); lg1 = __builtin_amdgcn_mfma_f32_16x16x32_bf16(th1, xl, lg1, 0, 0, 0); lg1 = __builtin_amdgcn_mfma_f32_16x16x32_bf16(tl1, xh, lg1, 0, 0, 0); }
        ss += __shfl_xor(ss, 16); ss += __shfl_xor(ss, 32);
        f32x4* p = (f32x4*)PART + ((unsigned)((u.pn * 4 + wc) * 6) * (unsigned)T + row);
        p[(unsigned)fq * (unsigned)T] = lg0; if (fq == 0) p[4u * (unsigned)T] = lg1; if (fq == 1) p[5u * (unsigned)T] = (f32x4){ss, 0.f, 0.f, 0.f};
    }
};
struct EpiMoeGU {
    static constexpr bool PAIR = true;
    bf16* HACT; const float* LPW;
    struct In { f32x4 pw; };
    __device__ __forceinline__ In load(const UnitX& u, int r, int) const { In in; const int pos = u.tic * 256 + r; in.pw = (f32x4){0.f, 0.f, 0.f, 0.f}; if (pos < u.cnt) in.pw = *((const f32x4*)LPW + (size_t)u.aux * T + pos); return in; }
    __device__ __forceinline__ void apply_pair(const UnitX& u, int r, int c, const float (&vg)[8], const float (&vu)[8], const In& in) const {
        const float w = (u.pn >> 1) ? in.pw.y : in.pw.x, rs = in.pw.z; float o[8];
#pragma unroll
        for (int e = 0; e < 8; ++e) { const float gt = vg[e] * rs; o[e] = gt * sigmoidf_(gt) * (vu[e] * rs) * w; }
        store8(HACT + (size_t)(u.pm * 256 + r) * 512 + (u.pn >> 1) * 256 + (u.pn & 1) * 128 + c, o);
    }
};
struct EpiMoeDN {
    static constexpr bool PAIR = false;
    bf16* Y;
    typedef NoIn In;
    __device__ __forceinline__ In load(const UnitX&, int, int) const { return In{}; }
    __device__ __forceinline__ void apply(const UnitX& u, int r, int c, const float (&v)[8], const In&) const { store8(Y + (size_t)(u.pm * 256 + r) * DM + u.pn * 256 + c, v); }
};

namespace pg8 {
constexpr int BM = 256, BK = 64, HALF = 128, HTB = HALF * BK * 2, STAGE_BYTES = 8 * HTB;
__host__ __device__ __forceinline__ int lds_byte(int r, int c) { const int st = (r >> 4) * 2 + (c >> 5), rr = r & 15, cc = c & 31, ob = rr * 64 + cc * 2; return st * 1024 + (ob ^ (((ob >> 9) & 1) << 5)); }
__host__ __device__ __forceinline__ void stage_rc(int b, int& R, int& C) { const int st = b / 1024, sb = b % 1024, swz = sb ^ (((sb >> 9) & 1) << 5); R = (st >> 1) * 16 + swz / 64; C = (st & 1) * 32 + (swz % 64) / 2; }
__host__ __device__ __forceinline__ int perm32(int rho) { const int n = rho >> 4, i = rho & 15; return 8 * (i >> 2) + 4 * n + (i & 3); }

template <class Epi, class = void> struct HasMid { static constexpr bool value = false; };
template <class Epi> struct HasMid<Epi, decltype((void)Epi::MID)> { static constexpr bool value = Epi::MID; };
template <class Epi, class = void> struct HasRowJ { static constexpr bool value = false; };
template <class Epi> struct HasRowJ<Epi, decltype((void)Epi::ROWJ)> { static constexpr bool value = Epi::ROWJ; };
template <class Epi> struct EpiAdapt {
    static constexpr bool PERM = true, MID = HasMid<Epi>::value;
    Epi E;
    __device__ __forceinline__ void mid(f32x4 (&acc)[2][2][4][2], const UnitX& u, int wr, int wc, int fr, int fq) const {
        if constexpr (MID) { asm volatile("" : "+v"(fr), "+v"(fq));
            const int c = wc * 32 + 8 * fq;
#pragma unroll
            for (int ai = 0; ai < 2; ++ai) { typename Epi::MidIn in[4][2];
#pragma unroll
                for (int m = 0; m < 4; ++m)
#pragma unroll
                    for (int bj = 0; bj < 2; ++bj) in[m][bj] = E.mid_load(u, ai * HALF + wr * 64 + m * 16 + fr, bj * HALF + c);
#pragma unroll
                for (int m = 0; m < 4; ++m)
#pragma unroll
                    for (int bj = 0; bj < 2; ++bj) { f32x4& a0 = acc[ai][bj][m][0]; f32x4& a1 = acc[ai][bj][m][1]; float v[8] = {a0[0], a0[1], a0[2], a0[3], a1[0], a1[1], a1[2], a1[3]};
                        E.mid_apply(v, in[m][bj]); a0 = (f32x4){v[0], v[1], v[2], v[3]}; a1 = (f32x4){v[4], v[5], v[6], v[7]}; } } }
    }
    __device__ __forceinline__ void operator()(const f32x4 (&acc)[2][2][4][2], const UnitX& u, int wr, int wc, int fr, int fq) const {
        asm volatile("" : "+v"(fr), "+v"(fq));
        const int c = wc * 32 + 8 * fq;
#pragma unroll
        for (int ai = 0; ai < 2; ++ai) {
            if constexpr (Epi::PAIR) { typename Epi::In in[4];
#pragma unroll
                for (int m = 0; m < 4; ++m) in[m] = E.load(u, ai * HALF + wr * 64 + m * 16 + fr, c);
#pragma unroll
                for (int m = 0; m < 4; ++m) { const int r = ai * HALF + wr * 64 + m * 16 + fr; const f32x4 g0 = acc[ai][0][m][0], g1 = acc[ai][0][m][1], u0 = acc[ai][1][m][0], u1 = acc[ai][1][m][1];
                    const float vg[8] = {g0[0], g0[1], g0[2], g0[3], g1[0], g1[1], g1[2], g1[3]}, vu[8] = {u0[0], u0[1], u0[2], u0[3], u1[0], u1[1], u1[2], u1[3]};
                    E.apply_pair(u, r, c, vg, vu, in[m]); } }
            else if constexpr (HasRowJ<Epi>::value) {
#pragma unroll
                for (int mp = 0; mp < 4; mp += 2) { typename Epi::In in[2][2];
#pragma unroll
                    for (int m = 0; m < 2; ++m)
#pragma unroll
                        for (int bj = 0; bj < 2; ++bj) in[m][bj] = E.load(u, ai * HALF + wr * 64 + (mp + m) * 16 + fr, bj * HALF + c);
#pragma unroll
                    for (int m = 0; m < 2; ++m) { const int r = ai * HALF + wr * 64 + (mp + m) * 16 + fr; const f32x4 a0 = acc[ai][0][mp + m][0], a1 = acc[ai][0][mp + m][1], b0 = acc[ai][1][mp + m][0], b1 = acc[ai][1][mp + m][1];
                        const float v0[8] = {a0[0], a0[1], a0[2], a0[3], a1[0], a1[1], a1[2], a1[3]}, v1[8] = {b0[0], b0[1], b0[2], b0[3], b1[0], b1[1], b1[2], b1[3]};
                        E.apply2(u, r, c, v0, v1, in[m][0], in[m][1]); } } }
            else { typename Epi::In in[4][2];
#pragma unroll
                for (int m = 0; m < 4; ++m)
#pragma unroll
                    for (int bj = 0; bj < 2; ++bj) in[m][bj] = E.load(u, ai * HALF + wr * 64 + m * 16 + fr, bj * HALF + c);
#pragma unroll
                for (int m = 0; m < 4; ++m)
#pragma unroll
                    for (int bj = 0; bj < 2; ++bj) { const int r = ai * HALF + wr * 64 + m * 16 + fr; const f32x4 a0 = acc[ai][bj][m][0], a1 = acc[ai][bj][m][1];
                        const float v[8] = {a0[0], a0[1], a0[2], a0[3], a1[0], a1[1], a1[2], a1[3]}; E.apply(u, r, bj * HALF + c, v, in[m][bj]); } } }
    }
};

template <class Epi, class Sched, bool ALIGN_EPI, bool SP2>
__device__ __forceinline__ void gemm_phase(LAS unsigned char* lds, const GemmDims d, const Sched& S, const Epi& E, const int G, const int cidx) {
    int tid = threadIdx.x; asm volatile("" : "+v"(tid));
    const int wid = __builtin_amdgcn_readfirstlane(tid >> 6), lane = tid & 63, wr = wid >> 2, wc = wid & 3, fr = lane & 15, fq = lane >> 4;
    const int K = d.K, nt = K / BK;
    unsigned voffB[2]; int RA[2], CA2[2];
#pragma unroll
    for (int i = 0; i < 2; ++i) { int R, C; stage_rc(tid * 16 + i * 8192, R, C); const int Rb = Epi::PERM ? ((R & ~31) + perm32(R & 31)) : R;
        RA[i] = R; CA2[i] = C * 2; voffB[i] = (unsigned)(Rb * d.ldb + C) * 2u; }
    const size_t kstep = (size_t)(BK * 2);
    const size_t hstepB = (size_t)HALF * d.ldb * 2;
#define PG8_AOFF(dst, unit) do { _Pragma("unroll") for (int h_ = 0; h_ < 2; ++h_) _Pragma("unroll") for (int i_ = 0; i_ < 2; ++i_) { \
        if constexpr (Sched::GATHER) dst[h_][i_] = S.rowoff(unit, h_ * HALF + RA[i_]) + (unsigned)CA2[i_]; else dst[h_][i_] = (unsigned)((h_ * HALF + RA[i_]) * d.lda) * 2u + (unsigned)CA2[i_]; } } while (0)
    const unsigned ldsw = (unsigned)wid * 1024u;
    const int aoff = lds_byte(wr * 64 + fr, fq * 8), boff = lds_byte(wc * 32 + fr, fq * 8);
#define PG8_SA(b, h) (((b) * 2 + (h)) * HTB)
#define PG8_SB(b, h) ((4 + (b) * 2 + (h)) * HTB)
#define PG8_STAGE(bufoff, gbase, voff) do { _Pragma("unroll") for (int _i = 0; _i < 2; ++_i) \
        __builtin_amdgcn_global_load_lds((const unsigned*)((const char*)(gbase) + (voff)[_i]), (LAS unsigned*)(lds + (bufoff) + ldsw + _i * 8192), 16, 0, 0); } while (0)
#define PG8_LDA(dst, b, h) do { _Pragma("unroll") for (int m = 0; m < 4; ++m) _Pragma("unroll") for (int k = 0; k < 2; ++k) dst[m][k] = *(const LAS bf16x8*)(lds + PG8_SA(b, h) + aoff + m * 2048 + k * 1024); } while (0)
#define PG8_LDB(dst, b, h) do { _Pragma("unroll") for (int n = 0; n < 2; ++n) _Pragma("unroll") for (int k = 0; k < 2; ++k) dst[n][k] = *(const LAS bf16x8*)(lds + PG8_SB(b, h) + boff + n * 2048 + k * 1024); } while (0)
#define PG8_MMA(ai, bj, At, Bt) do { __builtin_amdgcn_s_setprio(1); _Pragma("unroll") for (int m = 0; m < 4; ++m) _Pragma("unroll") for (int n = 0; n < 2; ++n) _Pragma("unroll") for (int k = 0; k < 2; ++k) \
        acc[ai][bj][m][n] = __builtin_amdgcn_mfma_f32_16x16x32_bf16(Bt[n][k], At[m][k], acc[ai][bj][m][n], 0, 0, 0); __builtin_amdgcn_s_setprio(0); } while (0)
#define PG8_WAIT_V(n) asm volatile("s_waitcnt vmcnt(" #n ")" ::: "memory")
#define PG8_WAIT_L(n) asm volatile("s_waitcnt lgkmcnt(" #n ")" ::: "memory")
#define PG8_BAR __builtin_amdgcn_s_barrier()
#define PG8_SCHED __builtin_amdgcn_sched_barrier(0)
    UnitX cur, nxt; int ui = 0;
    if (!S.get(cidx, cur)) return;
    f32x4 acc[2][2][4][2];
#pragma unroll
    for (int a = 0; a < 2; ++a)
#pragma unroll
        for (int b = 0; b < 2; ++b)
#pragma unroll
            for (int m = 0; m < 4; ++m)
#pragma unroll
                for (int n = 0; n < 2; ++n) acc[a][b][m][n] = (f32x4){0.f, 0.f, 0.f, 0.f};
    bf16x8 At[4][2], B0[2][2], B1[2][2];
    const char* cA = cur.A; const char* cB = cur.B;
    constexpr int KS = Sched::KSPLIT;
    const char* cA2 = KS < 1024 ? cur.A2 : cA; const char* cB2 = KS < 1024 ? cur.B2 : cB;
    unsigned vA[2][2], nvA[2][2]; PG8_AOFF(vA, cur);
    static_assert(SP2, "this port keeps the SP2 loop only");
    {
        PG8_STAGE(PG8_SB(0, 0), cB, voffB); PG8_STAGE(PG8_SB(0, 1), cB + hstepB, voffB); PG8_STAGE(PG8_SA(0, 0), cA, vA[0]); PG8_STAGE(PG8_SA(0, 1), cA, vA[1]);
        if (wr == 1) PG8_BAR;
        PG8_WAIT_V(2); PG8_BAR;
        PG8_STAGE(PG8_SB(1, 0), cB + kstep, voffB); PG8_STAGE(PG8_SA(1, 0), cA + kstep, vA[0]); PG8_STAGE(PG8_SB(1, 1), cB + hstepB + kstep, voffB);
        PG8_WAIT_V(6); PG8_BAR;
    }
    for (;;) {
        const bool has_next = S.get((ui + 1) * G + cidx, nxt);
        const char* nA = has_next ? nxt.A : cA; const char* nB = has_next ? nxt.B : cB;
        if (has_next) { PG8_AOFF(nvA, nxt); } else {
#pragma unroll
            for (int h_ = 0; h_ < 2; ++h_)
#pragma unroll
                for (int i_ = 0; i_ < 2; ++i_) nvA[h_][i_] = vA[h_][i_]; }
        for (int t = 0; t < nt; t += 2) {
            const bool last = (t == nt - 2);
            if constexpr (Epi::MID) { if (t == KS) E.mid(acc, cur, wr, wc, fr, fq); }
            const char* a1 = ((t + 1 >= KS) ? cA2 : cA) + (size_t)(t + 1) * kstep;
            const char* a2 = last ? nA : ((t + 2 >= KS) ? cA2 : cA) + (size_t)(t + 2) * kstep; const char* b2 = last ? nB : ((t + 2 >= KS) ? cB2 : cB) + (size_t)(t + 2) * kstep;
            const char* a3 = a2 + kstep; const char* b3 = b2 + kstep;
            unsigned wA0[2], wA1[2];
#pragma unroll
            for (int i_ = 0; i_ < 2; ++i_) { wA0[i_] = last ? nvA[0][i_] : vA[0][i_]; wA1[i_] = last ? nvA[1][i_] : vA[1][i_]; }
            PG8_LDB(B0, 0, 0); PG8_LDB(B1, 0, 1); PG8_SCHED; PG8_LDA(At, 0, 0); PG8_STAGE(PG8_SA(1, 1), a1, vA[1]);
            PG8_WAIT_V(8); PG8_WAIT_L(0); PG8_BAR; PG8_MMA(0, 0, At, B0); PG8_MMA(0, 1, At, B1); PG8_BAR; PG8_SCHED;
            PG8_LDA(At, 0, 1); PG8_STAGE(PG8_SB(0, 0), b2, voffB); PG8_STAGE(PG8_SB(0, 1), b2 + hstepB, voffB); PG8_STAGE(PG8_SA(0, 0), a2, wA0);
            PG8_WAIT_V(8); PG8_WAIT_L(0); PG8_BAR; PG8_MMA(1, 0, At, B0); PG8_MMA(1, 1, At, B1); PG8_BAR; PG8_SCHED;
            PG8_LDB(B0, 1, 0); PG8_LDB(B1, 1, 1); PG8_SCHED; PG8_LDA(At, 1, 0); PG8_STAGE(PG8_SA(0, 1), a2, wA1);
            PG8_WAIT_V(8); PG8_WAIT_L(0); PG8_BAR; PG8_MMA(0, 0, At, B0); PG8_MMA(0, 1, At, B1); PG8_BAR; PG8_SCHED;
            PG8_LDA(At, 1, 1); PG8_STAGE(PG8_SB(1, 0), b3, voffB); PG8_STAGE(PG8_SB(1, 1), b3 + hstepB, voffB); PG8_STAGE(PG8_SA(1, 0), a3, wA0);
            PG8_WAIT_V(8); PG8_WAIT_L(0); PG8_BAR; PG8_MMA(1, 0, At, B0); PG8_MMA(1, 1, At, B1); PG8_BAR; PG8_SCHED;
        }
        if constexpr (ALIGN_EPI) { if (wr == 0) PG8_BAR; }
        E(acc, cur, wr, wc, fr, fq);
        if (!has_next) break;
#pragma unroll
        for (int a = 0; a < 2; ++a)
#pragma unroll
            for (int b = 0; b < 2; ++b)
#pragma unroll
                for (int m = 0; m < 4; ++m)
#pragma unroll
                    for (int n = 0; n < 2; ++n) acc[a][b][m][n] = (f32x4){0.f, 0.f, 0.f, 0.f};
        cur = nxt; cA = nA; cB = nB; ++ui; if constexpr (KS < 1024) { cA2 = cur.A2; cB2 = cur.B2; }
#pragma unroll
        for (int h_ = 0; h_ < 2; ++h_)
#pragma unroll
            for (int i_ = 0; i_ < 2; ++i_) vA[h_][i_] = nvA[h_][i_];
        if constexpr (ALIGN_EPI) { if (wr == 1) PG8_BAR; }
    }
    PG8_WAIT_V(0);
    if constexpr (!ALIGN_EPI) { if (wr == 0) PG8_BAR; }
    PG8_BAR;
#undef PG8_SA
#undef PG8_SB
#undef PG8_STAGE
#undef PG8_LDA
#undef PG8_LDB
#undef PG8_MMA
#undef PG8_WAIT_V
#undef PG8_WAIT_L
#undef PG8_BAR
#undef PG8_SCHED
#undef PG8_AOFF
}
}
template <class Sched, class Epi> __device__ __forceinline__ void run_gemm(LAS unsigned char* lds, const GemmDims d, const Sched& S, const Epi& E) {
    pg8::EpiAdapt<Epi> EA{E};
    pg8::gemm_phase<pg8::EpiAdapt<Epi>, Sched, true, true>(lds, d, S, EA, (int)gridDim.x, (int)blockIdx.x);
}

constexpr int NWAVES = 8, NTHR = 512;
constexpr int LDS_BYTES = 163840;
constexpr int RING_BYTES = 131072;
constexpr int CW_GCNT = 9216;
constexpr int BIAS_OFF = 139264;
constexpr int RT_OFF = RING_BYTES + 4096;
static_assert(RT_OFF + 40 * RT_ROWB <= LDS_BYTES, "router table fits");
constexpr int TT_OFF = RING_BYTES + 1024;

struct Frame { LAS unsigned char* lds; int tid, lane, wave, vcu, G; };
#define LAUNDER(F) do { (F).tid = (int)threadIdx.x; (F).lane = (int)threadIdx.x & 63; asm volatile("" : "+v"((F).tid), "+v"((F).lane)); } while (0)

__device__ __forceinline__ void transpose_item(const float* W, int ldw, int k0, int scol0, bf16* WT, int ldd, int drow0, int dcol0, LAS float* scr, int lane, bf16* WT2 = nullptr, int dcol2 = 0, bf16* WT3 = nullptr, int dcol3 = 0, const float* ks = nullptr) {
    { f32x4 t[8];
#pragma unroll
        for (int i = 0; i < 8; ++i) t[i] = *(const f32x4*)(W + (size_t)(k0 + 8 * i + (lane >> 3)) * ldw + scol0 + (lane & 7) * 4);
        if (ks) { float sc[8];
#pragma unroll
            for (int i = 0; i < 8; ++i) sc[i] = ks[k0 + 8 * i + (lane >> 3)];
#pragma unroll
            for (int i = 0; i < 8; ++i) t[i] = t[i] * sc[i]; }
#pragma unroll
        for (int i = 0; i < 8; ++i) { LAS float* d = scr + (8 * i + (lane >> 3)) * 33 + (lane & 7) * 4; d[0] = t[i].x; d[1] = t[i].y; d[2] = t[i].z; d[3] = t[i].w; } }
    asm volatile("s_waitcnt lgkmcnt(0)" ::: "memory");
    const int c = lane & 7;
#pragma unroll
    for (int j = 0; j < 4; ++j) { const int n = (lane >> 3) + 8 * j; const LAS float* s = scr + (8 * c) * 33 + n;
        u32x4 o; o.x = pk2(s[0 * 33], s[1 * 33]); o.y = pk2(s[2 * 33], s[3 * 33]); o.z = pk2(s[4 * 33], s[5 * 33]); o.w = pk2(s[6 * 33], s[7 * 33]);
        *(u32x4*)(WT + (size_t)(drow0 + n) * ldd + dcol0 + k0 + 8 * c) = o;
        if (WT2) *(u32x4*)(WT2 + (size_t)(drow0 + n) * ldd + dcol2 + k0 + 8 * c) = o;
        if (WT3) *(u32x4*)(WT3 + (size_t)(drow0 + n) * ldd + dcol3 + k0 + 8 * c) = o; }
    asm volatile("s_waitcnt lgkmcnt(0)" ::: "memory");
}

__device__ __forceinline__ void p0_weights(const Frame& Fin_, const Params& P, const int part) {
    Frame F = Fin_; LAUNDER(F);
    LAS float* scr = (LAS float*)(F.lds + F.wave * 16384);
    unsigned char* ws = P.ws;
    constexpr int I_IN = 16 * 128, I_OA = 8 * 32, I_GLU = 8 * 16, I_OB = 8 * 32, I_O = 16 * 32, I_G = 16 * 16 * 8, I_U = I_G, I_D = 16 * 4 * 32;
    constexpr int NEARLY = I_IN + I_OA + I_GLU + I_OB + I_O, NITEMS = NEARLY + I_G + I_U + I_D;
    const int gw = part == 0 ? F.vcu * NWAVES + F.wave : ((int)blockIdx.x - 128) * NWAVES + F.wave, NGW = part == 0 ? F.G * NWAVES : (F.G - 128) * NWAVES;
    for (int it = (part == 0 ? 0 : NEARLY) + gw; it < (part == 0 ? NEARLY : NITEMS); it += NGW) {
        int r = it;
        if (r < I_IN) { const int kb = r / 128, nb = r % 128, n0 = nb * 32; transpose_item(P.in[2], WIN_LD, kb * 64, n0 + (n0 >= 1536 ? 8 : 0), (bf16*)(ws + WS_WIN), 1024, n0, 0, scr, F.lane); continue; } r -= I_IN;
        if (r < I_OA) { const int kb = r / 32, nb = r % 32; transpose_item(P.in[5], 1024, kb * 64, nb * 32, (bf16*)(ws + WS_WOA), 512, nb * 32, 0, scr, F.lane); continue; } r -= I_OA;
        if (r < I_GLU) { const int kb = r / 16, nb = r % 16; transpose_item(P.in[14], 512, kb * 64, nb * 32, (bf16*)(ws + WS_WGLU), 512, nb * 32, 0, scr, F.lane); continue; } r -= I_GLU;
        if (r < I_OB) { const int kb = r / 32, nb = r % 32; transpose_item(P.in[16], 1024, kb * 64, nb * 32, (bf16*)(ws + WS_WOB), 512, nb * 32, 0, scr, F.lane); continue; } r -= I_OB;
        if (r < I_O) { const int kb = r / 32, nb = r % 32; transpose_item(P.in[17], 1024, kb * 64, nb * 32, (bf16*)(ws + WS_WO), 1024, nb * 32, 0, scr, F.lane); continue; } r -= I_O;
        if (r < I_G + I_U) { const int isup = r >= I_G; if (isup) r -= I_G; const int e = r / 128, rr = r % 128, kb = rr / 8, nb = rr % 8, j0 = nb * 32;
            const float* W = (isup ? P.in[24] : P.in[23]) + (size_t)e * 1024 * 256;
            transpose_item(W, 256, kb * 64, j0, (bf16*)(ws + WS_WGU) + (size_t)e * 512 * 1024, 1024, (j0 >> 7) * 256 + isup * 128 + (j0 & 127), 0, scr, F.lane, nullptr, 0, nullptr, 0, P.in[18]); continue; } r -= I_G + I_U;
        { const int e = r / 128, r2 = r % 128, kb = r2 / 32, nb = r2 % 32; const int grp = e >> 2, j = e & 3;
            bf16* dst[3]; int dcol[3]; int nd = 0;
#pragma unroll
            for (int o = 0; o < 4; ++o) if (o != j) { const int a = o < j ? o : j, b = o < j ? j : o; dst[nd] = (bf16*)(ws + WS_WD) + (size_t)(grp * 6 + pair_idx(a, b)) * 1024 * 512; dcol[nd] = (j == a) ? 0 : 256; ++nd; }
            transpose_item(P.in[25] + (size_t)e * 256 * 1024, 1024, kb * 64, nb * 32, dst[0], 512, nb * 32, dcol[0], scr, F.lane, dst[1], dcol[1], dst[2], dcol[2]); }
    }
}

__device__ __forceinline__ void p0_stage_wf(const Frame& Fin_, const Params& P) {
    Frame F = Fin_; LAUNDER(F);
    LAS float* WfT = (LAS float*)F.lds; const float* win = P.in[2];
    for (int k = F.tid; k < DM; k += NTHR) { const float* wr = win + (size_t)k * WIN_LD + 1536; const f32x4 w0 = *(const f32x4*)wr, w1 = *(const f32x4*)(wr + 4);
        WfT[0 * DM + k] = w0.x; WfT[1 * DM + k] = w0.y; WfT[2 * DM + k] = w0.z; WfT[3 * DM + k] = w0.w; WfT[4 * DM + k] = w1.x; WfT[5 * DM + k] = w1.y; WfT[6 * DM + k] = w1.z; WfT[7 * DM + k] = w1.w; }
    __syncthreads();
}
__device__ __forceinline__ void p0_row2(const Frame& F, const Params& P, int m0, int m1, f32x4 (&v)[2][4]) {
    const float* gmix = P.in[1]; const float* bf = P.in[3];
    const LAS f32x4* WfT = (const LAS f32x4*)F.lds;
    float rs[2]; const int mm[2] = {m0, m1};
#pragma unroll
    for (int q = 0; q < 2; ++q) { float ss = 0.f;
#pragma unroll
        for (int j = 0; j < 4; ++j) ss += (v[q][j].x * v[q][j].x + v[q][j].y * v[q][j].y) + (v[q][j].z * v[q][j].z + v[q][j].w * v[q][j].w);
        rs[q] = 1.0f / sqrtf(wave_sum(ss) * (1.0f / DM) + EPS); }
    float f[2][8];
#pragma unroll
    for (int q = 0; q < 2; ++q)
#pragma unroll
        for (int h = 0; h < 8; ++h) f[q][h] = 0.f;
#pragma unroll
    for (int j = 0; j < 4; ++j) { const f32x4 g = ((const f32x4*)gmix)[F.lane + 64 * j];
#pragma unroll
        for (int q = 0; q < 2; ++q) { v[q][j] = v[q][j] * rs[q] * g; u32x2 w; w.x = pk2(v[q][j].x, v[q][j].y); w.y = pk2(v[q][j].z, v[q][j].w);
            ((u32x2*)((bf16*)(P.ws + WS_XN) + (size_t)mm[q] * DM) + F.lane)[64 * j] = w; }
#pragma unroll
        for (int h = 0; h < 8; ++h) { const f32x4 wv = WfT[h * (DM / 4) + 64 * j + F.lane];
#pragma unroll
            for (int q = 0; q < 2; ++q) f[q][h] += (v[q][j].x * wv.x + v[q][j].y * wv.y) + (v[q][j].z * wv.z + v[q][j].w * wv.w); } }
    const bool b5 = (F.lane & 32) != 0, b4 = (F.lane & 16) != 0, b3 = (F.lane & 8) != 0;
#pragma unroll
    for (int q = 0; q < 2; ++q) { float r4[4], r2[2], r1;
#pragma unroll
        for (int i = 0; i < 4; ++i) { const float keep = b5 ? f[q][i + 4] : f[q][i], send = b5 ? f[q][i] : f[q][i + 4]; r4[i] = keep + __shfl_xor(send, 32); }
#pragma unroll
        for (int i = 0; i < 2; ++i) { const float keep = b4 ? r4[i + 2] : r4[i], send = b4 ? r4[i] : r4[i + 2]; r2[i] = keep + __shfl_xor(send, 16); }
        { const float keep = b3 ? r2[1] : r2[0], send = b3 ? r2[0] : r2[1]; r1 = keep + __shfl_xor(send, 8); }
        r1 += __shfl_xor(r1, 4); r1 += __shfl_xor(r1, 2); r1 += __shfl_xor(r1, 1);
        if ((F.lane & 7) == 0) { const int h = (b5 ? 4 : 0) + (b4 ? 2 : 0) + (b3 ? 1 : 0); const float val = r1 + bf[h]; const float xe = __expf(-fabsf(val)); const float ls = fminf(val, 0.f) - (xe < 1e-3f ? xe * (1.0f - 0.5f * xe) : __logf(1.0f + xe));
            const int b = mm[q] / SEQ, s = mm[q] % SEQ; ((float*)(P.ws + WS_LF))[((size_t)b * NH + h) * SEQ + s] = ls * LOG2E; } }
}

__device__ __forceinline__ void p0_ssm_group(const Frame& Fin_, const Params& P, int g, int part) {
    Frame F = Fin_; LAUNDER(F);
    typedef float f32x2 __attribute__((ext_vector_type(2)));
    constexpr int CMS = 65;
    LAS f32x2* AP = (LAS f32x2*)(F.lds);
    LAS f32x2* CM = (LAS f32x2*)(F.lds + 33 * 64 * 8);
    LAS f32x2* BB = (LAS f32x2*)(F.lds + 33 * 64 * 8 + 16 * CMS * 8);
    LAS float* KT = (LAS float*)(F.lds + 33 * 64 * 8 + 16 * CMS * 8 + 8192);
    const float* lre = P.in[6]; const float* lim = P.in[7]; const float* lstep = P.in[8]; const float* bre = P.in[9]; const float* bim = P.in[10];
    const float* cre = P.in[11]; const float* cim = P.in[12]; const float* dsk = P.in[13];
    const float dtf = expf(lstep[g]);
    if (F.tid < 64) { const int p = F.tid; const double dt = (double)dtf, lr = (double)lre[g * 64 + p], li = (double)lim[g * 64 + p];
        const double mg = exp(lr * dt), ph = li * dt; const double a1r = mg * cos(ph), a1i = mg * sin(ph); double ar = 1.0, ai = 0.0;
        for (int d = 0; d <= LCH; ++d) { AP[d * 64 + p] = (f32x2){(float)ar, (float)ai}; const double nr = ar * a1r - ai * a1i, ni = ar * a1i + ai * a1r; ar = nr; ai = ni; } }
    for (int idx = F.tid; idx < 1024; idx += NTHR) { { const int o = idx >> 6, p = idx & 63; CM[o * CMS + p] = (f32x2){cre[(g * 16 + o) * 64 + p], cim[(g * 16 + o) * 64 + p]}; }
        { const int p = idx >> 4, c = idx & 15; const float lr = lre[g * 64 + p], li = lim[g * 64 + p];
          const float mag = expf(lr * dtf); float sn, cs; sincosf(li * dtf, &sn, &cs); const float are = mag * cs, aim = mag * sn, den = lr * lr + li * li, nre = are - 1.0f;
          const float zre = (nre * lr + aim * li) / den, zim = (aim * lr - nre * li) / den; const float br = bre[(g * 64 + p) * 16 + c], bi = bim[(g * 64 + p) * 16 + c];
          BB[idx] = (f32x2){zre * br - zim * bi, zre * bi + zim * br}; } }
    __syncthreads();
    { const int d = F.tid >> 4, o = F.tid & 15; float acc[16];
#pragma unroll
        for (int c = 0; c < 16; ++c) acc[c] = 0.f;
#pragma unroll 4
        for (int p = 0; p < 64; ++p) { const f32x2 a = AP[d * 64 + p], cm = CM[o * CMS + p]; const float car = cm.x * a.x - cm.y * a.y, cai = cm.x * a.y + cm.y * a.x;
#pragma unroll
            for (int c = 0; c < 16; ++c) { const f32x2 bb = BB[p * 16 + c]; acc[c] += car * bb.x - cai * bb.y; } }
        if (d == 0) acc[o] += dsk[g * 16 + o];
#pragma unroll
        for (int c = 0; c < 16; ++c) KT[(d * 16 + o) * 16 + c] = acc[c]; }
    __syncthreads();
    bf16* Mx = (bf16*)(P.ws + WS_MX) + (size_t)g * 512 * KY;
    for (int idx = F.tid; idx < 64 * 80; idx += NTHR) { const int n = part * 64 + idx / 80, k0 = (idx % 80) * 8, j = n >> 4, o = n & 15; float v[8];
        if (k0 < 512) { const int i = k0 >> 4, c0 = k0 & 15;
#pragma unroll
            for (int e = 0; e < 8; ++e) v[e] = (i <= j) ? KT[((j - i) * 16 + o) * 16 + c0 + e] : 0.f; }
        else { const int kk = k0 - 512, ri = kk >> 6, p0 = kk & 63;
#pragma unroll
            for (int e = 0; e < 8; ++e) { const f32x2 a = AP[(j + 1) * 64 + p0 + e], cm = CM[o * CMS + p0 + e]; v[e] = ri == 0 ? (cm.x * a.x - cm.y * a.y) : -(cm.x * a.y + cm.y * a.x); } }
        store8(Mx + (size_t)n * KY + k0, v); }
    bf16* Ws = (bf16*)(P.ws + WS_WS) + (size_t)g * 128 * 512;
    for (int idx = F.tid; idx < 16 * 64; idx += NTHR) { const int n = part * 16 + (idx >> 6), k0 = (idx & 63) * 8, ri = n >> 6, p = n & 63, i = k0 >> 4, c0 = k0 & 15; float v[8]; const f32x2 a = AP[(LCH - 1 - i) * 64 + p];
#pragma unroll
        for (int e = 0; e < 8; ++e) { const f32x2 bb = BB[p * 16 + c0 + e]; v[e] = ri == 0 ? (a.x * bb.x - a.y * bb.y) : (a.x * bb.y + a.y * bb.x); }
        store8(Ws + (size_t)n * 512 + k0, v); }
    if (part == 0 && F.tid < 64) { const f32x2 a = AP[LCH * 64 + F.tid]; float* AL = (float*)(P.ws + WS_AL) + (g * 64 + F.tid) * 2; AL[0] = a.x; AL[1] = a.y; }
    __syncthreads();
}

constexpr unsigned REP_PRO = 0u;
__device__ __forceinline__ void p0_prologue(const Frame& Fin_, const Params& P) {
    Frame F = Fin_; LAUNDER(F);
    for (int r_ = 0; r_ < 1 + (int)(REP_PRO & 1u); ++r_) p0_ssm_group(F, P, F.vcu >> 3, F.vcu & 7);
    for (int r_ = 0; r_ < 1 + (int)((REP_PRO >> 1) & 1u); ++r_) { p0_weights(F, P, 0); __syncthreads(); }
    p0_stage_wf(F, P);
    const int gw = F.vcu * NWAVES + F.wave, NGW = F.G * NWAVES;
    for (int r_ = 0; r_ < 1 + (int)((REP_PRO >> 2) & 1u); ++r_) {
        f32x4 nv[2][4];
#pragma unroll
        for (int q = 0; q < 2; ++q)
#pragma unroll
            for (int j = 0; j < 4; ++j) nv[q][j] = ((const f32x4*)(P.in[0] + (size_t)(gw + q * NGW) * DM) + F.lane)[64 * j];
        for (int m = gw; m < T; m += 2 * NGW) { f32x4 v[2][4];
#pragma unroll
            for (int q = 0; q < 2; ++q)
#pragma unroll
                for (int j = 0; j < 4; ++j) v[q][j] = nv[q][j];
            if (m + 2 * NGW < T) {
#pragma unroll
                for (int q = 0; q < 2; ++q)
#pragma unroll
                    for (int j = 0; j < 4; ++j) nv[q][j] = ((const f32x4*)(P.in[0] + (size_t)(m + (2 + q) * NGW) * DM) + F.lane)[64 * j]; }
            p0_row2(F, P, m, m + NGW, v); } }
}

__device__ __forceinline__ void p_cumsum(const Frame& Fin_, const Params& P) {
    Frame F = Fin_; LAUNDER(F);
    LAS float* part = (LAS float*)F.lds;
    for (int seq = (int)blockIdx.x - 128; seq < BATCH * NH; seq += 32) {
        const float* src = (const float*)(P.ws + WS_LF) + (size_t)seq * SEQ + F.tid * 16; float* dst = (float*)(P.ws + WS_CK2) + (size_t)seq * SEQ + F.tid * 16;
        float v[16]; float s = 0.f;
#pragma unroll
        for (int j = 0; j < 4; ++j) { const f32x4 t = ((const f32x4*)src)[j]; v[4 * j] = t.x; v[4 * j + 1] = t.y; v[4 * j + 2] = t.z; v[4 * j + 3] = t.w; }
#pragma unroll
        for (int j = 0; j < 16; ++j) { s += v[j]; v[j] = s; }
        __syncthreads();
        part[F.tid] = s; __syncthreads();
        if (F.tid == 0) { float run = 0.f; for (int i = 0; i < NTHR; ++i) { const float t = part[i]; part[i] = run; run += t; } }
        __syncthreads();
        const float base = part[F.tid];
#pragma unroll
        for (int j = 0; j < 4; ++j) ((f32x4*)dst)[j] = (f32x4){v[4 * j] + base, v[4 * j + 1] + base, v[4 * j + 2] + base, v[4 * j + 3] + base};
    }
}

constexpr int CARRY_WGS = BATCH * SG;
__device__ __forceinline__ void p_carry(const Frame& Fin_, const Params& P) {
    Frame F = Fin_; LAUNDER(F);
    const int cb = (int)blockIdx.x; if (cb >= CARRY_WGS) return;
    typedef float f32x2 __attribute__((ext_vector_type(2)));
    const int b = cb & 3, g = cb >> 2, p = F.lane, seg = F.wave;
    const float* AL = (const float*)(P.ws + WS_AL) + (g * 64 + p) * 2; const float ar = AL[0], ai = AL[1];
    const float* S = (const float*)(P.ws + WS_S) + ((size_t)g * NCH + b * NCHB + seg * 32) * 128 + p;
    bf16* UH = (bf16*)(P.ws + WS_UH) + ((size_t)g * NCH + b * NCHB + seg * 32) * KY + 512 + p;
    float sr[32], si[32];
#pragma unroll
    for (int n = 0; n < 32; ++n) { sr[n] = S[(size_t)n * 128]; si[n] = S[(size_t)n * 128 + 64]; }
    float a32r = ar, a32i = ai;
#pragma unroll
    for (int k = 0; k < 5; ++k) { const float nr = a32r * a32r - a32i * a32i, ni = 2.0f * a32r * a32i; a32r = nr; a32i = ni; }
    float er = 0.f, ei = 0.f;
#pragma unroll
    for (int n = 0; n < 32; ++n) { const float nr = ar * er - ai * ei + sr[n], ni = ar * ei + ai * er + si[n]; er = nr; ei = ni; }
    LAS f32x2* EX = (LAS f32x2*)F.lds;
    EX[seg * 64 + p] = (f32x2){er, ei};
    __syncthreads();
    float hr = 0.f, hi = 0.f;
    for (int s = 0; s < seg; ++s) { const f32x2 e = EX[s * 64 + p]; const float nr = a32r * hr - a32i * hi + e.x, ni = a32r * hi + a32i * hr + e.y; hr = nr; hi = ni; }
#pragma unroll
    for (int n = 0; n < 32; ++n) { UH[(size_t)n * KY] = (bf16)f2bf(hr); UH[(size_t)n * KY + 64] = (bf16)f2bf(hi);
        const float nr = ar * hr - ai * hi + sr[n], ni = ar * hi + ai * hr + si[n]; hr = nr; hi = ni; }
    __syncthreads();
}

__device__ __forceinline__ void p_router(const Frame& Fin_, const Params& P, const bool publish = true) {
    Frame F = Fin_; LAUNDER(F);
    const float* brg = P.in[20]; const float* bre_ = P.in[22];
    LAS f32x4* LOG = (LAS f32x4*)F.lds;
    LAS int* hist = (LAS int*)(F.lds + 4 * 128 * 96);
    LAS int* tcl = hist + 64;
    LAS int* tlr = tcl + 128;
    LAS float* twa = (LAS float*)(tlr + 128);
    if (F.tid < NCLS) hist[F.tid] = 0;
    const int tok0 = F.vcu * (T / 256);
    { const int t = F.tid & 127, qt = F.tid >> 7;
      const f32x4* pp = (const f32x4*)(P.ws + WS_PART) + ((size_t)(qt * 4 * 6) * T + tok0 + t);
      f32x4 v[4][6];
#pragma unroll
      for (int q = 0; q < 4; ++q)
#pragma unroll
          for (int j = 0; j < 6; ++j) v[q][j] = pp[(size_t)(q * 6 + j) * T];
#pragma unroll
      for (int j = 0; j < 6; ++j) LOG[(qt * 128 + t) * 6 + j] = (v[0][j] + v[1][j]) + (v[2][j] + v[3][j]); }
    __syncthreads();
    if (F.tid < T / 256) { const int t = F.tid;
        float lgt[24];
#pragma unroll
        for (int j = 0; j < 6; ++j) { const f32x4 a = (LOG[t * 6 + j] + LOG[(128 + t) * 6 + j]) + (LOG[(256 + t) * 6 + j] + LOG[(384 + t) * 6 + j]); lgt[4 * j] = a.x; lgt[4 * j + 1] = a.y; lgt[4 * j + 2] = a.z; lgt[4 * j + 3] = a.w; }
        const float rs = 1.0f / sqrtf(lgt[20] * (1.0f / DM) + EPS);
#pragma unroll
        for (int e = 0; e < 20; ++e) lgt[e] *= rs;
        const float l0 = lgt[0] + brg[0], l1 = lgt[1] + brg[1], l2 = lgt[2] + brg[2], l3 = lgt[3] + brg[3];
        int gi = 0; float mx = l0; if (l1 > mx) { mx = l1; gi = 1; } if (l2 > mx) { mx = l2; gi = 2; } if (l3 > mx) { mx = l3; gi = 3; }
        const float psel = 1.0f / (expf(l0 - mx) + expf(l1 - mx) + expf(l2 - mx) + expf(l3 - mx));
        float le[4];
#pragma unroll
        for (int k = 0; k < 4; ++k) { const float c0 = lgt[4 + k] + bre_[k], c1 = lgt[8 + k] + bre_[4 + k], c2 = lgt[12 + k] + bre_[8 + k], c3 = lgt[16 + k] + bre_[12 + k]; le[k] = gi == 0 ? c0 : (gi == 1 ? c1 : (gi == 2 ? c2 : c3)); }
        int i0 = 0; float v0 = le[0]; if (le[1] > v0) { v0 = le[1]; i0 = 1; } if (le[2] > v0) { v0 = le[2]; i0 = 2; } if (le[3] > v0) { v0 = le[3]; i0 = 3; }
        int i1 = -1; float v1 = -INFINITY;
#pragma unroll
        for (int k = 0; k < 4; ++k) if (k != i0 && le[k] > v1) { v1 = le[k]; i1 = k; }
        const float e1 = expf(v1 - v0), w0 = psel / (1.0f + e1), w1 = psel * e1 / (1.0f + e1);
        const int a = i0 < i1 ? i0 : i1, bb = i0 < i1 ? i1 : i0; const float wa = i0 < i1 ? w0 : w1, wb = i0 < i1 ? w1 : w0;
        const int cls = gi * 6 + pair_idx(a, bb);
        tcl[t] = cls; twa[4 * t] = wa; twa[4 * t + 1] = wb; twa[4 * t + 2] = rs; tlr[t] = atomicAdd((int*)&hist[cls], 1); }
    __syncthreads();
    if (!publish) return;
    if (F.tid < NCLS) hist[32 + F.tid] = (int)__hip_atomic_fetch_add((unsigned*)(P.ws + WS_CTL) + CW_GCNT + F.tid, (unsigned)hist[F.tid], __ATOMIC_RELAXED, __HIP_MEMORY_SCOPE_AGENT);
    __syncthreads();
    if (F.tid < T / 256) { const int cls = tcl[F.tid], pos = hist[32 + cls] + tlr[F.tid]; const size_t li = (size_t)cls * T + pos;
        ((int*)(P.ws + WS_LIST))[li] = tok0 + F.tid; ((int*)(P.ws + WS_TPOS))[tok0 + F.tid] = (cls << 16) | pos; *((f32x4*)(P.ws + WS_LPW) + li) = (f32x4){twa[4 * F.tid], twa[4 * F.tid + 1], twa[4 * F.tid + 2], 0.f}; }
    __syncthreads();
}

__device__ __forceinline__ void stage_router_table(const Frame& Fin_, const Params& P, const int pn) {
    Frame F = Fin_; LAUNDER(F);
    const float* gffn = P.in[18]; const float* wrg = P.in[19]; const float* wre = P.in[21];
    LAS unsigned char* TH = F.lds + RT_OFF; LAS unsigned char* TL = TH + 20 * RT_ROWB;
    for (int idx = F.tid; idx < 20 * 256; idx += NTHR) { const int n = idx >> 8, kc = idx & 255, k = pn * 256 + kc; const float w = (n < 4 ? wrg[(size_t)k * 4 + n] : wre[(size_t)k * 16 + (n - 4)]) * gffn[k];
        const unsigned h = f2bf(w); const unsigned l = f2bf(w - bf2f(h)); *(LAS bf16*)(TH + n * RT_ROWB + kc * 2) = (bf16)h; *(LAS bf16*)(TL + n * RT_ROWB + kc * 2) = (bf16)l; }
    __syncthreads();
}

__device__ __forceinline__ void moe_tile_table(const Frame& Fin_, const Params& P) {
    Frame F = Fin_; LAUNDER(F);
    LAS int* tt = (LAS int*)(F.lds + TT_OFF);
    if (F.tid < NCLS) tt[512 + F.tid] = (int)__hip_atomic_load((unsigned*)(P.ws + WS_CTL) + CW_GCNT + F.tid, __ATOMIC_RELAXED, __HIP_MEMORY_SCOPE_AGENT);
    __syncthreads();
    if (F.tid < MAXTILES) { int base = 0, cls = -1, tic = 0;
        for (int c = 0; c < NCLS; ++c) { const int nt = (tt[512 + c] + 255) >> 8; if (F.tid == 0) tt[544 + c] = base; if (cls < 0 && F.tid < base + nt) { cls = c; tic = F.tid - base; } base += nt; }
        if (F.tid == 0) tt[568] = base;
        tt[2 * F.tid] = cls; tt[2 * F.tid + 1] = tic; }
    __syncthreads();
}


__device__ __forceinline__ void p_final(const Frame& Fin_, const Params& P) {
    Frame F = Fin_; LAUNDER(F);
    const float* gf = P.in[26]; const bf16* Y = (const bf16*)(P.ws + WS_Y); const bf16* X1B = (const bf16*)(P.ws + WS_H2); const int* TPOS = (const int*)(P.ws + WS_TPOS); const LAS int* tt = (const LAS int*)(F.lds + TT_OFF);
    const int gw = F.vcu * NWAVES + F.wave, NGW = F.G * NWAVES;
    u32x2 nx[4], ny[4]; int tp1 = TPOS[gw], tp2 = (gw + NGW < T) ? TPOS[gw + NGW] : 0;
    { const size_t yr = (size_t)tt[544 + (tp1 >> 16)] * 256 + (tp1 & 0xffff);
#pragma unroll
      for (int j = 0; j < 4; ++j) { nx[j] = ((const u32x2*)(X1B + (size_t)gw * DM) + F.lane)[64 * j]; ny[j] = ((const u32x2*)(Y + yr * DM) + F.lane)[64 * j]; } }
    for (int m = gw; m < T; m += NGW) { f32x4* xr = (f32x4*)(P.out + (size_t)m * DM) + F.lane; f32x4 v[4]; float ss = 0.f;
#pragma unroll
        for (int j = 0; j < 4; ++j) { const u32x2 x = nx[j], y = ny[j]; v[j] = (f32x4){bf2f(x.x & 0xffffu), bf2f(x.x >> 16), bf2f(x.y & 0xffffu), bf2f(x.y >> 16)} + (f32x4){bf2f(y.x & 0xffffu), bf2f(y.x >> 16), bf2f(y.y & 0xffffu), bf2f(y.y >> 16)};
            ss += (v[j].x * v[j].x + v[j].y * v[j].y) + (v[j].z * v[j].z + v[j].w * v[j].w); }
        tp1 = tp2; if (m + 2 * NGW < T) tp2 = TPOS[m + 2 * NGW];
        if (m + NGW < T) { const size_t yr = (size_t)tt[544 + (tp1 >> 16)] * 256 + (tp1 & 0xffff);
#pragma unroll
            for (int j = 0; j < 4; ++j) { nx[j] = ((const u32x2*)(X1B + (size_t)(m + NGW) * DM) + F.lane)[64 * j]; ny[j] = ((const u32x2*)(Y + yr * DM) + F.lane)[64 * j]; } }
        const float rs = 1.0f / sqrtf(wave_sum(ss) * (1.0f / DM) + EPS);
#pragma unroll
        for (int j = 0; j < 4; ++j) { const f32x4 g = ((const f32x4*)gf)[F.lane + 64 * j]; xr[64 * j] = v[j] * rs * g; } }
}

namespace fox {
using bf16x8=__attribute__((ext_vector_type(8)))short;
using s16x4=__attribute__((ext_vector_type(4)))short;
using f32x16=__attribute__((ext_vector_type(16)))float;
using u32x4_=__attribute__((ext_vector_type(4)))unsigned;
using f32x4_=__attribute__((ext_vector_type(4)))float;
constexpr int D=64,DMP=512;
constexpr int NW=8,QBLK=32,QB=QBLK*NW,KVBLK=64;
__device__ __forceinline__ int crow(int r,int hi){return (r&3)+8*(r>>2)+4*hi;}
#define SBAR() __builtin_amdgcn_sched_barrier(0)
__device__ __forceinline__ void cmask(f32x16&p0,f32x16&p1,int jb,int qrel,int hi){
  const float NEG=-INFINITY; int d=qrel-64*jb-4*hi; asm volatile("":"+v"(d));
  #pragma unroll
  for(int r=0;r<16;++r){const int c=(r&3)+8*(r>>2); if(c>d)p0[r]=NEG; if(c+32>d)p1[r]=NEG;}
}
constexpr int NSLOT=3, SLOTB=8192;
constexpr int LDS_K=0, LDS_V=NSLOT*SLOTB, LDS_WS=2*NSLOT*SLOTB, LDS_OST=LDS_WS+NW*64*4, LDS_CK=LDS_OST+NW*4096, LDS_BYTES=LDS_CK+32768;
constexpr float PRUNE_X=40.0f;
__device__ __forceinline__ void glds16(const void*sbase,unsigned voff,unsigned lds_dst){unsigned keep;
  asm volatile("s_mov_b32 %0, m0\n\ts_mov_b32 m0, %3\n\ts_nop 0\n\tglobal_load_lds_dwordx4 %1, %2\n\ts_mov_b32 m0, %0":"=&s"(keep):"v"(voff),"s"(sbase),"s"(lds_dst):"memory");}
__device__ __forceinline__ float max3f(float a,float b,float c){float r;asm("v_max3_f32 %0, %1, %2, %3":"=v"(r):"v"(a),"v"(b),"v"(c));return r;}
__device__ __forceinline__ float max2f(float a,float b){float r;asm("v_max_f32_e32 %0, %1, %2":"=v"(r):"v"(a),"v"(b));return r;}
__device__ __forceinline__ float fadd_s(float a,float b){float r;asm("v_add_f32_e32 %0, %1, %2":"=v"(r):"v"(a),"v"(b));return r;}
__device__ __forceinline__ float fsub_s(float a,float b){float r;asm("v_sub_f32_e32 %0, %1, %2":"=v"(r):"v"(a),"v"(b));return r;}
typedef float f32x2_t __attribute__((ext_vector_type(2))); typedef __bf16 bf16x2_t __attribute__((ext_vector_type(2)));
__device__ __forceinline__ unsigned cvtpk_s(float lo,float hi){f32x2_t v={lo,hi};bf16x2_t b=__builtin_convertvector(v,bf16x2_t);return __builtin_bit_cast(unsigned,b);}
#define WAIT_BAR(N) asm volatile("s_waitcnt vmcnt(" #N ") lgkmcnt(0)\n\ts_barrier":::"memory")
typedef __attribute__((address_space(3))) const char* lds_cptr;
typedef short v4i16_t __attribute__((ext_vector_type(4)));
__device__ __forceinline__ void cinit(f32x16&p0,f32x16&p1,lds_cptr ckp,float nb){
  #pragma unroll
  for(int g=0;g<4;++g){ const f32x4_ a=*(const __attribute__((address_space(3))) f32x4_*)(ckp+g*32); const f32x4_ c=*(const __attribute__((address_space(3))) f32x4_*)(ckp+128+g*32);
    #pragma unroll
    for(int e=0;e<4;++e){p0[4*g+e]=nb-a[e];p1[4*g+e]=nb-c[e];} }
}
__device__ __forceinline__ void qkt(f32x16&p0,f32x16&p1,const char*Kslot,const bf16x8*qr,int r32,int hi){
  const char*kb=Kslot+hi*1024+r32*16;
  #pragma unroll
  for(int d0=0;d0<4;++d0){
    const bf16x8 b0=*reinterpret_cast<const bf16x8*>(kb+d0*2048);
    const bf16x8 b1=*reinterpret_cast<const bf16x8*>(kb+d0*2048+512);
    p0=__builtin_amdgcn_mfma_f32_32x32x16_bf16(b0,qr[d0],p0,0,0,0);p1=__builtin_amdgcn_mfma_f32_32x32x16_bf16(b1,qr[d0],p1,0,0,0);}
}
__device__ __forceinline__ void kload8(bf16x8*kf,lds_cptr kp){
  kf[0]=*(const __attribute__((address_space(3))) bf16x8*)(kp);      kf[1]=*(const __attribute__((address_space(3))) bf16x8*)(kp+512);
  kf[2]=*(const __attribute__((address_space(3))) bf16x8*)(kp+2048); kf[3]=*(const __attribute__((address_space(3))) bf16x8*)(kp+2560);
  kf[4]=*(const __attribute__((address_space(3))) bf16x8*)(kp+4096); kf[5]=*(const __attribute__((address_space(3))) bf16x8*)(kp+4608);
  kf[6]=*(const __attribute__((address_space(3))) bf16x8*)(kp+6144); kf[7]=*(const __attribute__((address_space(3))) bf16x8*)(kp+6656);
}
__device__ __forceinline__ void kload2(bf16x8*kf,lds_cptr kp,int j){ kf[2*j]=*(const __attribute__((address_space(3))) bf16x8*)(kp+j*2048); kf[2*j+1]=*(const __attribute__((address_space(3))) bf16x8*)(kp+j*2048+512); }
__device__ __forceinline__ s16x4 vtr(lds_cptr p){ return __builtin_bit_cast(s16x4,__builtin_amdgcn_ds_read_tr16_b64_v4i16((__attribute__((address_space(3))) v4i16_t*)p)); }
__device__ __forceinline__ float rowmax(const f32x16&p0,const f32x16&p1){
  float a=max3f(p0[0],p0[1],p1[0]),b=max3f(p0[2],p0[3],p1[1]);a=max3f(a,p1[2],p1[3]);
  #pragma unroll
  for(int r=4;r<16;r+=4){a=max3f(a,p0[r],p0[r+1]);b=max3f(b,p0[r+2],p0[r+3]);a=max3f(a,p1[r],p1[r+1]);b=max3f(b,p1[r+2],p1[r+3]);}
  const float m=max2f(a,b);
  auto rr=__builtin_amdgcn_permlane32_swap(__float_as_uint(m),__float_as_uint(m),false,false);
  return max2f(__uint_as_float(rr[0]),__uint_as_float(rr[1]));
}
__device__ __forceinline__ void pv(f32x16*o,int vb,bf16x8 pa0,bf16x8 pa1,bf16x8 pa2,bf16x8 pa3){
  #pragma unroll
  for(int d0=0;d0<2;++d0){s16x4 lo[4],hi[4];
    #pragma unroll
    for(int ks=0;ks<4;++ks){
      asm volatile("ds_read_b64_tr_b16 %0,%1 offset:%c2":"=&v"(lo[ks]):"v"(vb),"i"(d0*4096+ks*1024):"memory");
      asm volatile("ds_read_b64_tr_b16 %0,%1 offset:%c2":"=&v"(hi[ks]):"v"(vb),"i"(d0*4096+ks*1024+512):"memory");}
    asm volatile("s_waitcnt lgkmcnt(0)":::"memory");SBAR();
    #define PK(k) (bf16x8){lo[k][0],lo[k][1],lo[k][2],lo[k][3],hi[k][0],hi[k][1],hi[k][2],hi[k][3]}
    o[d0]=__builtin_amdgcn_mfma_f32_32x32x16_bf16(pa0,PK(0),o[d0],0,0,0);
    o[d0]=__builtin_amdgcn_mfma_f32_32x32x16_bf16(pa1,PK(1),o[d0],0,0,0);
    o[d0]=__builtin_amdgcn_mfma_f32_32x32x16_bf16(pa2,PK(2),o[d0],0,0,0);
    o[d0]=__builtin_amdgcn_mfma_f32_32x32x16_bf16(pa3,PK(3),o[d0],0,0,0);
    #undef PK
  }
}
struct Tensors { const bf16* Q; const bf16* K; const bf16* V; bf16* O; const float* CK2; const float* QN; const float* KN; };

template<int THRL> __device__ __forceinline__ void attn_unit(int b,int h,int qb,const Tensors&TT,char*shm){
  const bf16*Q=TT.Q; const bf16*__restrict__ K=TT.K; const bf16*__restrict__ V=TT.V; bf16*O=TT.O;
  int tid=threadIdx.x; asm volatile("":"+v"(tid));
  const int lane=tid&63,r32=lane&31,hi=lane>>5; const int wid=__builtin_amdgcn_readfirstlane(tid>>6);
  const long rowbase=(long)b*SEQ; const int q0=qb*QB; const int bh=b*NH+h;
  const float*ck=TT.CK2+(size_t)bh*SEQ;
  const int NTF=(q0+QB)/KVBLK;
  const bf16*Qw=Q+(rowbase+q0+wid*QBLK)*DMP+h*D;
  const bf16*Kh=K+rowbase*DMP+h*D,*Vh=V+rowbase*DMP+h*D;
  const unsigned lds0=(unsigned)(uintptr_t)shm;
  const unsigned koff=(unsigned)(lane*DMP+wid*8)*2u;
  const unsigned voff=(unsigned)((16*(wid&3)+(lane>>2))*DMP+(wid>>2)*32+(lane&3)*8)*2u;
  const unsigned kdst=lds0+LDS_K+wid*1024, vdst=lds0+LDS_V+wid*1024;
  #define TJ(t) (NTF-1-(t))
  #define DMA_K(t,slot) glds16(Kh+(long)TJ(t)*KVBLK*DMP,koff,(unsigned)__builtin_amdgcn_readfirstlane(kdst+(slot)))
  #define DMA_V(t,slot) glds16(Vh+(long)TJ(t)*KVBLK*DMP,voff,(unsigned)__builtin_amdgcn_readfirstlane(vdst+(slot)))
  DMA_K(0,0);DMA_V(0,0);DMA_K(1,SLOTB);DMA_K(2,2*SLOTB);
  float Bq; int jmin;
  { float qn=(lane<4)?TT.QN[bh*128+4*qb+lane]:0.f; float kn=0.f; if(lane<NTF)kn=TT.KN[bh*128+lane]; if(lane+64<NTF)kn=fmaxf(kn,TT.KN[bh*128+64+lane]);
    const float cq0=ck[q0]; const float c0=(lane<NTF)?ck[64*lane+63]:0.f, c1=(lane+64<NTF)?ck[64*(lane+64)+63]:0.f;
    #pragma unroll
    for(int o_=1;o_<64;o_<<=1){qn=fmaxf(qn,__shfl_xor(qn,o_));kn=fmaxf(kn,__shfl_xor(kn,o_));}
    Bq=sqrtf(qn*kn)*1.001f+1e-3f;
    const float lim=2.0f*Bq+PRUNE_X;
    const bool n0=(lane>=NTF)||((c0-cq0)<=lim), n1=(lane+64>=NTF)||((c1-cq0)<=lim);
    const unsigned long long m0=__ballot(n0), m1=__ballot(n1);
    jmin=m0?(int)__builtin_ctzll(m0):(64+(m1?(int)__builtin_ctzll(m1):63));
    jmin=__builtin_amdgcn_readfirstlane(jmin)&~1; if(jmin>NTF-4)jmin=NTF-4; }
  const int NT=NTF-jmin;
  float*wsf=(float*)(shm+LDS_WS)+wid*64;
  const int vb0=(int)(lds0+LDS_V)+((lane>>4)&1)*32+(lane&3)*8+(4*hi+((lane&15)>>2))*64;
  const char*Kbase=shm+LDS_K; bf16x8 kf[8];
  const lds_cptr shm3=(lds_cptr)shm; const lds_cptr kp0=shm3+LDS_K+hi*1024+r32*16; const lds_cptr vp0=shm3+LDS_V+((lane>>4)&1)*32+(lane&3)*8+(4*hi+((lane&15)>>2))*64;
  const lds_cptr ckp0=shm3+LDS_CK+hi*16;
  #define CKP(t) (ckp0+(t)*256)
  bf16x8 qr[4];
  #pragma unroll
  for(int d0=0;d0<4;++d0)qr[d0]=*reinterpret_cast<const bf16x8*>(&Qw[(long)r32*DMP+d0*16+hi*8]);
  const float cq=ck[q0+wid*QBLK+r32];
  { const int n4=NT*16; const f32x4_*src=(const f32x4_*)ck; __attribute__((address_space(3))) f32x4_*dst=(__attribute__((address_space(3))) f32x4_*)(shm3+LDS_CK);
    for(int i=tid;i<n4;i+=NW*64)dst[i]=src[(NTF-1-(i>>4))*16+(i&15)]; }
  float mhat=0.f,l_reg=0.f;f32x16 o[2];o[0]=f32x16{};o[1]=f32x16{};
  const int qrel=wid*QBLK+r32;
  #define CMASK(P0,P1,t) do{int jb_=3-(t); if(jb_>=0)cmask(P0,P1,jb_,qrel,hi);}while(0)
  bool resc=false;
  #define START(P0,P1) do{ const float rm=fmaxf(rowmax(P0,P1),-Bq); resc=false; \
    { const float dl=rm; mhat=fadd_s(mhat,dl); \
      _Pragma("unroll") for(int r=0;r<16;++r){P0[r]=fsub_s(P0[r],dl);P1[r]=fsub_s(P1[r],dl);} } \
    _Pragma("unroll") for(int r=0;r<16;++r)P0[r]=__builtin_amdgcn_exp2f(P0[r]); }while(0)
  #define RESC() do{ if(resc){ asm volatile("s_waitcnt lgkmcnt(0)":::"memory"); \
      _Pragma("unroll") for(int d_=0;d_<2;++d_) _Pragma("unroll") for(int r=0;r<16;++r)o[d_][r]*=wsf[crow(r,hi)]; } }while(0)
  f32x16 pA0,pA1,pB0,pB1;
  int sl_prev=0,sl_cur=0,sl_next=SLOTB;
  #define ROT() do{sl_prev=sl_cur;sl_cur=sl_next;sl_next=(sl_next==(NSLOT-1)*SLOTB)?0:sl_next+SLOTB;}while(0)
  WAIT_BAR(0);
  asm volatile("":::"memory");
  cinit(pA0,pA1,CKP(0),cq);
  qkt(pA0,pA1,Kbase,qr,r32,hi);asm volatile("s_nop 15\n\ts_nop 7":"+v"(pA0),"+v"(pA1));CMASK(pA0,pA1,0);
  START(pA0,pA1);
  _Pragma("unroll") for(int r=0;r<16;++r)pA1[r]=__builtin_amdgcn_exp2f(pA1[r]);
  WAIT_BAR(0);
  DMA_K(3,0);DMA_V(1,SLOTB);
  ROT();
  kload8(kf,kp0+sl_cur);
  WAIT_BAR(2);
  s16x4 vlo[8],vhi[8]; u32x4_ pw0,pw1,pw2,pw3;
  #define PKW(P,B) cvtpk_s(P[B],P[B+1])
  #define PAF(k) __builtin_bit_cast(bf16x8,pw##k)
  #define VFR(i) (bf16x8){vlo[i][0],vlo[i][1],vlo[i][2],vlo[i][3],vhi[i][0],vhi[i][1],vhi[i][2],vhi[i][3]}
  #define PIN(x) asm volatile("":"+v"(x))
  #define MX3(a,b,c) __builtin_fmaxf(__builtin_fmaxf((a),(b)),(c))
  #define GAPA(MF,A0,A1,A2,A3,W0,W1,PW) do{ MF; sacc+=A0; sacc+=A1; sacc+=A2; sacc+=A3; PIN(sacc); W0; W1; PIN(PW); SBAR(); }while(0)
  #define EX(v) __builtin_amdgcn_exp2f(v)
  #define GAPB(MF,X,B) do{ MF; X[B]=EX(X[B]); X[B+1]=EX(X[B+1]); X[B+2]=EX(X[B+2]); X[B+3]=EX(X[B+3]); PIN(X); SBAR(); }while(0)
  #define VRD(i) do{ vlo[i]=vtr(vp_+(((i)>>2)*4096+((i)&3)*1024)); vhi[i]=vtr(vp_+(((i)>>2)*4096+((i)&3)*1024+512)); }while(0)
  #define KRD(G,j) do{ if(G){ kload2(kf,kp0+sl_next,j); SBAR(); } }while(0)
  #define STEP(C0,C1,P0,P1,t,GK,GV,GL) do{ SBAR(); \
    const lds_cptr vp_=vp0+sl_prev; \
    cinit(C0,C1,CKP(t),cq-mhat); SBAR(); \
    VRD(0); SBAR(); float sacc=(P0[0]+P0[1]); \
    GAPA(C0=__builtin_amdgcn_mfma_f32_32x32x16_bf16(kf[0],qr[0],C0,0,0,0), P0[2],P0[3],P0[4],P0[5],     pw0[0]=PKW(P0,0), pw0[1]=PKW(P0,2), pw0); \
    VRD(4); SBAR(); GAPA(C1=__builtin_amdgcn_mfma_f32_32x32x16_bf16(kf[1],qr[0],C1,0,0,0), P0[6],P0[7],P0[8],P0[9],     pw0[2]=PKW(P0,4), pw0[3]=PKW(P0,6), pw0); \
    VRD(1); SBAR(); GAPA(C0=__builtin_amdgcn_mfma_f32_32x32x16_bf16(kf[2],qr[1],C0,0,0,0),   P0[10],P0[11],P0[12],P0[13], pw1[0]=PKW(P0,8), pw1[1]=PKW(P0,10), pw1); \
    VRD(5); SBAR(); GAPA(C1=__builtin_amdgcn_mfma_f32_32x32x16_bf16(kf[3],qr[1],C1,0,0,0),   P0[14],P0[15],P1[0],P1[1],   pw1[2]=PKW(P0,12),pw1[3]=PKW(P0,14), pw1); \
    VRD(2); SBAR(); GAPA(C0=__builtin_amdgcn_mfma_f32_32x32x16_bf16(kf[4],qr[2],C0,0,0,0),   P1[2],P1[3],P1[4],P1[5],     pw2[0]=PKW(P1,0), pw2[1]=PKW(P1,2), pw2); \
    VRD(6); SBAR(); GAPA(C1=__builtin_amdgcn_mfma_f32_32x32x16_bf16(kf[5],qr[2],C1,0,0,0),   P1[6],P1[7],P1[8],P1[9],     pw2[2]=PKW(P1,4), pw2[3]=PKW(P1,6), pw2); \
    VRD(3); SBAR(); GAPA(C0=__builtin_amdgcn_mfma_f32_32x32x16_bf16(kf[6],qr[3],C0,0,0,0),   P1[10],P1[11],P1[12],P1[13], pw3[0]=PKW(P1,8), pw3[1]=PKW(P1,10), pw3); \
    VRD(7); SBAR(); GAPA(C1=__builtin_amdgcn_mfma_f32_32x32x16_bf16(kf[7],qr[3],C1,0,0,0),   P1[14],P1[15],0.f,0.f,       pw3[2]=PKW(P1,12),pw3[3]=PKW(P1,14), pw3); \
    l_reg+=sacc; \
    if(GK){DMA_K((t)+3,sl_cur);} if(GV){DMA_V((t)+1,sl_next);} \
    CMASK(C0,C1,t); \
    { float a=MX3(C0[0],C0[1],C1[0]),b=MX3(C0[2],C0[3],C1[1]); a=MX3(a,C1[2],C1[3]); \
      _Pragma("unroll") for(int r=4;r<16;r+=4){a=MX3(a,C0[r],C0[r+1]);b=MX3(b,C0[r+2],C0[r+3]);a=MX3(a,C1[r],C1[r+1]);b=MX3(b,C1[r+2],C1[r+3]);} \
      float rm=__builtin_fmaxf(a,b); { auto rr=__builtin_amdgcn_permlane32_swap(__float_as_uint(rm),__float_as_uint(rm),false,false); rm=__builtin_fmaxf(__uint_as_float(rr[0]),__uint_as_float(rr[1])); } \
      resc=false; \
      if(__builtin_expect(__any(rm>(float)THRL),0)){ const float dl=__builtin_fmaxf(rm,0.f); mhat+=dl; \
        _Pragma("unroll") for(int r=0;r<16;++r){C0[r]-=dl;C1[r]-=dl;} \
        const float f=__builtin_amdgcn_exp2f(-dl); l_reg*=f; if(hi==0)wsf[r32]=f; resc=true; } } \
    SBAR(); \
    GAPB(o[0]=__builtin_amdgcn_mfma_f32_32x32x16_bf16(PAF(0),VFR(0),o[0],0,0,0), C0,0); \
    GAPB(o[1]=__builtin_amdgcn_mfma_f32_32x32x16_bf16(PAF(0),VFR(4),o[1],0,0,0), C0,4); \
    KRD(GL,0); GAPB(o[0]=__builtin_amdgcn_mfma_f32_32x32x16_bf16(PAF(1),VFR(1),o[0],0,0,0), C0,8); \
    KRD(GL,1); GAPB(o[1]=__builtin_amdgcn_mfma_f32_32x32x16_bf16(PAF(1),VFR(5),o[1],0,0,0), C0,12); \
    KRD(GL,2); GAPB(o[0]=__builtin_amdgcn_mfma_f32_32x32x16_bf16(PAF(2),VFR(2),o[0],0,0,0), C1,0); \
    KRD(GL,3); GAPB(o[1]=__builtin_amdgcn_mfma_f32_32x32x16_bf16(PAF(2),VFR(6),o[1],0,0,0), C1,4); \
    GAPB(o[0]=__builtin_amdgcn_mfma_f32_32x32x16_bf16(PAF(3),VFR(3),o[0],0,0,0), C1,8); \
    GAPB(o[1]=__builtin_amdgcn_mfma_f32_32x32x16_bf16(PAF(3),VFR(7),o[1],0,0,0), C1,12); \
    }while(0)
  #define ENDW(tt) do{ if((tt)+3<NT){WAIT_BAR(2);} else if((tt)+2<NT){WAIT_BAR(1);} else {WAIT_BAR(0);} }while(0)
  int t=1;
  for(;t+1<NT&&t<5;t+=2){
    STEP(pB0,pB1,pA0,pA1,t,(t+3<NT),(t+1<NT),(t+1<NT));       ENDW(t);   RESC(); ROT();
    STEP(pA0,pA1,pB0,pB1,t+1,(t+4<NT),(t+2<NT),(t+2<NT));     ENDW(t+1); RESC(); ROT();
  }
  #undef CMASK
  #define CMASK(P0,P1,t) do{}while(0)
  for(;t+5<NT;t+=2){
    STEP(pB0,pB1,pA0,pA1,t,true,true,true);     WAIT_BAR(2); RESC(); ROT();
    STEP(pA0,pA1,pB0,pB1,t+1,true,true,true);   WAIT_BAR(2); RESC(); ROT();
  }
  for(;t+1<NT;t+=2){
    STEP(pB0,pB1,pA0,pA1,t,(t+3<NT),(t+1<NT),(t+1<NT));       ENDW(t);   RESC(); ROT();
    STEP(pA0,pA1,pB0,pB1,t+1,(t+4<NT),(t+2<NT),(t+2<NT));     ENDW(t+1); RESC(); ROT();
  }
  #undef CMASK
  #define CMASK(P0,P1,t) do{int jb_=3-(t); if(jb_>=0)cmask(P0,P1,jb_,qrel,hi);}while(0)
  STEP(pB0,pB1,pA0,pA1,NT-1,false,false,false); RESC();
  { float sacc=pB0[0]+pB0[1]; _Pragma("unroll") for(int r=2;r<16;++r)sacc+=pB0[r]; _Pragma("unroll") for(int r=0;r<16;++r)sacc+=pB1[r]; l_reg+=sacc;
    pw0=(u32x4_){PKW(pB0,0),PKW(pB0,2),PKW(pB0,4),PKW(pB0,6)};pw1=(u32x4_){PKW(pB0,8),PKW(pB0,10),PKW(pB0,12),PKW(pB0,14)};pw2=(u32x4_){PKW(pB1,0),PKW(pB1,2),PKW(pB1,4),PKW(pB1,6)};pw3=(u32x4_){PKW(pB1,8),PKW(pB1,10),PKW(pB1,12),PKW(pB1,14)};
    SBAR(); pv(o,vb0+sl_cur,PAF(0),PAF(1),PAF(2),PAF(3)); }
  #undef PKW
  #undef PAF
  #undef VFR
  #undef PIN
  #undef MX3
  #undef GAPA
  #undef GAPB
  #undef EX
  #undef VRD
  #undef KRD
  #undef STEP
  #undef ENDW
  {auto rr=__builtin_amdgcn_permlane32_swap(__float_as_uint(l_reg),__float_as_uint(l_reg),false,false);l_reg=__uint_as_float(rr[0])+__uint_as_float(rr[1]);}
  if(hi==0)wsf[32+r32]=l_reg;asm volatile("s_waitcnt lgkmcnt(0)":::"memory");
  float rli[16];
  #pragma unroll
  for(int r=0;r<16;++r)rli[r]=__builtin_amdgcn_rcpf(wsf[32+crow(r,hi)]);
  bf16*Ow=O+(rowbase+q0+wid*QBLK)*DMP+h*D;
  { bf16*stg=(bf16*)(shm+LDS_OST)+wid*2048;
    #pragma unroll
    for(int r=0;r<16;++r){const int orow=crow(r,hi);
      #pragma unroll
      for(int d0=0;d0<2;++d0)stg[orow*64+d0*32+r32]=(bf16)f2bf(o[d0][r]*rli[r]);}
    asm volatile("s_waitcnt lgkmcnt(0)":::"memory");
    #pragma unroll
    for(int i=0;i<4;++i){const int row=i*8+(lane>>3),ch=lane&7; const u32x4_ v=*(const u32x4_*)(stg+row*64+ch*8); *(u32x4_*)(Ow+(long)row*DMP+ch*8)=v;} }
  asm volatile("s_waitcnt lgkmcnt(0)\n\ts_barrier":::"memory");
  #undef DMA_K
  #undef DMA_V
  #undef CMASK
  #undef START
  #undef RESC
  #undef ROT
  #undef TJ
  #undef CKP
}
#undef SBAR
#undef WAIT_BAR
}

__device__ __forceinline__ void p_norms(const Frame& Fin_, const Params& P) {
    Frame F = Fin_; LAUNDER(F);
    const float* NP = (const float*)(P.ws + WS_NP); float* QN = (float*)(P.ws + WS_QN); float* KN = (float*)(P.ws + WS_KN);
    const int gw = ((int)blockIdx.x - 160) * NWAVES + F.wave, NGW = (F.G - 160) * NWAVES;
    for (int it = gw; it < T / 64; it += NGW) { const int b = it >> 7, tile = it & 127; const float* p = NP + ((size_t)b * SEQ + tile * 64) * 32 + F.lane;
        float v[32];
#pragma unroll
        for (int i = 0; i < 32; ++i) v[i] = p[i * 64];
        float m = 0.f;
#pragma unroll
        for (int i = 0; i < 32; ++i) m = fmaxf(m, v[i] + __shfl_xor(v[i], 1));
        m = fmaxf(m, __shfl_xor(m, 32)) * (1.0f + 1.0f / 64.0f);
        const int seg = F.lane & 31;
        if (F.lane < 32 && (seg & 1) == 0) { if (seg < 16) QN[(b * NH + (seg >> 1)) * 128 + tile] = m; else KN[(b * NH + ((seg - 16) >> 1)) * 128 + tile] = m; } }
}


#define XB_TMO      128
#define XB_XCNT(j)  (256  + 64 * (j))
#define XB_XSUB(j)  (1280 + 64 * (j))
#define XB_XGEN(j)  (2304 + 64 * (j))
#define XB_TOP      3328
#define XB_TOPGEN   3392
#define XCD_BAR_WORDS 3456
#define XB_SPIN_CAP (1u << 18)
constexpr int CW_BAR = 4096;
constexpr size_t CTL_ZERO_BYTES = 65536;
constexpr unsigned REP_MASK = 0u;
constexpr int CW_ATTNQ = 8192;
constexpr int LDSCTL_OFF = RING_BYTES, MISC_OFF = LDSCTL_OFF + 320;
__device__ __forceinline__ unsigned xb_ld(unsigned* p)              { return __hip_atomic_load(p, __ATOMIC_RELAXED, __HIP_MEMORY_SCOPE_AGENT); }
__device__ __forceinline__ unsigned xb_add(unsigned* p, unsigned v) { return __hip_atomic_fetch_add(p, v, __ATOMIC_RELAXED, __HIP_MEMORY_SCOPE_AGENT); }
__device__ __forceinline__ unsigned xb_xcc_id() { return (unsigned)__builtin_amdgcn_s_getreg((3 << 11) | 20) & 0xFu; }
#define XB_SPIN(cond, bar) do { unsigned _sp = 0; while (cond) { __builtin_amdgcn_s_sleep(1); \
    if ((++_sp & 255u) == 0u) { if (xb_ld(&(bar)[XB_TMO])) break; if (_sp > XB_SPIN_CAP) { atomicAdd(&(bar)[XB_TMO], 1u); break; } } } } while (0)
struct XcdBarrier { unsigned* bar; unsigned x; volatile LAS unsigned* st; };
__device__ __forceinline__ XcdBarrier xcd_barrier_post(unsigned* bar, volatile LAS unsigned* st) {
    XcdBarrier b; b.bar = bar; b.x = xb_xcc_id(); b.st = st;
    if (threadIdx.x == 0) (void)xb_add(&bar[XB_XCNT(b.x)], 1u);
    return b;
}
__device__ __forceinline__ void xcd_barrier_complete(unsigned* bar, unsigned x, unsigned& nloc, unsigned& nx) {
    const unsigned G = gridDim.x * gridDim.y * gridDim.z;
    unsigned sum, cnt, mine, sp = 0u;
    for (;;) {
        sum = 0u; cnt = 0u; mine = 0u;
#pragma unroll
        for (unsigned j = 0; j < 16; ++j) { const unsigned c = xb_ld(&bar[XB_XCNT(j)]); sum += c; cnt += (c > 0u) ? 1u : 0u; mine = (j == x) ? c : mine; }
        if (sum == G) break;
        __builtin_amdgcn_s_sleep(1);
        if ((++sp & 255u) == 0u) { if (xb_ld(&bar[XB_TMO])) break; if (sp > XB_SPIN_CAP) { atomicAdd(&bar[XB_TMO], 1u); break; } }
    }
    nloc = mine > 0u ? mine : 1u; nx = cnt > 0u ? cnt : 1u;
}
__device__ __forceinline__ void xcd_barrier(const XcdBarrier& b) {
    asm volatile("s_waitcnt vmcnt(0)" ::: "memory");
    __syncthreads();
    if (threadIdx.x == 0) {
        unsigned* bar = b.bar;
        __builtin_amdgcn_s_waitcnt(0);
        unsigned nloc = b.st[0], nx = b.st[1];
        if (nloc == 0u) { xcd_barrier_complete(bar, b.x, nloc, nx); b.st[0] = nloc; b.st[1] = nx; }
        const unsigned old = xb_add(&bar[XB_XSUB(b.x)], 1u);
        const unsigned gen = old / nloc;
        if (old + 1u == (gen + 1u) * nloc) {
            __builtin_amdgcn_fence(__ATOMIC_RELEASE, "agent");
            asm volatile("s_waitcnt vmcnt(0)" ::: "memory");
            const unsigned og = xb_add(&bar[XB_TOP], 1u);
            const unsigned tg = og / nx;
            __builtin_amdgcn_fence(__ATOMIC_ACQUIRE, "agent");
            if (og + 1u == (tg + 1u) * nx) xb_add(&bar[XB_TOPGEN], 1u);
            else XB_SPIN(xb_ld(&bar[XB_TOPGEN]) == tg, bar);
            xb_add(&bar[XB_XGEN(b.x)], 1u);
            asm volatile("s_waitcnt vmcnt(0)" ::: "memory");
        } else {
            __builtin_amdgcn_fence(__ATOMIC_ACQUIRE, "agent");
            XB_SPIN(xb_ld(&bar[XB_XGEN(b.x)]) == gen, bar);
            asm volatile("s_waitcnt vmcnt(0)" ::: "memory");
        }
    }
    __syncthreads();
}


__device__ __forceinline__ void attn_only_phase(const fox::Tensors& TT, char* lds, unsigned* ctr, volatile LAS int* qw) {
    if (threadIdx.x == 0) qw[0] = (int)__hip_atomic_fetch_add(ctr, 1u, __ATOMIC_RELAXED, __HIP_MEMORY_SCOPE_AGENT);
    __syncthreads();
    for (int slot = 0;; slot ^= 1) { const int u = qw[slot]; if (u >= 32 * 32) break;
        int nxt = 0; if (threadIdx.x == 0) nxt = (int)__hip_atomic_fetch_add(ctr, 1u, __ATOMIC_RELAXED, __HIP_MEMORY_SCOPE_AGENT);
        const int qb = 31 - (u >> 5), bh = u & 31; fox::attn_unit<8>(bh / NH, bh % NH, qb, TT, lds);
        if (threadIdx.x == 0) qw[slot ^ 1] = nxt; __syncthreads(); }
}

enum Phase { PH_PRO = 0, PH_PROJ, PH_CUMSUM, PH_SSMS, PH_CARRY, PH_SSMY, PH_ATTN, PH_GLU, PH_OUTA, PH_OUTB, PH_WOUT, PH_ROUTER, PH_POS, PH_MOEGU, PH_MOEMIX, PH_MOEDN, PH_FINAL, PH_N };

__global__ void __launch_bounds__(NTHR, 2) mega(Params P) {
    extern __shared__ __attribute__((aligned(16))) unsigned char lds_raw[];
    Frame F; F.lds = (LAS unsigned char*)lds_raw; F.tid = threadIdx.x; F.lane = F.tid & 63; F.wave = __builtin_amdgcn_readfirstlane(F.tid >> 6);
    F.G = gridDim.x; { const int bx = blockIdx.x; F.vcu = (F.G % 8 == 0) ? (bx % 8) * (F.G / 8) + bx / 8 : bx; }
    const int lo = P.ph_lo, hi = P.ph_hi;
    unsigned char* ws = P.ws;
    for (int u = F.tid; u < (LDS_BYTES - LDSCTL_OFF) / 4; u += NTHR) ((LAS unsigned*)(F.lds + LDSCTL_OFF))[u] = 0u;
    __syncthreads();
    XcdBarrier bar; bar.bar = (unsigned*)(ws + WS_CTL) + CW_BAR; bar.x = 0; bar.st = nullptr;
    if (hi - lo > 1) bar = xcd_barrier_post((unsigned*)(ws + WS_CTL) + CW_BAR, (volatile LAS unsigned*)(F.lds + MISC_OFF) + 8);
#define IN(k) (lo <= (k) && (k) < hi)
#define SEAM(k) do { if (IN(k) && IN((k) + 1)) xcd_barrier(bar); } while (0)
#define REPEAT(i) for (int rep_ = 0; rep_ < 1 + (int)((REP_MASK >> (i)) & 1u); ++rep_)
    REPEAT(0) { if (IN(PH_PRO)) p0_prologue(F, P);
    SEAM(PH_PRO); }
    REPEAT(1) { if (IN(PH_PROJ)) { for (int i = F.tid; i < 2048; i += NTHR) ((LAS float*)(F.lds + BIAS_OFF))[i] = P.in[4][i] * -LOG2E; __syncthreads();
        SchedPlain S{(const bf16*)(ws + WS_XN), (const bf16*)(ws + WS_WIN), T / 256, NPROJ / 256, {1024, 1024, 1024}};
        EpiProj E{(bf16*)(ws + WS_Q), (bf16*)(ws + WS_K), (bf16*)(ws + WS_V), (bf16*)(ws + WS_UH), (bf16*)(ws + WS_GATES), (const LAS float*)(F.lds + BIAS_OFF), (float*)(ws + WS_NP)}; run_gemm(F.lds, S.d, S, E); }
    SEAM(PH_PROJ); }
    REPEAT(2) { if (IN(PH_CUMSUM)) { if (blockIdx.x >= 160) p_norms(F, P); else if (blockIdx.x >= 128) p_cumsum(F, P);
        if (blockIdx.x >= 128) { __syncthreads(); p0_weights(F, P, 1); } }
    if (IN(PH_SSMS)) { SchedSsmS S{(const bf16*)(ws + WS_UH), (const bf16*)(ws + WS_WS)}; EpiSsmS E{(float*)(ws + WS_S)}; run_gemm(F.lds, GemmDims{512, KY, 512}, S, E); }
    if (IN(PH_CARRY)) { __syncthreads(); p_carry(F, P); }
    SEAM(PH_CARRY); }
    REPEAT(3) { if (IN(PH_SSMY)) { SchedSsmY S{(const bf16*)(ws + WS_UH), (const bf16*)(ws + WS_MX), F.G}; EpiSsmY E{(bf16*)(ws + WS_Z)}; run_gemm(F.lds, GemmDims{KY, KY, KY}, S, E); __syncthreads(); }
    if (IN(PH_ATTN)) { const fox::Tensors TT{(const bf16*)(ws + WS_Q), (const bf16*)(ws + WS_K), (const bf16*)(ws + WS_V), (bf16*)(ws + WS_OA), (const float*)(ws + WS_CK2), (const float*)(ws + WS_QN), (const float*)(ws + WS_KN)};
        attn_only_phase(TT, (char*)lds_raw, (unsigned*)(ws + WS_CTL) + CW_ATTNQ + 64 * rep_, (volatile LAS int*)(F.lds + MISC_OFF) + 16); }
    SEAM(PH_ATTN); }
    REPEAT(5) { if (IN(PH_GLU)) { for (int i = F.tid; i < 512; i += NTHR) ((LAS float*)(F.lds + BIAS_OFF))[i] = P.in[15][i] * -LOG2E; __syncthreads();
        SchedPlain S{(const bf16*)(ws + WS_Z), (const bf16*)(ws + WS_WGLU), T / 256, 2, {512, 512, 512}}; EpiGlu E{(const bf16*)(ws + WS_Z), (bf16*)(ws + WS_ZZ), (const LAS float*)(F.lds + BIAS_OFF)}; run_gemm(F.lds, S.d, S, E); }
    SEAM(PH_GLU); }
    REPEAT(6) { if (IN(PH_OUTB)) { SchedOutAB S{(const bf16*)(ws + WS_OA), (const bf16*)(ws + WS_ZZ), (const bf16*)(ws + WS_WOA), (const bf16*)(ws + WS_WOB)}; EpiOutAB E{(const unsigned char*)(ws + WS_GATES), (bf16*)(ws + WS_MERGED)};
        run_gemm(F.lds, GemmDims{1024, 512, 512}, S, E); }
    SEAM(PH_OUTB); }
    REPEAT(7) { if (IN(PH_WOUT)) { SchedPlain S{(const bf16*)(ws + WS_MERGED), (const bf16*)(ws + WS_WO), T / 256, 4, {1024, 1024, 1024}};
        { UnitX u0; u0.pn = 0; S.get((int)blockIdx.x, u0); stage_router_table(F, P, u0.pn); }
        EpiWout E{P.in[0], (bf16*)(ws + WS_H2), (float*)(ws + WS_PART), (const LAS unsigned char*)(F.lds + RT_OFF)}; run_gemm(F.lds, S.d, S, E); }
    SEAM(PH_WOUT); }
    REPEAT(8) { if (IN(PH_ROUTER)) p_router(F, P, rep_ == 0);
    SEAM(PH_ROUTER); }
    REPEAT(10) { if (IN(PH_MOEGU)) { moe_tile_table(F, P);
        SchedMoeGU S{(const bf16*)(ws + WS_H2), (const bf16*)(ws + WS_WGU), (const int*)(ws + WS_LIST), (const LAS int*)(F.lds + TT_OFF), MoeRange{0, 512, 0, 0, F.G}}; EpiMoeGU E{(bf16*)(ws + WS_HACT), (const float*)(ws + WS_LPW)}; run_gemm(F.lds, GemmDims{1024, 1024, 1024}, S, E); }
    SEAM(PH_MOEGU); }
    REPEAT(11) { if (IN(PH_MOEMIX)) { const LAS int* tt = (const LAS int*)(F.lds + TT_OFF); const int nu = 4 * tt[568]; int L = nu - 512; L = L < 0 ? 0 : (L > F.G ? F.G : L);
        { SchedMoeGU S{(const bf16*)(ws + WS_H2), (const bf16*)(ws + WS_WGU), (const int*)(ws + WS_LIST), tt, MoeRange{512, nu, 1, 0, F.G}}; EpiMoeGU E{(bf16*)(ws + WS_HACT), (const float*)(ws + WS_LPW)}; run_gemm(F.lds, GemmDims{1024, 1024, 1024}, S, E); }
        { const int dn_b = nu < 512 ? nu : 512;
          SchedMoeDN S{(const bf16*)(ws + WS_HACT), (const bf16*)(ws + WS_WD), tt, MoeRange{0, dn_b, 2, L, F.G}}; EpiMoeDN E{(bf16*)(ws + WS_Y)}; run_gemm(F.lds, GemmDims{512, 512, 512}, S, E); } }
    SEAM(PH_MOEMIX); }
    REPEAT(13) { if (IN(PH_MOEDN)) { const LAS int* tt = (const LAS int*)(F.lds + TT_OFF); const int nu = 4 * tt[568]; int L = nu - 512; L = L < 0 ? 0 : (L > F.G ? F.G : L);
        int d0 = 2 * (F.G - L); { const int dn_b = nu < 512 ? nu : 512; d0 = d0 < dn_b ? d0 : dn_b; }
        SchedMoeDN S{(const bf16*)(ws + WS_HACT), (const bf16*)(ws + WS_WD), tt, MoeRange{d0, nu, 0, 0, F.G}}; EpiMoeDN E{(bf16*)(ws + WS_Y)}; run_gemm(F.lds, GemmDims{512, 512, 512}, S, E); }
    SEAM(PH_MOEDN); }
    REPEAT(12) { if (IN(PH_FINAL)) p_final(F, P); }
#undef REPEAT
#undef SEAM
#undef IN
}

static void launch_mega(const Params& base, int lo, int hi, int grid, hipStream_t stream) {
    Params p = base; p.ph_lo = lo; p.ph_hi = hi;
    hipLaunchKernelGGL(mega, dim3(grid), dim3(NTHR), LDS_BYTES, stream, p);
}

extern "C" void kernel_launch(void* const* d_in, const int* in_sizes, int n_in, void* d_out, int out_size, void* d_ws, size_t ws_size, hipStream_t stream) {
    static int grid = 0;
    if (grid == 0) {
        if (n_in != 27 || out_size != T * DM || ws_size < WS_END) { fprintf(stderr, "kernel_launch: unexpected shapes (n_in %d out %d ws %zu)\n", n_in, out_size, ws_size); grid = -1; return; }
        if (hipFuncSetAttribute((const void*)mega, hipFuncAttributeMaxDynamicSharedMemorySize, LDS_BYTES) != hipSuccess) { fprintf(stderr, "hipFuncSetAttribute failed\n"); grid = -1; return; }
        int dev = 0, cus = 0, per_cu = 0; hipGetDevice(&dev); hipDeviceGetAttribute(&cus, hipDeviceAttributeMultiprocessorCount, dev);
        hipOccupancyMaxActiveBlocksPerMultiprocessor(&per_cu, (const void*)mega, NTHR, LDS_BYTES);
        (void)hipGetLastError();
        grid = cus * (per_cu < 1 ? 1 : 1);
    }
    if (grid < 0) return;
    Params P{};
    for (int i = 0; i < 27; ++i) P.in[i] = (const float*)d_in[i];
    P.out = (float*)d_out; P.ws = (unsigned char*)d_ws;
    if (hipMemsetAsync((char*)d_ws + WS_CTL, 0, CTL_ZERO_BYTES, stream) != hipSuccess) { fprintf(stderr, "kernel_launch: memset failed\n"); return; }
    P.ph_lo = 0; P.ph_hi = PH_N;
    void* args[] = {&P};
    const hipError_t le = hipLaunchCooperativeKernel((const void*)mega, dim3(grid), dim3(NTHR), args, LDS_BYTES, stream);
    if (le != hipSuccess) fprintf(stderr, "kernel_launch: cooperative launch failed: %s (grid %d)\n", hipGetErrorString(le), grid);
}
```

```cpp
#include <hip/hip_runtime.h>
#include <cstdint>
#include <cstdio>

#ifndef FAST_SSM
#define FAST_SSM 1
#endif
#ifndef FAST_ATTN
#define FAST_ATTN 1
#endif
#ifndef FAST_GEMM
#define FAST_GEMM 1
#endif
constexpr int BATCH = 4, SEQ = 8192, DM = 1024, T = BATCH * SEQ;
constexpr int NH = 8, HD = 64, FW = 512;
constexpr int SG = 32, SC = 16, SP = 64, SW = 512, LCH = 32, NCHB = SEQ / LCH, NCH = T / LCH;
constexpr int KY = 640;
constexpr int NPROJ = 4096;
constexpr int WIN_LD = 4104;
constexpr int NE = 16, FF = 256, NCLS = 24;
constexpr int MAXTILES = T / 256 + NCLS;
constexpr float EPS = 1e-6f;
constexpr float LOG2E = 1.4426950408889634f;
constexpr float C2 = 0.125f * LOG2E;

constexpr size_t MiB = 1u << 20;
constexpr size_t WS_CTL = 0;
constexpr size_t WS_WIN = 1 * MiB;
constexpr size_t WS_WOA = 9 * MiB;
constexpr size_t WS_WGLU = 10 * MiB;
constexpr size_t WS_WOB = 11 * MiB;
constexpr size_t WS_WO = 12 * MiB;
constexpr size_t WS_WGU = 14 * MiB;
constexpr size_t WS_WD = 30 * MiB;
constexpr size_t WS_MX = 54 * MiB;
constexpr size_t WS_WS = 74 * MiB;
constexpr size_t WS_AL = 79 * MiB;
constexpr size_t WS_CK2 = 80 * MiB;
constexpr size_t WS_LF = 81 * MiB;
constexpr size_t WS_CLS = 82 * MiB;
constexpr size_t WS_WAB = WS_CLS + 128 * 1024;
constexpr size_t WS_CNT = WS_WAB + 256 * 1024;
constexpr size_t WS_P2T = WS_CNT + 32 * 1024;
constexpr size_t WS_PW = WS_P2T + 160 * 1024;
constexpr size_t WS_TCLS = WS_PW + 320 * 1024;
constexpr size_t WS_QN = 83 * MiB;
constexpr size_t WS_KN = 83 * MiB + 65536;
constexpr size_t WS_NP = 84 * MiB;
constexpr size_t WS_XN = 96 * MiB;
constexpr size_t WS_T1 = WS_XN, WS_H2 = WS_XN;
constexpr size_t WS_Q = 160 * MiB, WS_K = 192 * MiB, WS_V = 224 * MiB;
constexpr size_t WS_MERGED = WS_Q;
constexpr size_t WS_HACT = WS_Q;
constexpr size_t WS_ZZ = WS_V;
constexpr size_t WS_UH = 256 * MiB;
constexpr size_t WS_S = 296 * MiB;
constexpr size_t WS_GATES = 312 * MiB;
constexpr size_t WS_XG = WS_GATES;
constexpr size_t WS_LIST = WS_UH;
constexpr size_t WS_LPW = WS_UH + 4 * MiB;
constexpr size_t WS_Y = WS_GATES;
constexpr size_t WS_TPOS = WS_UH + 20 * MiB;
constexpr size_t WS_PART = 392 * MiB;
constexpr size_t WS_OA = 440 * MiB;
constexpr size_t WS_Z = 472 * MiB;
constexpr size_t WS_END = 504 * MiB;

#define LAS __attribute__((address_space(3)))
typedef unsigned short bf16;
typedef float f32x4 __attribute__((ext_vector_type(4)));
typedef unsigned u32x4 __attribute__((ext_vector_type(4)));
typedef unsigned u32x2 __attribute__((ext_vector_type(2)));
typedef short bf16x8 __attribute__((ext_vector_type(8)));

typedef float f32x2_cv __attribute__((ext_vector_type(2))); typedef __bf16 bf16x2_cv __attribute__((ext_vector_type(2)));
__device__ __forceinline__ unsigned pk2(float lo, float hi) { const f32x2_cv v = {lo, hi}; const bf16x2_cv b = __builtin_convertvector(v, bf16x2_cv); return __builtin_bit_cast(unsigned, b); }
__device__ __forceinline__ unsigned f2bf(float f) { return pk2(f, 0.f) & 0xffffu; }
__device__ __forceinline__ float bf2f(unsigned b) { return __builtin_bit_cast(float, b << 16); }
__device__ __forceinline__ float wave_sum(float v) {
#pragma unroll
    for (int o = 1; o < 64; o <<= 1) v += __shfl_xor(v, o);
    return v;
}
__device__ __forceinline__ float sigmoidf_(float v) { return __builtin_amdgcn_rcpf(1.0f + __builtin_amdgcn_exp2f(v * -LOG2E)); }
__device__ __forceinline__ float sigmoid_b(float v, float nb) { return __builtin_amdgcn_rcpf(1.0f + __builtin_amdgcn_exp2f(__builtin_fmaf(v, -LOG2E, nb))); }
__device__ __forceinline__ float gelu_tanh(float y) { const float y2 = y * y; const float t = y * __builtin_fmaf(y2, -2.0f * LOG2E * 0.7978845608028654f * 0.044715f, -2.0f * LOG2E * 0.7978845608028654f); return y * __builtin_amdgcn_rcpf(1.0f + __builtin_amdgcn_exp2f(t)); }
__device__ __forceinline__ void store8(bf16* p, const float (&v)[8]) { u32x4 w; w.x = pk2(v[0], v[1]); w.y = pk2(v[2], v[3]); w.z = pk2(v[4], v[5]); w.w = pk2(v[6], v[7]); *(u32x4*)p = w; }
__device__ __forceinline__ void load8(const bf16* p, float (&v)[8]) { const u32x4 w = *(const u32x4*)p; v[0] = bf2f(w.x & 0xffffu); v[1] = bf2f(w.x >> 16); v[2] = bf2f(w.y & 0xffffu); v[3] = bf2f(w.y >> 16); v[4] = bf2f(w.z & 0xffffu); v[5] = bf2f(w.z >> 16); v[6] = bf2f(w.w & 0xffffu); v[7] = bf2f(w.w >> 16); }

__host__ __device__ __forceinline__ int pair_a(int pi) { return (pi >= 3) + (pi >= 5); }
__host__ __device__ __forceinline__ int pair_b(int pi) { return pi < 3 ? pi + 1 : (pi < 5 ? pi - 1 : 3); }
__host__ __device__ __forceinline__ int pair_idx(int a, int b) { return a == 0 ? b - 1 : (a == 1 ? b + 1 : 5); }

struct Params {
    const float* in[27];
    float* out;
    unsigned char* ws;
    int ph_lo, ph_hi;
};

struct UnitX { int pm, pn; const char* A; const char* B; int aux, tic, cnt; const char* A2; const char* B2; };
struct GemmDims { int K, lda, ldb; };
constexpr int RT_ROWB = 528;

struct SchedPlain {
    static constexpr bool GATHER = false;
    static constexpr int KSPLIT = 1 << 20;
    const bf16* A; const bf16* Bt; int nM, nN; GemmDims d;
    __device__ __forceinline__ int count() const { return nM * nN; }
    __device__ __forceinline__ bool get(int idx, UnitX& u) const {
        if (idx >= nM * nN) return false;
        int wgid = idx; { const int nwg = nM * nN, q = nwg / 8, r = nwg % 8, xcd = wgid % 8, off = wgid / 8; wgid = (xcd < r ? xcd * (q + 1) : r * (q + 1) + (xcd - r) * q) + off; }
        const int nig = 8 * nN, gid = wgid / nig, fm = gid * 8, gsz = (nM - fm) < 8 ? (nM - fm) : 8;
        u.pm = fm + ((wgid % nig) % gsz); u.pn = (wgid % nig) / gsz; u.aux = 0;
        u.A = (const char*)A + (size_t)u.pm * 256 * d.lda * 2; u.B = (const char*)Bt + (size_t)u.pn * 256 * d.ldb * 2; return true;
    }
};
struct SchedOutAB {
    static constexpr bool GATHER = false; static constexpr int KSPLIT = 8;
    const bf16* OA; const bf16* ZZ; const bf16* WoaT; const bf16* WobT;
    __device__ __forceinline__ bool get(int idx, UnitX& u) const {
        const int nM = T / 256, nN = 4; if (idx >= nM * nN) return false;
        int wgid = idx; { const int nwg = nM * nN, q = nwg / 8, r = nwg % 8, xcd = wgid % 8, off = wgid / 8; wgid = (xcd < r ? xcd * (q + 1) : r * (q + 1) + (xcd - r) * q) + off; }
        const int nig = 8 * nN, gid = wgid / nig, fm = gid * 8, gsz = (nM - fm) < 8 ? (nM - fm) : 8;
        u.pm = fm + ((wgid % nig) % gsz); u.pn = (wgid % nig) / gsz; u.aux = 0; u.tic = 0; u.cnt = 0;
        u.A = (const char*)(OA + (size_t)u.pm * 256 * 512); u.B = (const char*)(WoaT + (size_t)u.pn * 256 * 512);
        u.A2 = (const char*)(ZZ + (size_t)u.pm * 256 * 512) - (size_t)KSPLIT * 128; u.B2 = (const char*)(WobT + (size_t)u.pn * 256 * 512) - (size_t)KSPLIT * 128; return true;
    }
};
struct SchedSsmS {
    static constexpr bool GATHER = false;
    static constexpr int KSPLIT = 1 << 20;
    const bf16* UH; const bf16* WsT;
    __device__ __forceinline__ int count() const { return SG * 4; }
    __device__ __forceinline__ bool get(int idx, UnitX& u) const {
        if (idx >= SG * 4) return false; const int g = idx >> 2, mt = idx & 3;
        u.pm = g * 4 + mt; u.pn = 0; u.aux = g; u.A = (const char*)(UH + ((size_t)g * NCH + mt * 256) * KY); u.B = (const char*)(WsT + (size_t)g * 128 * 512); return true;
    }
};
struct SchedSsmY {
    static constexpr bool GATHER = false;
    static constexpr int KSPLIT = 1 << 20;
    const bf16* UH; const bf16* MxT; int G;
    __device__ __forceinline__ int count() const { return SG * 8; }
    __device__ __forceinline__ bool get(int idx, UnitX& u) const {
        const int k = idx / G, c = idx - k * G; if (c >= SG * 4 || k >= 2) return false; const int g = c >> 2, mt = c & 3, nt = k;
        u.pm = g * 4 + mt; u.pn = nt; u.aux = g; u.A = (const char*)(UH + ((size_t)g * NCH + mt * 256) * KY); u.B = (const char*)(MxT + ((size_t)g * 512 + nt * 256) * KY); return true;
    }
};
struct MoeRange { int base, end, per, wskip, G;
    __device__ __forceinline__ int unit(int idx) const { int u;
        if (per > 0) { const int k = idx / G, c = idx - k * G - wskip; if (c < 0 || k >= per) return -1; u = base + c * per + k; } else u = base + idx;
        return u < end ? u : -1; } };
struct SchedMoeGU {
    static constexpr bool GATHER = true;
    static constexpr int KSPLIT = 1 << 20;
    const bf16* H2; const bf16* WguT; const int* LIST; const LAS int* tt;
    MoeRange R;
    __device__ __forceinline__ int count() const { return MAXTILES * 4; }
    __device__ __forceinline__ bool get(int idx_, UnitX& u) const {
        const int idx = R.unit(idx_); if (idx < 0) return false; const int tile = idx >> 2, pn = idx & 3; const int cls = tt[2 * tile]; if (cls < 0) return false;
        const int grp = cls / 6, pi = cls % 6, e = grp * 4 + ((pn >> 1) ? pair_b(pi) : pair_a(pi));
        u.pm = tile; u.pn = pn; u.aux = cls; u.tic = tt[2 * tile + 1]; u.cnt = tt[512 + cls]; u.A = (const char*)H2; u.B = (const char*)(WguT + ((size_t)e * 512 + (pn & 1) * 256) * DM); return true;
    }
    __device__ __forceinline__ unsigned rowoff(const UnitX& u, int r) const { const int pos = u.tic * 256 + r; const int tok = pos < u.cnt ? LIST[(size_t)u.aux * T + pos] : 0; return (unsigned)tok * (unsigned)(DM * 2); }
};
struct SchedMoeDN {
    static constexpr bool GATHER = false;
    static constexpr int KSPLIT = 1 << 20;
    const bf16* HACT; const bf16* WdT; const LAS int* tt;
    MoeRange R;
    __device__ __forceinline__ int count() const { return MAXTILES * 4; }
    __device__ __forceinline__ bool get(int idx_, UnitX& u) const {
        const int idx = R.unit(idx_); if (idx < 0) return false; const int tile = idx >> 2, pn = idx & 3; const int cls = tt[2 * tile]; if (cls < 0) return false;
        u.pm = tile; u.pn = pn; u.aux = cls; u.tic = tt[2 * tile + 1]; u.cnt = tt[512 + cls]; u.A = (const char*)(HACT + (size_t)tile * 256 * 512); u.B = (const char*)(WdT + ((size_t)cls * 1024 + pn * 256) * 512); return true;
    }
};

struct NoIn {};
struct EpiProj {
    static constexpr bool PAIR = false;
    bf16 *Q, *K, *V, *UH, *GATES; const LAS float* bgate; float* NP;
    struct In { f32x4 b0, b1; };
    __device__ __forceinline__ In load(const UnitX& u, int r, int c) const { In in; const int pn = __builtin_amdgcn_readfirstlane(u.pn);
        if (pn >= 8) { const LAS float* bp = bgate + (pn - 8) * 256 + c; in.b0 = *(const LAS f32x4*)bp; in.b1 = *(const LAS f32x4*)(bp + 4); } else { in.b0 = (f32x4){0.f, 0.f, 0.f, 0.f}; in.b1 = in.b0; } return in; }
    __device__ __forceinline__ void apply(const UnitX& u, int r, int c, const float (&v)[8], const In& in) const {
        const int pn = __builtin_amdgcn_readfirstlane(u.pn); const unsigned row = (unsigned)(u.pm * 256 + r);
        static_assert(WS_K - WS_Q == 32 * MiB && WS_V - WS_K == 32 * MiB, "q | k | v buffers equally spaced");
        if (pn < 6) { bf16* base = Q + (size_t)(pn >> 1) * (size_t)(16u << 20); const float sc = pn < 2 ? C2 : 1.0f; float w[8];
#pragma unroll
            for (int e = 0; e < 8; ++e) w[e] = v[e] * sc;
            store8(base + (row * 512u + (unsigned)((pn & 1) * 256 + c)), w);
            if (pn < 4) { float ss = ((w[0] * w[0] + w[1] * w[1]) + (w[2] * w[2] + w[3] * w[3])) + ((w[4] * w[4] + w[5] * w[5]) + (w[6] * w[6] + w[7] * w[7]));
                ss += __shfl_xor(ss, 16); ss += __shfl_xor(ss, 32);
                if ((c & 24) == 0) NP[row * 32u + (unsigned)((pn >> 1) * 16 + (pn & 1) * 8 + (c >> 5))] = ss; } }
        else if (pn < 8) { const int cc = (pn - 6) * 256 + c, g = cc >> 4, ch0 = cc & 15; const unsigned n = row >> 5, i = row & 31u; store8(UH + (((unsigned)g * NCH + n) * (unsigned)KY + i * 16u + (unsigned)ch0), v); }
        else { const unsigned cc = (unsigned)((pn - 8) * 256 + c); unsigned q[8]; const float bb[8] = {in.b0.x, in.b0.y, in.b0.z, in.b0.w, in.b1.x, in.b1.y, in.b1.z, in.b1.w};
#pragma unroll
            for (int e = 0; e < 8; ++e) q[e] = (unsigned)__builtin_fmaf(sigmoid_b(v[e], bb[e]), 255.0f, 0.5f);
            u32x2 w; w.x = q[0] | (q[1] << 8) | (q[2] << 16) | (q[3] << 24); w.y = q[4] | (q[5] << 8) | (q[6] << 16) | (q[7] << 24);
            *(u32x2*)((unsigned char*)GATES + (row * 2048u + cc)) = w; }
    }
};
struct EpiSsmS {
    static constexpr bool PAIR = false;
    float* S;
    typedef NoIn In;
    __device__ __forceinline__ In load(const UnitX&, int, int) const { return In{}; }
    __device__ __forceinline__ void apply(const UnitX& u, int r, int c, const float (&v)[8], const In&) const {
        if (c >= 128) return;
        float* p = S + ((size_t)u.pm * 256 + r) * 128 + c;
        *(f32x4*)p = (f32x4){v[0], v[1], v[2], v[3]}; *(f32x4*)(p + 4) = (f32x4){v[4], v[5], v[6], v[7]};
    }
};
struct EpiSsmY {
    static constexpr bool PAIR = false;
    bf16* Z;
    typedef NoIn In;
    __device__ __forceinline__ In load(const UnitX&, int, int) const { return In{}; }
    __device__ __forceinline__ void apply(const UnitX& u, int r, int c, const float (&v)[8], const In&) const {
        const int g = u.aux, chunk = (u.pm & 3) * 256 + r, col = u.pn * 256 + c, j = col >> 4, o0 = col & 15; const int token = chunk * LCH + j; float w[8];
#pragma unroll
        for (int e = 0; e < 8; ++e) w[e] = gelu_tanh(v[e]);
        store8(Z + (size_t)token * SW + g * 16 + o0, w);
    }
};
struct EpiGlu {
    static constexpr bool PAIR = false;
    const bf16* Z; bf16* ZZ; const LAS float* bglu;
    struct In { u32x4 z; f32x4 b0, b1; };
    __device__ __forceinline__ In load(const UnitX& u, int r, int c) const { In in; const int row = u.pm * 256 + r, col = u.pn * 256 + c;
        in.z = *(const u32x4*)(Z + (size_t)row * SW + col); in.b0 = *(const LAS f32x4*)(bglu + col); in.b1 = *(const LAS f32x4*)(bglu + col + 4); return in; }
    __device__ __forceinline__ void apply(const UnitX& u, int r, int c, const float (&v)[8], const In& in) const {
        const int row = u.pm * 256 + r, col = u.pn * 256 + c; float w[8];
        const float z[8] = {bf2f(in.z.x & 0xffffu), bf2f(in.z.x >> 16), bf2f(in.z.y & 0xffffu), bf2f(in.z.y >> 16), bf2f(in.z.z & 0xffffu), bf2f(in.z.z >> 16), bf2f(in.z.w & 0xffffu), bf2f(in.z.w >> 16)};
        const float bb[8] = {in.b0.x, in.b0.y, in.b0.z, in.b0.w, in.b1.x, in.b1.y, in.b1.z, in.b1.w};
#pragma unroll
        for (int e = 0; e < 8; ++e) w[e] = z[e] * sigmoid_b(v[e], bb[e]);
        store8(ZZ + (size_t)row * SW + col, w);
    }
};
__device__ __forceinline__ void unpack_u8(const u32x2 w, float (&v)[8]) { const float s = 1.0f / 255.0f;
    v[0] = (float)(w.x & 0xffu) * s; v[1] = (float)((w.x >> 8) & 0xffu) * s; v[2] = (float)((w.x >> 16) & 0xffu) * s; v[3] = (float)(w.x >> 24) * s;
    v[4] = (float)(w.y & 0xffu) * s; v[5] = (float)((w.y >> 8) & 0xffu) * s; v[6] = (float)((w.y >> 16) & 0xffu) * s; v[7] = (float)(w.y >> 24) * s; }
struct EpiOutA {
    static constexpr bool PAIR = false;
    const bf16* GATES; bf16* T1;
    struct In { u32x2 g; };
    __device__ __forceinline__ In load(const UnitX& u, int r, int c) const { In in; in.g = *(const u32x2*)((const unsigned char*)GATES + (size_t)(u.pm * 256 + r) * 2048 + u.pn * 256 + c); return in; }
    __device__ __forceinline__ void apply(const UnitX& u, int r, int c, const float (&v)[8], const In& in) const {
        const int row = u.pm * 256 + r, col = u.pn * 256 + c; float g[8], w[8]; unpack_u8(in.g, g);
#pragma unroll
        for (int e = 0; e < 8; ++e) w[e] = g[e] * v[e];
        store8(T1 + (size_t)row * DM + col, w);
    }
};
struct EpiOutB {
    static constexpr bool PAIR = false;
    const bf16* GATES; const bf16* T1; bf16* MG;
    struct In { u32x2 g; u32x4 t; };
    __device__ __forceinline__ In load(const UnitX& u, int r, int c) const { In in; const int row = u.pm * 256 + r, col = u.pn * 256 + c;
        in.g = *(const u32x2*)((const unsigned char*)GATES + (size_t)row * 2048 + 1024 + col); in.t = *(const u32x4*)(T1 + (size_t)row * DM + col); return in; }
    __device__ __forceinline__ void apply(const UnitX& u, int r, int c, const float (&v)[8], const In& in) const {
        const int row = u.pm * 256 + r, col = u.pn * 256 + c; float g[8], w[8]; unpack_u8(in.g, g);
        const float t[8] = {bf2f(in.t.x & 0xffffu), bf2f(in.t.x >> 16), bf2f(in.t.y & 0xffffu), bf2f(in.t.y >> 16), bf2f(in.t.z & 0xffffu), bf2f(in.t.z >> 16), bf2f(in.t.w & 0xffffu), bf2f(in.t.w >> 16)};
#pragma unroll
        for (int e = 0; e < 8; ++e) w[e] = t[e] + g[e] * v[e];
        store8(MG + (size_t)row * DM + col, w);
    }
};
struct EpiOutAB {
    static constexpr bool PAIR = false, MID = true;
    const unsigned char* GATES; bf16* MG;
    struct In { u32x2 g; };
    struct MidIn { u32x2 g0, g1; };
    __device__ __forceinline__ MidIn mid_load(const UnitX& u, int r, int c) const { MidIn in; const unsigned char* p = GATES + (size_t)(u.pm * 256 + r) * 2048 + u.pn * 256 + c; in.g0 = *(const u32x2*)p; in.g1 = *(const u32x2*)(p + 1024); return in; }
    __device__ __forceinline__ void mid_apply(float (&v)[8], const MidIn& in) const { float g0[8], g1[8]; unpack_u8(in.g0, g0); unpack_u8(in.g1, g1);
#pragma unroll
        for (int e = 0; e < 8; ++e) v[e] *= g0[e] * __builtin_amdgcn_rcpf(fmaxf(g1[e], 1.0f / 512.0f)); }
    __device__ __forceinline__ In load(const UnitX& u, int r, int c) const { In in; in.g = *(const u32x2*)(GATES + (size_t)(u.pm * 256 + r) * 2048 + 1024 + u.pn * 256 + c); return in; }
    __device__ __forceinline__ void apply(const UnitX& u, int r, int c, const float (&v)[8], const In& in) const {
        float g1[8], w[8]; unpack_u8(in.g, g1);
#pragma unroll
        for (int e = 0; e < 8; ++e) w[e] = v[e] * fmaxf(g1[e], 1.0f / 512.0f);
        store8(MG + (size_t)(u.pm * 256 + r) * DM + u.pn * 256 + c, w);
    }
};
struct EpiWout {
    static constexpr bool PAIR = false, ROWJ = true;
    const float* x; bf16* X1B; float* PART; const LAS unsigned char* TB;
    struct In { f32x4 a, b; };
    __device__ __forceinline__ In load(const UnitX& u, int r, int c) const { In in; const size_t off = (size_t)(u.pm * 256 + r) * DM + u.pn * 256 + c; in.a = *(const f32x4*)(x + off); in.b = *(const f32x4*)(x + off + 4); return in; }
    __device__ __forceinline__ void apply2(const UnitX& u, int r, int c, const float (&v0)[8], const float (&v1)[8], const In& i0, const In& i1) const {
        const int fr = r & 15, fq = (c >> 3) & 3, wc = c >> 5; const unsigned row = (unsigned)(u.pm * 256 + r);
        const float xa[2][8] = {{i0.a.x + v0[0], i0.a.y + v0[1], i0.a.z + v0[2], i0.a.w + v0[3], i0.b.x + v0[4], i0.b.y + v0[5], i0.b.z + v0[6], i0.b.w + v0[7]},
                                {i1.a.x + v1[0], i1.a.y + v1[1], i1.a.z + v1[2], i1.a.w + v1[3], i1.b.x + v1[4], i1.b.y + v1[5], i1.b.z + v1[6], i1.b.w + v1[7]}};
        float ss = 0.f; f32x4 lg0 = {0.f, 0.f, 0.f, 0.f}, lg1 = {0.f, 0.f, 0.f, 0.f};
        const LAS unsigned char* t0 = TB + fr * RT_ROWB + c * 2; const LAS unsigned char* t1 = TB + (16 + (fr & 3)) * RT_ROWB + c * 2;
#pragma unroll
        for (int bj = 0; bj < 2; ++bj) { const float (&xv)[8] = xa[bj];
            const unsigned h0 = pk2(xv[0], xv[1]), h1 = pk2(xv[2], xv[3]), h2 = pk2(xv[4], xv[5]), h3 = pk2(xv[6], xv[7]);
            const unsigned l0 = pk2(xv[0] - bf2f(h0 & 0xffffu), xv[1] - bf2f(h0 >> 16)), l1 = pk2(xv[2] - bf2f(h1 & 0xffffu), xv[3] - bf2f(h1 >> 16)),
                           l2 = pk2(xv[4] - bf2f(h2 & 0xffffu), xv[5] - bf2f(h2 >> 16)), l3 = pk2(xv[6] - bf2f(h3 & 0xffffu), xv[7] - bf2f(h3 >> 16));
            *(u32x4*)(X1B + (row * (unsigned)DM + (unsigned)(u.pn * 256 + bj * 128 + c))) = (u32x4){h0, h1, h2, h3};
            ss += ((xv[0] * xv[0] + xv[1] * xv[1]) + (xv[2] * xv[2] + xv[3] * xv[3])) + ((xv[4] * xv[4] + xv[5] * xv[5]) + (xv[6] * xv[6] + xv[7] * xv[7]));
            const bf16x8 xh = __builtin_bit_cast(bf16x8, (u32x4){h0, h1, h2, h3}), xl = __builtin_bit_cast(bf16x8, (u32x4){l0, l1, l2, l3});
            const bf16x8 th0 = *(const LAS bf16x8*)(t0 + bj * 256), tl0 = *(const LAS bf16x8*)(t0 + bj * 256 + 20 * RT_ROWB), th1 = *(const LAS bf16x8*)(t1 + bj * 256), tl1 = *(const LAS bf16x8*)(t1 + bj * 256 + 20 * RT_ROWB);
            lg0 = __builtin_amdgcn_mfma_f32_16x16x32_bf16(th0, xh, lg0, 0, 0, 0); lg0 = __builtin_amdgcn_mfma_f32_16x16x32_bf16(th0, xl, lg0, 0, 0, 0); lg0 = __builtin_amdgcn_mfma_f32_16x16x32_bf16(tl0, xh, lg0, 0, 0, 0);
            lg1 = __builtin_amdgcn_mfma_f32_16x16x32_bf16(th1, xh, lg1, 0, 0, 0); lg1 = __builtin_amdgcn_mfma_f32_16x16x32_bf16(th1, xl, lg1, 0, 0, 0); lg1 = __builtin_amdgcn_mfma_f32_16x16x32_bf16(tl1, xh, lg1, 0, 0, 0); }
        ss += __shfl_xor(ss, 16); ss += __shfl_xor(ss, 32);
        f32x4* p = (f32x4*)PART + ((unsigned)((u.pn * 4 + wc) * 6) * (unsigned)T + row);
        p[(unsigned)fq * (unsigned)T] = lg0; if (fq == 0) p[4u * (unsigned)T] = lg1; if (fq == 1) p[5u * (unsigned)T] = (f32x4){ss, 0.f, 0.f, 0.f};
    }
};
struct EpiMoeGU {
    static constexpr bool PAIR = true;
    bf16* HACT; const float* LPW;
    struct In { f32x4 pw; };
    __device__ __forceinline__ In load(const UnitX& u, int r, int) const { In in; const int pos = u.tic * 256 + r; in.pw = (f32x4){0.f, 0.f, 0.f, 0.f}; if (pos < u.cnt) in.pw = *((const f32x4*)LPW + (size_t)u.aux * T + pos); return in; }
    __device__ __forceinline__ void apply_pair(const UnitX& u, int r, int c, const float (&vg)[8], const float (&vu)[8], const In& in) const {
        const float w = (u.pn >> 1) ? in.pw.y : in.pw.x, rs = in.pw.z; float o[8];
#pragma unroll
        for (int e = 0; e < 8; ++e) { const float gt = vg[e] * rs; o[e] = gt * sigmoidf_(gt) * (vu[e] * rs) * w; }
        store8(HACT + (size_t)(u.pm * 256 + r) * 512 + (u.pn >> 1) * 256 + (u.pn & 1) * 128 + c, o);
    }
};
struct EpiMoeDN {
    static constexpr bool PAIR = false;
    bf16* Y;
    typedef NoIn In;
    __device__ __forceinline__ In load(const UnitX&, int, int) const { return In{}; }
    __device__ __forceinline__ void apply(const UnitX& u, int r, int c, const float (&v)[8], const In&) const { store8(Y + (size_t)(u.pm * 256 + r) * DM + u.pn * 256 + c, v); }
};

namespace pg8 {
constexpr int BM = 256, BK = 64, HALF = 128, HTB = HALF * BK * 2, STAGE_BYTES = 8 * HTB;
__host__ __device__ __forceinline__ int lds_byte(int r, int c) { const int st = (r >> 4) * 2 + (c >> 5), rr = r & 15, cc = c & 31, ob = rr * 64 + cc * 2; return st * 1024 + (ob ^ (((ob >> 9) & 1) << 5)); }
__host__ __device__ __forceinline__ void stage_rc(int b, int& R, int& C) { const int st = b / 1024, sb = b % 1024, swz = sb ^ (((sb >> 9) & 1) << 5); R = (st >> 1) * 16 + swz / 64; C = (st & 1) * 32 + (swz % 64) / 2; }
__host__ __device__ __forceinline__ int perm32(int rho) { const int n = rho >> 4, i = rho & 15; return 8 * (i >> 2) + 4 * n + (i & 3); }

template <class Epi, class = void> struct HasMid { static constexpr bool value = false; };
template <class Epi> struct HasMid<Epi, decltype((void)Epi::MID)> { static constexpr bool value = Epi::MID; };
template <class Epi, class = void> struct HasRowJ { static constexpr bool value = false; };
template <class Epi> struct HasRowJ<Epi, decltype((void)Epi::ROWJ)> { static constexpr bool value = Epi::ROWJ; };
template <class Epi> struct EpiAdapt {
    static constexpr bool PERM = true, MID = HasMid<Epi>::value;
    Epi E;
    __device__ __forceinline__ void mid(f32x4 (&acc)[2][2][4][2], const UnitX& u, int wr, int wc, int fr, int fq) const {
        if constexpr (MID) { asm volatile("" : "+v"(fr), "+v"(fq));
            const int c = wc * 32 + 8 * fq;
#pragma unroll
            for (int ai = 0; ai < 2; ++ai) { typename Epi::MidIn in[4][2];
#pragma unroll
                for (int m = 0; m < 4; ++m)
#pragma unroll
                    for (int bj = 0; bj < 2; ++bj) in[m][bj] = E.mid_load(u, ai * HALF + wr * 64 + m * 16 + fr, bj * HALF + c);
#pragma unroll
                for (int m = 0; m < 4; ++m)
#pragma unroll
                    for (int bj = 0; bj < 2; ++bj) { f32x4& a0 = acc[ai][bj][m][0]; f32x4& a1 = acc[ai][bj][m][1]; float v[8] = {a0[0], a0[1], a0[2], a0[3], a1[0], a1[1], a1[2], a1[3]};
                        E.mid_apply(v, in[m][bj]); a0 = (f32x4){v[0], v[1], v[2], v[3]}; a1 = (f32x4){v[4], v[5], v[6], v[7]}; } } }
    }
    __device__ __forceinline__ void operator()(const f32x4 (&acc)[2][2][4][2], const UnitX& u, int wr, int wc, int fr, int fq) const {
        asm volatile("" : "+v"(fr), "+v"(fq));
        const int c = wc * 32 + 8 * fq;
#pragma unroll
        for (int ai = 0; ai < 2; ++ai) {
            if constexpr (Epi::PAIR) { typename Epi::In in[4];
#pragma unroll
                for (int m = 0; m < 4; ++m) in[m] = E.load(u, ai * HALF + wr * 64 + m * 16 + fr, c);
#pragma unroll
                for (int m = 0; m < 4; ++m) { const int r = ai * HALF + wr * 64 + m * 16 + fr; const f32x4 g0 = acc[ai][0][m][0], g1 = acc[ai][0][m][1], u0 = acc[ai][1][m][0], u1 = acc[ai][1][m][1];
                    const float vg[8] = {g0[0], g0[1], g0[2], g0[3], g1[0], g1[1], g1[2], g1[3]}, vu[8] = {u0[0], u0[1], u0[2], u0[3], u1[0], u1[1], u1[2], u1[3]};
                    E.apply_pair(u, r, c, vg, vu, in[m]); } }
            else if constexpr (HasRowJ<Epi>::value) {
#pragma unroll
                for (int mp = 0; mp < 4; mp += 2) { typename Epi::In in[2][2];
#pragma unroll
                    for (int m = 0; m < 2; ++m)
#pragma unroll
                        for (int bj = 0; bj < 2; ++bj) in[m][bj] = E.load(u, ai * HALF + wr * 64 + (mp + m) * 16 + fr, bj * HALF + c);
#pragma unroll
                    for (int m = 0; m < 2; ++m) { const int r = ai * HALF + wr * 64 + (mp + m) * 16 + fr; const f32x4 a0 = acc[ai][0][mp + m][0], a1 = acc[ai][0][mp + m][1], b0 = acc[ai][1][mp + m][0], b1 = acc[ai][1][mp + m][1];
                        const float v0[8] = {a0[0], a0[1], a0[2], a0[3], a1[0], a1[1], a1[2], a1[3]}, v1[8] = {b0[0], b0[1], b0[2], b0[3], b1[0], b1[1], b1[2], b1[3]};
                        E.apply2(u, r, c, v0, v1, in[m][0], in[m][1]); } } }
            else { typename Epi::In in[4][2];
#pragma unroll
                for (int m = 0; m < 4; ++m)
#pragma unroll
                    for (int bj = 0; bj < 2; ++bj) in[m][bj] = E.load(u, ai * HALF + wr * 64 + m * 16 + fr, bj * HALF + c);
#pragma unroll
                for (int m = 0; m < 4; ++m)
#pragma unroll
                    for (int bj = 0; bj < 2; ++bj) { const int r = ai * HALF + wr * 64 + m * 16 + fr; const f32x4 a0 = acc[ai][bj][m][0], a1 = acc[ai][bj][m][1];
                        const float v[8] = {a0[0], a0[1], a0[2], a0[3], a1[0], a1[1], a1[2], a1[3]}; E.apply(u, r, bj * HALF + c, v, in[m][bj]); } } }
    }
};

template <class Epi, class Sched, bool ALIGN_EPI, bool SP2>
__device__ __forceinline__ void gemm_phase(LAS unsigned char* lds, const GemmDims d, const Sched& S, const Epi& E, const int G, const int cidx) {
    int tid = threadIdx.x; asm volatile("" : "+v"(tid));
    const int wid = __builtin_amdgcn_readfirstlane(tid >> 6), lane = tid & 63, wr = wid >> 2, wc = wid & 3, fr = lane & 15, fq = lane >> 4;
    const int K = d.K, nt = K / BK;
    unsigned voffB[2]; int RA[2], CA2[2];
#pragma unroll
    for (int i = 0; i < 2; ++i) { int R, C; stage_rc(tid * 16 + i * 8192, R, C); const int Rb = Epi::PERM ? ((R & ~31) + perm32(R & 31)) : R;
        RA[i] = R; CA2[i] = C * 2; voffB[i] = (unsigned)(Rb * d.ldb + C) * 2u; }
    const size_t kstep = (size_t)(BK * 2);
    const size_t hstepB = (size_t)HALF * d.ldb * 2;
#define PG8_AOFF(dst, unit) do { _Pragma("unroll") for (int h_ = 0; h_ < 2; ++h_) _Pragma("unroll") for (int i_ = 0; i_ < 2; ++i_) { \
        if constexpr (Sched::GATHER) dst[h_][i_] = S.rowoff(unit, h_ * HALF + RA[i_]) + (unsigned)CA2[i_]; else dst[h_][i_] = (unsigned)((h_ * HALF + RA[i_]) * d.lda) * 2u + (unsigned)CA2[i_]; } } while (0)
    const unsigned ldsw = (unsigned)wid * 1024u;
    const int aoff = lds_byte(wr * 64 + fr, fq * 8), boff = lds_byte(wc * 32 + fr, fq * 8);
#define PG8_SA(b, h) (((b) * 2 + (h)) * HTB)
#define PG8_SB(b, h) ((4 + (b) * 2 + (h)) * HTB)
#define PG8_STAGE(bufoff, gbase, voff) do { _Pragma("unroll") for (int _i = 0; _i < 2; ++_i) \
        __builtin_amdgcn_global_load_lds((const unsigned*)((const char*)(gbase) + (voff)[_i]), (LAS unsigned*)(lds + (bufoff) + ldsw + _i * 8192), 16, 0, 0); } while (0)
#define PG8_LDA(dst, b, h) do { _Pragma("unroll") for (int m = 0; m < 4; ++m) _Pragma("unroll") for (int k = 0; k < 2; ++k) dst[m][k] = *(const LAS bf16x8*)(lds + PG8_SA(b, h) + aoff + m * 2048 + k * 1024); } while (0)
#define PG8_LDB(dst, b, h) do { _Pragma("unroll") for (int n = 0; n < 2; ++n) _Pragma("unroll") for (int k = 0; k < 2; ++k) dst[n][k] = *(const LAS bf16x8*)(lds + PG8_SB(b, h) + boff + n * 2048 + k * 1024); } while (0)
#define PG8_MMA(ai, bj, At, Bt) do { __builtin_amdgcn_s_setprio(1); _Pragma("unroll") for (int m = 0; m < 4; ++m) _Pragma("unroll") for (int n = 0; n < 2; ++n) _Pragma("unroll") for (int k = 0; k < 2; ++k) \
        acc[ai][bj][m][n] = __builtin_amdgcn_mfma_f32_16x16x32_bf16(Bt[n][k], At[m][k], acc[ai][bj][m][n], 0, 0, 0); __builtin_amdgcn_s_setprio(0); } while (0)
#define PG8_WAIT_V(n) asm volatile("s_waitcnt vmcnt(" #n ")" ::: "memory")
#define PG8_WAIT_L(n) asm volatile("s_waitcnt lgkmcnt(" #n ")" ::: "memory")
#define PG8_BAR __builtin_amdgcn_s_barrier()
#define PG8_SCHED __builtin_amdgcn_sched_barrier(0)
    UnitX cur, nxt; int ui = 0;
    if (!S.get(cidx, cur)) return;
    f32x4 acc[2][2][4][2];
#pragma unroll
    for (int a = 0; a < 2; ++a)
#pragma unroll
        for (int b = 0; b < 2; ++b)
#pragma unroll
            for (int m = 0; m < 4; ++m)
#pragma unroll
                for (int n = 0; n < 2; ++n) acc[a][b][m][n] = (f32x4){0.f, 0.f, 0.f, 0.f};
    bf16x8 At[4][2], B0[2][2], B1[2][2];
    const char* cA = cur.A; const char* cB = cur.B;
    constexpr int KS = Sched::KSPLIT;
    const char* cA2 = KS < 1024 ? cur.A2 : cA; const char* cB2 = KS < 1024 ? cur.B2 : cB;
    unsigned vA[2][2], nvA[2][2]; PG8_AOFF(vA, cur);
    static_assert(SP2, "this port keeps the SP2 loop only");
    {
        PG8_STAGE(PG8_SB(0, 0), cB, voffB); PG8_STAGE(PG8_SB(0, 1), cB + hstepB, voffB); PG8_STAGE(PG8_SA(0, 0), cA, vA[0]); PG8_STAGE(PG8_SA(0, 1), cA, vA[1]);
        if (wr == 1) PG8_BAR;
        PG8_WAIT_V(2); PG8_BAR;
        PG8_STAGE(PG8_SB(1, 0), cB + kstep, voffB); PG8_STAGE(PG8_SA(1, 0), cA + kstep, vA[0]); PG8_STAGE(PG8_SB(1, 1), cB + hstepB + kstep, voffB);
        PG8_WAIT_V(6); PG8_BAR;
    }
    for (;;) {
        const bool has_next = S.get((ui + 1) * G + cidx, nxt);
        const char* nA = has_next ? nxt.A : cA; const char* nB = has_next ? nxt.B : cB;
        if (has_next) { PG8_AOFF(nvA, nxt); } else {
#pragma unroll
            for (int h_ = 0; h_ < 2; ++h_)
#pragma unroll
                for (int i_ = 0; i_ < 2; ++i_) nvA[h_][i_] = vA[h_][i_]; }
        for (int t = 0; t < nt; t += 2) {
            const bool last = (t == nt - 2);
            if constexpr (Epi::MID) { if (t == KS) E.mid(acc, cur, wr, wc, fr, fq); }
            const char* a1 = ((t + 1 >= KS) ? cA2 : cA) + (size_t)(t + 1) * kstep;
            const char* a2 = last ? nA : ((t + 2 >= KS) ? cA2 : cA) + (size_t)(t + 2) * kstep; const char* b2 = last ? nB : ((t + 2 >= KS) ? cB2 : cB) + (size_t)(t + 2) * kstep;
            const char* a3 = a2 + kstep; const char* b3 = b2 + kstep;
            unsigned wA0[2], wA1[2];
#pragma unroll
            for (int i_ = 0; i_ < 2; ++i_) { wA0[i_] = last ? nvA[0][i_] : vA[0][i_]; wA1[i_] = last ? nvA[1][i_] : vA[1][i_]; }
            PG8_LDB(B0, 0, 0); PG8_LDB(B1, 0, 1); PG8_SCHED; PG8_LDA(At, 0, 0); PG8_STAGE(PG8_SA(1, 1), a1, vA[1]);
            PG8_WAIT_V(8); PG8_WAIT_L(0); PG8_BAR; PG8_MMA(0, 0, At, B0); PG8_MMA(0, 1, At, B1); PG8_BAR; PG8_SCHED;
            PG8_LDA(At, 0, 1); PG8_STAGE(PG8_SB(0, 0), b2, voffB); PG8_STAGE(PG8_SB(0, 1), b2 + hstepB, voffB); PG8_STAGE(PG8_SA(0, 0), a2, wA0);
            PG8_WAIT_V(8); PG8_WAIT_L(0); PG8_BAR; PG8_MMA(1, 0, At, B0); PG8_MMA(1, 1, At, B1); PG8_BAR; PG8_SCHED;
            PG8_LDB(B0, 1, 0); PG8_LDB(B1, 1, 1); PG8_SCHED; PG8_LDA(At, 1, 0); PG8_STAGE(PG8_SA(0, 1), a2, wA1);
            PG8_WAIT_V(8); PG8_WAIT_L(0); PG8_BAR; PG8_MMA(0, 0, At, B0); PG8_MMA(0, 1, At, B1); PG8_BAR; PG8_SCHED;
            PG8_LDA(At, 1, 1); PG8_STAGE(PG8_SB(1, 0), b3, voffB); PG8_STAGE(PG8_SB(1, 1), b3 + hstepB, voffB); PG8_STAGE(PG8_SA(1, 0), a3, wA0);
            PG8_WAIT_V(8); PG8_WAIT_L(0); PG8_BAR; PG8_MMA(1, 0, At, B0); PG8_MMA(1, 1, At, B1); PG8_BAR; PG8_SCHED;
        }
        if constexpr (ALIGN_EPI) { if (wr == 0) PG8_BAR; }
        E(acc, cur, wr, wc, fr, fq);
        if (!has_next) break;
#pragma unroll
        for (int a = 0; a < 2; ++a)
#pragma unroll
            for (int b = 0; b < 2; ++b)
#pragma unroll
                for (int m = 0; m < 4; ++m)
#pragma unroll
                    for (int n = 0; n < 2; ++n) acc[a][b][m][n] = (f32x4){0.f, 0.f, 0.f, 0.f};
        cur = nxt; cA = nA; cB = nB; ++ui; if constexpr (KS < 1024) { cA2 = cur.A2; cB2 = cur.B2; }
#pragma unroll
        for (int h_ = 0; h_ < 2; ++h_)
#pragma unroll
            for (int i_ = 0; i_ < 2; ++i_) vA[h_][i_] = nvA[h_][i_];
        if constexpr (ALIGN_EPI) { if (wr == 1) PG8_BAR; }
    }
    PG8_WAIT_V(0);
    if constexpr (!ALIGN_EPI) { if (wr == 0) PG8_BAR; }
    PG8_BAR;
#undef PG8_SA
#undef PG8_SB
#undef PG8_STAGE
#undef PG8_LDA
#undef PG8_LDB
#undef PG8_MMA
#undef PG8_WAIT_V
#undef PG8_WAIT_L
#undef PG8_BAR
#undef PG8_SCHED
#undef PG8_AOFF
}
}
template <class Sched, class Epi> __device__ __forceinline__ void run_gemm(LAS unsigned char* lds, const GemmDims d, const Sched& S, const Epi& E) {
    pg8::EpiAdapt<Epi> EA{E};
    pg8::gemm_phase<pg8::EpiAdapt<Epi>, Sched, true, true>(lds, d, S, EA, (int)gridDim.x, (int)blockIdx.x);
}

constexpr int NWAVES = 8, NTHR = 512;
constexpr int LDS_BYTES = 163840;
constexpr int RING_BYTES = 131072;
constexpr int CW_GCNT = 9216;
constexpr int BIAS_OFF = 139264;
constexpr int RT_OFF = RING_BYTES + 4096;
static_assert(RT_OFF + 40 * RT_ROWB <= LDS_BYTES, "router table fits");
constexpr int TT_OFF = RING_BYTES + 1024;

struct Frame { LAS unsigned char* lds; int tid, lane, wave, vcu, G; };
#define LAUNDER(F) do { (F).tid = (int)threadIdx.x; (F).lane = (int)threadIdx.x & 63; asm volatile("" : "+v"((F).tid), "+v"((F).lane)); } while (0)

__device__ __forceinline__ void transpose_item(const float* W, int ldw, int k0, int scol0, bf16* WT, int ldd, int drow0, int dcol0, LAS float* scr, int lane, bf16* WT2 = nullptr, int dcol2 = 0, bf16* WT3 = nullptr, int dcol3 = 0, const float* ks = nullptr) {
    { f32x4 t[8];
#pragma unroll
        for (int i = 0; i < 8; ++i) t[i] = *(const f32x4*)(W + (size_t)(k0 + 8 * i + (lane >> 3)) * ldw + scol0 + (lane & 7) * 4);
        if (ks) { float sc[8];
#pragma unroll
            for (int i = 0; i < 8; ++i) sc[i] = ks[k0 + 8 * i + (lane >> 3)];
#pragma unroll
            for (int i = 0; i < 8; ++i) t[i] = t[i] * sc[i]; }
#pragma unroll
        for (int i = 0; i < 8; ++i) { LAS float* d = scr + (8 * i + (lane >> 3)) * 33 + (lane & 7) * 4; d[0] = t[i].x; d[1] = t[i].y; d[2] = t[i].z; d[3] = t[i].w; } }
    asm volatile("s_waitcnt lgkmcnt(0)" ::: "memory");
    const int c = lane & 7;
#pragma unroll
    for (int j = 0; j < 4; ++j) { const int n = (lane >> 3) + 8 * j; const LAS float* s = scr + (8 * c) * 33 + n;
        u32x4 o; o.x = pk2(s[0 * 33], s[1 * 33]); o.y = pk2(s[2 * 33], s[3 * 33]); o.z = pk2(s[4 * 33], s[5 * 33]); o.w = pk2(s[6 * 33], s[7 * 33]);
        *(u32x4*)(WT + (size_t)(drow0 + n) * ldd + dcol0 + k0 + 8 * c) = o;
        if (WT2) *(u32x4*)(WT2 + (size_t)(drow0 + n) * ldd + dcol2 + k0 + 8 * c) = o;
        if (WT3) *(u32x4*)(WT3 + (size_t)(drow0 + n) * ldd + dcol3 + k0 + 8 * c) = o; }
    asm volatile("s_waitcnt lgkmcnt(0)" ::: "memory");
}

__device__ __forceinline__ void p0_weights(const Frame& Fin_, const Params& P, const int part) {
    Frame F = Fin_; LAUNDER(F);
    LAS float* scr = (LAS float*)(F.lds + F.wave * 16384);
    unsigned char* ws = P.ws;
    constexpr int I_IN = 16 * 128, I_OA = 8 * 32, I_GLU = 8 * 16, I_OB = 8 * 32, I_O = 16 * 32, I_G = 16 * 16 * 8, I_U = I_G, I_D = 16 * 4 * 32;
    constexpr int NEARLY = I_IN + I_OA + I_GLU + I_OB + I_O, NITEMS = NEARLY + I_G + I_U + I_D;
    const int gw = part == 0 ? F.vcu * NWAVES + F.wave : ((int)blockIdx.x - 128) * NWAVES + F.wave, NGW = part == 0 ? F.G * NWAVES : (F.G - 128) * NWAVES;
    constexpr int SPLIT = I_IN;
    for (int it = (part == 0 ? 0 : SPLIT) + gw; it < (part == 0 ? SPLIT : NITEMS); it += NGW) {
        int r = it;
        if (r < I_IN) { const int kb = r / 128, nb = r % 128, n0 = nb * 32; transpose_item(P.in[2], WIN_LD, kb * 64, n0 + (n0 >= 1536 ? 8 : 0), (bf16*)(ws + WS_WIN), 1024, n0, 0, scr, F.lane); continue; } r -= I_IN;
        if (r < I_OA) { const int kb = r / 32, nb = r % 32; transpose_item(P.in[5], 1024, kb * 64, nb * 32, (bf16*)(ws + WS_WOA), 512, nb * 32, 0, scr, F.lane); continue; } r -= I_OA;
        if (r < I_GLU) { const int kb = r / 16, nb = r % 16; transpose_item(P.in[14], 512, kb * 64, nb * 32, (bf16*)(ws + WS_WGLU), 512, nb * 32, 0, scr, F.lane); continue; } r -= I_GLU;
        if (r < I_OB) { const int kb = r / 32, nb = r % 32; transpose_item(P.in[16], 1024, kb * 64, nb * 32, (bf16*)(ws + WS_WOB), 512, nb * 32, 0, scr, F.lane); continue; } r -= I_OB;
        if (r < I_O) { const int kb = r / 32, nb = r % 32; transpose_item(P.in[17], 1024, kb * 64, nb * 32, (bf16*)(ws + WS_WO), 1024, nb * 32, 0, scr, F.lane); continue; } r -= I_O;
        if (r < I_G + I_U) { const int isup = r >= I_G; if (isup) r -= I_G; const int e = r / 128, rr = r % 128, kb = rr / 8, nb = rr % 8, j0 = nb * 32;
            const float* W = (isup ? P.in[24] : P.in[23]) + (size_t)e * 1024 * 256;
            transpose_item(W, 256, kb * 64, j0, (bf16*)(ws + WS_WGU) + (size_t)e * 512 * 1024, 1024, (j0 >> 7) * 256 + isup * 128 + (j0 & 127), 0, scr, F.lane, nullptr, 0, nullptr, 0, P.in[18]); continue; } r -= I_G + I_U;
        { const int e = r / 128, r2 = r % 128, kb = r2 / 32, nb = r2 % 32; const int grp = e >> 2, j = e & 3;
            bf16* dst[3]; int dcol[3]; int nd = 0;
#pragma unroll
            for (int o = 0; o < 4; ++o) if (o != j) { const int a = o < j ? o : j, b = o < j ? j : o; dst[nd] = (bf16*)(ws + WS_WD) + (size_t)(grp * 6 + pair_idx(a, b)) * 1024 * 512; dcol[nd] = (j == a) ? 0 : 256; ++nd; }
            transpose_item(P.in[25] + (size_t)e * 256 * 1024, 1024, kb * 64, nb * 32, dst[0], 512, nb * 32, dcol[0], scr, F.lane, dst[1], dcol[1], dst[2], dcol[2]); }
    }
}

__device__ __forceinline__ void p0_stage_wf(const Frame& Fin_, const Params& P) {
    Frame F = Fin_; LAUNDER(F);
    LAS float* WfT = (LAS float*)F.lds; const float* win = P.in[2];
    for (int k = F.tid; k < DM; k += NTHR) { const float* wr = win + (size_t)k * WIN_LD + 1536; const f32x4 w0 = *(const f32x4*)wr, w1 = *(const f32x4*)(wr + 4);
        WfT[0 * DM + k] = w0.x; WfT[1 * DM + k] = w0.y; WfT[2 * DM + k] = w0.z; WfT[3 * DM + k] = w0.w; WfT[4 * DM + k] = w1.x; WfT[5 * DM + k] = w1.y; WfT[6 * DM + k] = w1.z; WfT[7 * DM + k] = w1.w; }
    __syncthreads();
}
__device__ __forceinline__ void p0_row2(const Frame& F, const Params& P, int m0, int m1, f32x4 (&v)[2][4]) {
    const float* gmix = P.in[1]; const float* bf = P.in[3];
    const LAS f32x4* WfT = (const LAS f32x4*)F.lds;
    float rs[2]; const int mm[2] = {m0, m1};
#pragma unroll
    for (int q = 0; q < 2; ++q) { float ss = 0.f;
#pragma unroll
        for (int j = 0; j < 4; ++j) ss += (v[q][j].x * v[q][j].x + v[q][j].y * v[q][j].y) + (v[q][j].z * v[q][j].z + v[q][j].w * v[q][j].w);
        rs[q] = 1.0f / sqrtf(wave_sum(ss) * (1.0f / DM) + EPS); }
    float f[2][8];
#pragma unroll
    for (int q = 0; q < 2; ++q)
#pragma unroll
        for (int h = 0; h < 8; ++h) f[q][h] = 0.f;
#pragma unroll
    for (int j = 0; j < 4; ++j) { const f32x4 g = ((const f32x4*)gmix)[F.lane + 64 * j];
#pragma unroll
        for (int q = 0; q < 2; ++q) { v[q][j] = v[q][j] * rs[q] * g; u32x2 w; w.x = pk2(v[q][j].x, v[q][j].y); w.y = pk2(v[q][j].z, v[q][j].w);
            ((u32x2*)((bf16*)(P.ws + WS_XN) + (size_t)mm[q] * DM) + F.lane)[64 * j] = w; }
#pragma unroll
        for (int h = 0; h < 8; ++h) { const f32x4 wv = WfT[h * (DM / 4) + 64 * j + F.lane];
#pragma unroll
            for (int q = 0; q < 2; ++q) f[q][h] += (v[q][j].x * wv.x + v[q][j].y * wv.y) + (v[q][j].z * wv.z + v[q][j].w * wv.w); } }
    const bool b5 = (F.lane & 32) != 0, b4 = (F.lane & 16) != 0, b3 = (F.lane & 8) != 0;
#pragma unroll
    for (int q = 0; q < 2; ++q) { float r4[4], r2[2], r1;
#pragma unroll
        for (int i = 0; i < 4; ++i) { const float keep = b5 ? f[q][i + 4] : f[q][i], send = b5 ? f[q][i] : f[q][i + 4]; r4[i] = keep + __shfl_xor(send, 32); }
#pragma unroll
        for (int i = 0; i < 2; ++i) { const float keep = b4 ? r4[i + 2] : r4[i], send = b4 ? r4[i] : r4[i + 2]; r2[i] = keep + __shfl_xor(send, 16); }
        { const float keep = b3 ? r2[1] : r2[0], send = b3 ? r2[0] : r2[1]; r1 = keep + __shfl_xor(send, 8); }
        r1 += __shfl_xor(r1, 4); r1 += __shfl_xor(r1, 2); r1 += __shfl_xor(r1, 1);
        if ((F.lane & 7) == 0) { const int h = (b5 ? 4 : 0) + (b4 ? 2 : 0) + (b3 ? 1 : 0); const float val = r1 + bf[h]; const float xe = __expf(-fabsf(val)); const float ls = fminf(val, 0.f) - (xe < 1e-3f ? xe * (1.0f - 0.5f * xe) : __logf(1.0f + xe));
            const int b = mm[q] / SEQ, s = mm[q] % SEQ; ((float*)(P.ws + WS_LF))[((size_t)b * NH + h) * SEQ + s] = ls * LOG2E; } }
}

__device__ __forceinline__ void p0_ssm_group(const Frame& Fin_, const Params& P, int g, int part) {
    Frame F = Fin_; LAUNDER(F);
    typedef float f32x2 __attribute__((ext_vector_type(2)));
    constexpr int CMS = 65;
    LAS f32x2* AP = (LAS f32x2*)(F.lds);
    LAS f32x2* CM = (LAS f32x2*)(F.lds + 33 * 64 * 8);
    LAS f32x2* BB = (LAS f32x2*)(F.lds + 33 * 64 * 8 + 16 * CMS * 8);
    LAS float* KT = (LAS float*)(F.lds + 33 * 64 * 8 + 16 * CMS * 8 + 8192);
    const float* lre = P.in[6]; const float* lim = P.in[7]; const float* lstep = P.in[8]; const float* bre = P.in[9]; const float* bim = P.in[10];
    const float* cre = P.in[11]; const float* cim = P.in[12]; const float* dsk = P.in[13];
    const float dtf = expf(lstep[g]);
    if (F.tid < 64) { const int p = F.tid; const double dt = (double)dtf, lr = (double)lre[g * 64 + p], li = (double)lim[g * 64 + p];
        const double mg = exp(lr * dt), ph = li * dt; const double a1r = mg * cos(ph), a1i = mg * sin(ph); double ar = 1.0, ai = 0.0;
        for (int d = 0; d <= LCH; ++d) { AP[d * 64 + p] = (f32x2){(float)ar, (float)ai}; const double nr = ar * a1r - ai * a1i, ni = ar * a1i + ai * a1r; ar = nr; ai = ni; } }
    for (int idx = F.tid; idx < 1024; idx += NTHR) { { const int o = idx >> 6, p = idx & 63; CM[o * CMS + p] = (f32x2){cre[(g * 16 + o) * 64 + p], cim[(g * 16 + o) * 64 + p]}; }
        { const int p = idx >> 4, c = idx & 15; const float lr = lre[g * 64 + p], li = lim[g * 64 + p];
          const float mag = expf(lr * dtf); float sn, cs; sincosf(li * dtf, &sn, &cs); const float are = mag * cs, aim = mag * sn, den = lr * lr + li * li, nre = are - 1.0f;
          const float zre = (nre * lr + aim * li) / den, zim = (aim * lr - nre * li) / den; const float br = bre[(g * 64 + p) * 16 + c], bi = bim[(g * 64 + p) * 16 + c];
          BB[idx] = (f32x2){zre * br - zim * bi, zre * bi + zim * br}; } }
    __syncthreads();
    { const int d = F.tid >> 4, o = F.tid & 15; float acc[16];
#pragma unroll
        for (int c = 0; c < 16; ++c) acc[c] = 0.f;
#pragma unroll 4
        for (int p = 0; p < 64; ++p) { const f32x2 a = AP[d * 64 + p], cm = CM[o * CMS + p]; const float car = cm.x * a.x - cm.y * a.y, cai = cm.x * a.y + cm.y * a.x;
#pragma unroll
            for (int c = 0; c < 16; ++c) { const f32x2 bb = BB[p * 16 + c]; acc[c] += car * bb.x - cai * bb.y; } }
        if (d == 0) acc[o] += dsk[g * 16 + o];
#pragma unroll
        for (int c = 0; c < 16; ++c) KT[(d * 16 + o) * 16 + c] = acc[c]; }
    __syncthreads();
    bf16* Mx = (bf16*)(P.ws + WS_MX) + (size_t)g * 512 * KY;
    for (int idx = F.tid; idx < 64 * 80; idx += NTHR) { const int n = part * 64 + idx / 80, k0 = (idx % 80) * 8, j = n >> 4, o = n & 15; float v[8];
        if (k0 < 512) { const int i = k0 >> 4, c0 = k0 & 15;
#pragma unroll
            for (int e = 0; e < 8; ++e) v[e] = (i <= j) ? KT[((j - i) * 16 + o) * 16 + c0 + e] : 0.f; }
        else { const int kk = k0 - 512, ri = kk >> 6, p0 = kk & 63;
#pragma unroll
            for (int e = 0; e < 8; ++e) { const f32x2 a = AP[(j + 1) * 64 + p0 + e], cm = CM[o * CMS + p0 + e]; v[e] = ri == 0 ? (cm.x * a.x - cm.y * a.y) : -(cm.x * a.y + cm.y * a.x); } }
        store8(Mx + (size_t)n * KY + k0, v); }
    bf16* Ws = (bf16*)(P.ws + WS_WS) + (size_t)g * 128 * 512;
    for (int idx = F.tid; idx < 16 * 64; idx += NTHR) { const int n = part * 16 + (idx >> 6), k0 = (idx & 63) * 8, ri = n >> 6, p = n & 63, i = k0 >> 4, c0 = k0 & 15; float v[8]; const f32x2 a = AP[(LCH - 1 - i) * 64 + p];
#pragma unroll
        for (int e = 0; e < 8; ++e) { const f32x2 bb = BB[p * 16 + c0 + e]; v[e] = ri == 0 ? (a.x * bb.x - a.y * bb.y) : (a.x * bb.y + a.y * bb.x); }
        store8(Ws + (size_t)n * 512 + k0, v); }
    if (part == 0 && F.tid < 64) { const f32x2 a = AP[LCH * 64 + F.tid]; float* AL = (float*)(P.ws + WS_AL) + (g * 64 + F.tid) * 2; AL[0] = a.x; AL[1] = a.y; }
    __syncthreads();
}

constexpr unsigned REP_PRO = 0u;
__device__ __forceinline__ void p0_prologue(const Frame& Fin_, const Params& P) {
    Frame F = Fin_; LAUNDER(F);
    for (int r_ = 0; r_ < 1 + (int)(REP_PRO & 1u); ++r_) p0_ssm_group(F, P, F.vcu >> 3, F.vcu & 7);
    for (int r_ = 0; r_ < 1 + (int)((REP_PRO >> 1) & 1u); ++r_) { p0_weights(F, P, 0); __syncthreads(); }
    p0_stage_wf(F, P);
    const int gw = F.vcu * NWAVES + F.wave, NGW = F.G * NWAVES;
    for (int r_ = 0; r_ < 1 + (int)((REP_PRO >> 2) & 1u); ++r_) {
        f32x4 nv[2][4];
#pragma unroll
        for (int q = 0; q < 2; ++q)
#pragma unroll
            for (int j = 0; j < 4; ++j) nv[q][j] = ((const f32x4*)(P.in[0] + (size_t)(gw + q * NGW) * DM) + F.lane)[64 * j];
        for (int m = gw; m < T; m += 2 * NGW) { f32x4 v[2][4];
#pragma unroll
            for (int q = 0; q < 2; ++q)
#pragma unroll
                for (int j = 0; j < 4; ++j) v[q][j] = nv[q][j];
            if (m + 2 * NGW < T) {
#pragma unroll
                for (int q = 0; q < 2; ++q)
#pragma unroll
                    for (int j = 0; j < 4; ++j) nv[q][j] = ((const f32x4*)(P.in[0] + (size_t)(m + (2 + q) * NGW) * DM) + F.lane)[64 * j]; }
            p0_row2(F, P, m, m + NGW, v); } }
}

__device__ __forceinline__ void p_cumsum(const Frame& Fin_, const Params& P) {
    Frame F = Fin_; LAUNDER(F);
    LAS float* part = (LAS float*)F.lds;
    for (int seq = (int)blockIdx.x - 128; seq < BATCH * NH; seq += 32) {
        const float* src = (const float*)(P.ws + WS_LF) + (size_t)seq * SEQ + F.tid * 16; float* dst = (float*)(P.ws + WS_CK2) + (size_t)seq * SEQ + F.tid * 16;
        float v[16]; float s = 0.f;
#pragma unroll
        for (int j = 0; j < 4; ++j) { const f32x4 t = ((const f32x4*)src)[j]; v[4 * j] = t.x; v[4 * j + 1] = t.y; v[4 * j + 2] = t.z; v[4 * j + 3] = t.w; }
#pragma unroll
        for (int j = 0; j < 16; ++j) { s += v[j]; v[j] = s; }
        __syncthreads();
        part[F.tid] = s; __syncthreads();
        if (F.tid == 0) { float run = 0.f; for (int i = 0; i < NTHR; ++i) { const float t = part[i]; part[i] = run; run += t; } }
        __syncthreads();
        const float base = part[F.tid];
#pragma unroll
        for (int j = 0; j < 4; ++j) ((f32x4*)dst)[j] = (f32x4){v[4 * j] + base, v[4 * j + 1] + base, v[4 * j + 2] + base, v[4 * j + 3] + base};
    }
}

constexpr int CARRY_WGS = BATCH * SG;
__device__ __forceinline__ void p_carry(const Frame& Fin_, const Params& P) {
    Frame F = Fin_; LAUNDER(F);
    const int cb = (int)blockIdx.x; if (cb >= CARRY_WGS) return;
    typedef float f32x2 __attribute__((ext_vector_type(2)));
    const int b = cb & 3, g = cb >> 2, p = F.lane, seg = F.wave;
    const float* AL = (const float*)(P.ws + WS_AL) + (g * 64 + p) * 2; const float ar = AL[0], ai = AL[1];
    const float* S = (const float*)(P.ws + WS_S) + ((size_t)g * NCH + b * NCHB + seg * 32) * 128 + p;
    bf16* UH = (bf16*)(P.ws + WS_UH) + ((size_t)g * NCH + b * NCHB + seg * 32) * KY + 512 + p;
    float sr[32], si[32];
#pragma unroll
    for (int n = 0; n < 32; ++n) { sr[n] = S[(size_t)n * 128]; si[n] = S[(size_t)n * 128 + 64]; }
    float a32r = ar, a32i = ai;
#pragma unroll
    for (int k = 0; k < 5; ++k) { const float nr = a32r * a32r - a32i * a32i, ni = 2.0f * a32r * a32i; a32r = nr; a32i = ni; }
    float er = 0.f, ei = 0.f;
#pragma unroll
    for (int n = 0; n < 32; ++n) { const float nr = ar * er - ai * ei + sr[n], ni = ar * ei + ai * er + si[n]; er = nr; ei = ni; }
    LAS f32x2* EX = (LAS f32x2*)F.lds;
    EX[seg * 64 + p] = (f32x2){er, ei};
    __syncthreads();
    float hr = 0.f, hi = 0.f;
    for (int s = 0; s < seg; ++s) { const f32x2 e = EX[s * 64 + p]; const float nr = a32r * hr - a32i * hi + e.x, ni = a32r * hi + a32i * hr + e.y; hr = nr; hi = ni; }
#pragma unroll
    for (int n = 0; n < 32; ++n) { UH[(size_t)n * KY] = (bf16)f2bf(hr); UH[(size_t)n * KY + 64] = (bf16)f2bf(hi);
        const float nr = ar * hr - ai * hi + sr[n], ni = ar * hi + ai * hr + si[n]; hr = nr; hi = ni; }
    __syncthreads();
}

__device__ __forceinline__ void p_router(const Frame& Fin_, const Params& P, const bool publish = true) {
    Frame F = Fin_; LAUNDER(F);
    const float* brg = P.in[20]; const float* bre_ = P.in[22];
    LAS f32x4* LOG = (LAS f32x4*)F.lds;
    LAS int* hist = (LAS int*)(F.lds + 4 * 128 * 96);
    LAS int* tcl = hist + 64;
    LAS int* tlr = tcl + 128;
    LAS float* twa = (LAS float*)(tlr + 128);
    if (F.tid < NCLS) hist[F.tid] = 0;
    const int tok0 = F.vcu * (T / 256);
    { const int t = F.tid & 127, qt = F.tid >> 7;
      const f32x4* pp = (const f32x4*)(P.ws + WS_PART) + ((size_t)(qt * 4 * 6) * T + tok0 + t);
      f32x4 v[4][6];
#pragma unroll
      for (int q = 0; q < 4; ++q)
#pragma unroll
          for (int j = 0; j < 6; ++j) v[q][j] = pp[(size_t)(q * 6 + j) * T];
#pragma unroll
      for (int j = 0; j < 6; ++j) LOG[(qt * 128 + t) * 6 + j] = (v[0][j] + v[1][j]) + (v[2][j] + v[3][j]); }
    __syncthreads();
    if (F.tid < T / 256) { const int t = F.tid;
        float lgt[24];
#pragma unroll
        for (int j = 0; j < 6; ++j) { const f32x4 a = (LOG[t * 6 + j] + LOG[(128 + t) * 6 + j]) + (LOG[(256 + t) * 6 + j] + LOG[(384 + t) * 6 + j]); lgt[4 * j] = a.x; lgt[4 * j + 1] = a.y; lgt[4 * j + 2] = a.z; lgt[4 * j + 3] = a.w; }
        const float rs = 1.0f / sqrtf(lgt[20] * (1.0f / DM) + EPS);
#pragma unroll
        for (int e = 0; e < 20; ++e) lgt[e] *= rs;
        const float l0 = lgt[0] + brg[0], l1 = lgt[1] + brg[1], l2 = lgt[2] + brg[2], l3 = lgt[3] + brg[3];
        int gi = 0; float mx = l0; if (l1 > mx) { mx = l1; gi = 1; } if (l2 > mx) { mx = l2; gi = 2; } if (l3 > mx) { mx = l3; gi = 3; }
        const float psel = 1.0f / (expf(l0 - mx) + expf(l1 - mx) + expf(l2 - mx) + expf(l3 - mx));
        float le[4];
#pragma unroll
        for (int k = 0; k < 4; ++k) { const float c0 = lgt[4 + k] + bre_[k], c1 = lgt[8 + k] + bre_[4 + k], c2 = lgt[12 + k] + bre_[8 + k], c3 = lgt[16 + k] + bre_[12 + k]; le[k] = gi == 0 ? c0 : (gi == 1 ? c1 : (gi == 2 ? c2 : c3)); }
        int i0 = 0; float v0 = le[0]; if (le[1] > v0) { v0 = le[1]; i0 = 1; } if (le[2] > v0) { v0 = le[2]; i0 = 2; } if (le[3] > v0) { v0 = le[3]; i0 = 3; }
        int i1 = -1; float v1 = -INFINITY;
#pragma unroll
        for (int k = 0; k < 4; ++k) if (k != i0 && le[k] > v1) { v1 = le[k]; i1 = k; }
        const float e1 = expf(v1 - v0), w0 = psel / (1.0f + e1), w1 = psel * e1 / (1.0f + e1);
        const int a = i0 < i1 ? i0 : i1, bb = i0 < i1 ? i1 : i0; const float wa = i0 < i1 ? w0 : w1, wb = i0 < i1 ? w1 : w0;
        const int cls = gi * 6 + pair_idx(a, bb);
        tcl[t] = cls; twa[4 * t] = wa; twa[4 * t + 1] = wb; twa[4 * t + 2] = rs; tlr[t] = atomicAdd((int*)&hist[cls], 1); }
    __syncthreads();
    if (!publish) return;
    if (F.tid < NCLS) hist[32 + F.tid] = (int)__hip_atomic_fetch_add((unsigned*)(P.ws + WS_CTL) + CW_GCNT + F.tid, (unsigned)hist[F.tid], __ATOMIC_RELAXED, __HIP_MEMORY_SCOPE_AGENT);
    __syncthreads();
    if (F.tid < T / 256) { const int cls = tcl[F.tid], pos = hist[32 + cls] + tlr[F.tid]; const size_t li = (size_t)cls * T + pos;
        ((int*)(P.ws + WS_LIST))[li] = tok0 + F.tid; ((int*)(P.ws + WS_TPOS))[tok0 + F.tid] = (cls << 16) | pos; *((f32x4*)(P.ws + WS_LPW) + li) = (f32x4){twa[4 * F.tid], twa[4 * F.tid + 1], twa[4 * F.tid + 2], 0.f}; }
    __syncthreads();
}

__device__ __forceinline__ void stage_router_table(const Frame& Fin_, const Params& P, const int pn) {
    Frame F = Fin_; LAUNDER(F);
    const float* gffn = P.in[18]; const float* wrg = P.in[19]; const float* wre = P.in[21];
    LAS unsigned char* TH = F.lds + RT_OFF; LAS unsigned char* TL = TH + 20 * RT_ROWB;
    for (int idx = F.tid; idx < 20 * 256; idx += NTHR) { const int n = idx >> 8, kc = idx & 255, k = pn * 256 + kc; const float w = (n < 4 ? wrg[(size_t)k * 4 + n] : wre[(size_t)k * 16 + (n - 4)]) * gffn[k];
        const unsigned h = f2bf(w); const unsigned l = f2bf(w - bf2f(h)); *(LAS bf16*)(TH + n * RT_ROWB + kc * 2) = (bf16)h; *(LAS bf16*)(TL + n * RT_ROWB + kc * 2) = (bf16)l; }
    __syncthreads();
}

__device__ __forceinline__ void moe_tile_table(const Frame& Fin_, const Params& P) {
    Frame F = Fin_; LAUNDER(F);
    LAS int* tt = (LAS int*)(F.lds + TT_OFF);
    if (F.tid < NCLS) tt[512 + F.tid] = (int)__hip_atomic_load((unsigned*)(P.ws + WS_CTL) + CW_GCNT + F.tid, __ATOMIC_RELAXED, __HIP_MEMORY_SCOPE_AGENT);
    __syncthreads();
    if (F.tid < MAXTILES) { int base = 0, cls = -1, tic = 0;
        for (int c = 0; c < NCLS; ++c) { const int nt = (tt[512 + c] + 255) >> 8; if (F.tid == 0) tt[544 + c] = base; if (cls < 0 && F.tid < base + nt) { cls = c; tic = F.tid - base; } base += nt; }
        if (F.tid == 0) tt[568] = base;
        tt[2 * F.tid] = cls; tt[2 * F.tid + 1] = tic; }
    __syncthreads();
}


__device__ __forceinline__ void p_final(const Frame& Fin_, const Params& P) {
    Frame F = Fin_; LAUNDER(F);
    const float* gf = P.in[26]; const bf16* Y = (const bf16*)(P.ws + WS_Y); const bf16* X1B = (const bf16*)(P.ws + WS_H2); const int* TPOS = (const int*)(P.ws + WS_TPOS); const LAS int* tt = (const LAS int*)(F.lds + TT_OFF);
    const int gw = F.vcu * NWAVES + F.wave, NGW = F.G * NWAVES;
    u32x2 nx[4], ny[4]; int tp1 = TPOS[gw], tp2 = (gw + NGW < T) ? TPOS[gw + NGW] : 0;
    { const size_t yr = (size_t)tt[544 + (tp1 >> 16)] * 256 + (tp1 & 0xffff);
#pragma unroll
      for (int j = 0; j < 4; ++j) { nx[j] = ((const u32x2*)(X1B + (size_t)gw * DM) + F.lane)[64 * j]; ny[j] = ((const u32x2*)(Y + yr * DM) + F.lane)[64 * j]; } }
    for (int m = gw; m < T; m += NGW) { f32x4* xr = (f32x4*)(P.out + (size_t)m * DM) + F.lane; f32x4 v[4]; float ss = 0.f;
#pragma unroll
        for (int j = 0; j < 4; ++j) { const u32x2 x = nx[j], y = ny[j]; v[j] = (f32x4){bf2f(x.x & 0xffffu), bf2f(x.x >> 16), bf2f(x.y & 0xffffu), bf2f(x.y >> 16)} + (f32x4){bf2f(y.x & 0xffffu), bf2f(y.x >> 16), bf2f(y.y & 0xffffu), bf2f(y.y >> 16)};
            ss += (v[j].x * v[j].x + v[j].y * v[j].y) + (v[j].z * v[j].z + v[j].w * v[j].w); }
        tp1 = tp2; if (m + 2 * NGW < T) tp2 = TPOS[m + 2 * NGW];
        if (m + NGW < T) { const size_t yr = (size_t)tt[544 + (tp1 >> 16)] * 256 + (tp1 & 0xffff);
#pragma unroll
            for (int j = 0; j < 4; ++j) { nx[j] = ((const u32x2*)(X1B + (size_t)(m + NGW) * DM) + F.lane)[64 * j]; ny[j] = ((const u32x2*)(Y + yr * DM) + F.lane)[64 * j]; } }
        const float rs = 1.0f / sqrtf(wave_sum(ss) * (1.0f / DM) + EPS);
#pragma unroll
        for (int j = 0; j < 4; ++j) { const f32x4 g = ((const f32x4*)gf)[F.lane + 64 * j]; xr[64 * j] = v[j] * rs * g; } }
}

namespace fox {
using bf16x8=__attribute__((ext_vector_type(8)))short;
using s16x4=__attribute__((ext_vector_type(4)))short;
using f32x16=__attribute__((ext_vector_type(16)))float;
using u32x4_=__attribute__((ext_vector_type(4)))unsigned;
using f32x4_=__attribute__((ext_vector_type(4)))float;
constexpr int D=64,DMP=512;
constexpr int NW=8,QBLK=32,QB=QBLK*NW,KVBLK=64;
__device__ __forceinline__ int crow(int r,int hi){return (r&3)+8*(r>>2)+4*hi;}
#define SBAR() __builtin_amdgcn_sched_barrier(0)
__device__ __forceinline__ void cmask(f32x16&p0,f32x16&p1,int jb,int qrel,int hi){
  const float NEG=-INFINITY; int d=qrel-64*jb-4*hi; asm volatile("":"+v"(d));
  #pragma unroll
  for(int r=0;r<16;++r){const int c=(r&3)+8*(r>>2); if(c>d)p0[r]=NEG; if(c+32>d)p1[r]=NEG;}
}
constexpr int NSLOT=3, SLOTB=8192;
constexpr int LDS_K=0, LDS_V=NSLOT*SLOTB, LDS_WS=2*NSLOT*SLOTB, LDS_OST=LDS_WS+NW*64*4, LDS_CK=LDS_OST+NW*4096, LDS_BYTES=LDS_CK+32768;
constexpr float PRUNE_X=40.0f;
__device__ __forceinline__ void glds16(const void*sbase,unsigned voff,unsigned lds_dst){unsigned keep;
  asm volatile("s_mov_b32 %0, m0\n\ts_mov_b32 m0, %3\n\ts_nop 0\n\tglobal_load_lds_dwordx4 %1, %2\n\ts_mov_b32 m0, %0":"=&s"(keep):"v"(voff),"s"(sbase),"s"(lds_dst):"memory");}
__device__ __forceinline__ float max3f(float a,float b,float c){float r;asm("v_max3_f32 %0, %1, %2, %3":"=v"(r):"v"(a),"v"(b),"v"(c));return r;}
__device__ __forceinline__ float max2f(float a,float b){float r;asm("v_max_f32_e32 %0, %1, %2":"=v"(r):"v"(a),"v"(b));return r;}
__device__ __forceinline__ float fadd_s(float a,float b){float r;asm("v_add_f32_e32 %0, %1, %2":"=v"(r):"v"(a),"v"(b));return r;}
__device__ __forceinline__ float fsub_s(float a,float b){float r;asm("v_sub_f32_e32 %0, %1, %2":"=v"(r):"v"(a),"v"(b));return r;}
typedef float f32x2_t __attribute__((ext_vector_type(2))); typedef __bf16 bf16x2_t __attribute__((ext_vector_type(2)));
__device__ __forceinline__ unsigned cvtpk_s(float lo,float hi){f32x2_t v={lo,hi};bf16x2_t b=__builtin_convertvector(v,bf16x2_t);return __builtin_bit_cast(unsigned,b);}
#define WAIT_BAR(N) asm volatile("s_waitcnt vmcnt(" #N ") lgkmcnt(0)\n\ts_barrier":::"memory")
typedef __attribute__((address_space(3))) const char* lds_cptr;
typedef short v4i16_t __attribute__((ext_vector_type(4)));
__device__ __forceinline__ void cinit(f32x16&p0,f32x16&p1,lds_cptr ckp,float nb){
  #pragma unroll
  for(int g=0;g<4;++g){ const f32x4_ a=*(const __attribute__((address_space(3))) f32x4_*)(ckp+g*32); const f32x4_ c=*(const __attribute__((address_space(3))) f32x4_*)(ckp+128+g*32);
    #pragma unroll
    for(int e=0;e<4;++e){p0[4*g+e]=nb-a[e];p1[4*g+e]=nb-c[e];} }
}
__device__ __forceinline__ void qkt(f32x16&p0,f32x16&p1,const char*Kslot,const bf16x8*qr,int r32,int hi){
  const char*kb=Kslot+hi*1024+r32*16;
  #pragma unroll
  for(int d0=0;d0<4;++d0){
    const bf16x8 b0=*reinterpret_cast<const bf16x8*>(kb+d0*2048);
    const bf16x8 b1=*reinterpret_cast<const bf16x8*>(kb+d0*2048+512);
    p0=__builtin_amdgcn_mfma_f32_32x32x16_bf16(b0,qr[d0],p0,0,0,0);p1=__builtin_amdgcn_mfma_f32_32x32x16_bf16(b1,qr[d0],p1,0,0,0);}
}
__device__ __forceinline__ void kload8(bf16x8*kf,lds_cptr kp){
  kf[0]=*(const __attribute__((address_space(3))) bf16x8*)(kp);      kf[1]=*(const __attribute__((address_space(3))) bf16x8*)(kp+512);
  kf[2]=*(const __attribute__((address_space(3))) bf16x8*)(kp+2048); kf[3]=*(const __attribute__((address_space(3))) bf16x8*)(kp+2560);
  kf[4]=*(const __attribute__((address_space(3))) bf16x8*)(kp+4096); kf[5]=*(const __attribute__((address_space(3))) bf16x8*)(kp+4608);
  kf[6]=*(const __attribute__((address_space(3))) bf16x8*)(kp+6144); kf[7]=*(const __attribute__((address_space(3))) bf16x8*)(kp+6656);
}
__device__ __forceinline__ void kload2(bf16x8*kf,lds_cptr kp,int j){ kf[2*j]=*(const __attribute__((address_space(3))) bf16x8*)(kp+j*2048); kf[2*j+1]=*(const __attribute__((address_space(3))) bf16x8*)(kp+j*2048+512); }
__device__ __forceinline__ s16x4 vtr(lds_cptr p){ return __builtin_bit_cast(s16x4,__builtin_amdgcn_ds_read_tr16_b64_v4i16((__attribute__((address_space(3))) v4i16_t*)p)); }
__device__ __forceinline__ float rowmax(const f32x16&p0,const f32x16&p1){
  float a=max3f(p0[0],p0[1],p1[0]),b=max3f(p0[2],p0[3],p1[1]);a=max3f(a,p1[2],p1[3]);
  #pragma unroll
  for(int r=4;r<16;r+=4){a=max3f(a,p0[r],p0[r+1]);b=max3f(b,p0[r+2],p0[r+3]);a=max3f(a,p1[r],p1[r+1]);b=max3f(b,p1[r+2],p1[r+3]);}
  const float m=max2f(a,b);
  auto rr=__builtin_amdgcn_permlane32_swap(__float_as_uint(m),__float_as_uint(m),false,false);
  return max2f(__uint_as_float(rr[0]),__uint_as_float(rr[1]));
}
__device__ __forceinline__ void pv(f32x16*o,int vb,bf16x8 pa0,bf16x8 pa1,bf16x8 pa2,bf16x8 pa3){
  #pragma unroll
  for(int d0=0;d0<2;++d0){s16x4 lo[4],hi[4];
    #pragma unroll
    for(int ks=0;ks<4;++ks){
      asm volatile("ds_read_b64_tr_b16 %0,%1 offset:%c2":"=&v"(lo[ks]):"v"(vb),"i"(d0*4096+ks*1024):"memory");
      asm volatile("ds_read_b64_tr_b16 %0,%1 offset:%c2":"=&v"(hi[ks]):"v"(vb),"i"(d0*4096+ks*1024+512):"memory");}
    asm volatile("s_waitcnt lgkmcnt(0)":::"memory");SBAR();
    #define PK(k) (bf16x8){lo[k][0],lo[k][1],lo[k][2],lo[k][3],hi[k][0],hi[k][1],hi[k][2],hi[k][3]}
    o[d0]=__builtin_amdgcn_mfma_f32_32x32x16_bf16(pa0,PK(0),o[d0],0,0,0);
    o[d0]=__builtin_amdgcn_mfma_f32_32x32x16_bf16(pa1,PK(1),o[d0],0,0,0);
    o[d0]=__builtin_amdgcn_mfma_f32_32x32x16_bf16(pa2,PK(2),o[d0],0,0,0);
    o[d0]=__builtin_amdgcn_mfma_f32_32x32x16_bf16(pa3,PK(3),o[d0],0,0,0);
    #undef PK
  }
}
struct Tensors { const bf16* Q; const bf16* K; const bf16* V; bf16* O; const float* CK2; const float* QN; const float* KN; };

template<int THRL> __device__ __forceinline__ void attn_unit(int b,int h,int qb,const Tensors&TT,char*shm){
  const bf16*Q=TT.Q; const bf16*__restrict__ K=TT.K; const bf16*__restrict__ V=TT.V; bf16*O=TT.O;
  int tid=threadIdx.x; asm volatile("":"+v"(tid));
  const int lane=tid&63,r32=lane&31,hi=lane>>5; const int wid=__builtin_amdgcn_readfirstlane(tid>>6);
  const long rowbase=(long)b*SEQ; const int q0=qb*QB; const int bh=b*NH+h;
  const float*ck=TT.CK2+(size_t)bh*SEQ;
  const int NTF=(q0+QB)/KVBLK;
  const bf16*Qw=Q+(rowbase+q0+wid*QBLK)*DMP+h*D;
  const bf16*Kh=K+rowbase*DMP+h*D,*Vh=V+rowbase*DMP+h*D;
  const unsigned lds0=(unsigned)(uintptr_t)shm;
  const unsigned koff=(unsigned)(lane*DMP+wid*8)*2u;
  const unsigned voff=(unsigned)((16*(wid&3)+(lane>>2))*DMP+(wid>>2)*32+(lane&3)*8)*2u;
  const unsigned kdst=lds0+LDS_K+wid*1024, vdst=lds0+LDS_V+wid*1024;
  #define TJ(t) (NTF-1-(t))
  #define DMA_K(t,slot) glds16(Kh+(long)TJ(t)*KVBLK*DMP,koff,(unsigned)__builtin_amdgcn_readfirstlane(kdst+(slot)))
  #define DMA_V(t,slot) glds16(Vh+(long)TJ(t)*KVBLK*DMP,voff,(unsigned)__builtin_amdgcn_readfirstlane(vdst+(slot)))
  DMA_K(0,0);DMA_V(0,0);DMA_K(1,SLOTB);DMA_K(2,2*SLOTB);
  float Bq; int jmin;
  { float qn=(lane<4)?TT.QN[bh*128+4*qb+lane]:0.f; float kn=0.f; if(lane<NTF)kn=TT.KN[bh*128+lane]; if(lane+64<NTF)kn=fmaxf(kn,TT.KN[bh*128+64+lane]);
    const float cq0=ck[q0]; const float c0=(lane<NTF)?ck[64*lane+63]:0.f, c1=(lane+64<NTF)?ck[64*(lane+64)+63]:0.f;
    #pragma unroll
    for(int o_=1;o_<64;o_<<=1){qn=fmaxf(qn,__shfl_xor(qn,o_));kn=fmaxf(kn,__shfl_xor(kn,o_));}
    Bq=sqrtf(qn*kn)*1.001f+1e-3f;
    const float lim=2.0f*Bq+PRUNE_X;
    const bool n0=(lane>=NTF)||((c0-cq0)<=lim), n1=(lane+64>=NTF)||((c1-cq0)<=lim);
    const unsigned long long m0=__ballot(n0), m1=__ballot(n1);
    jmin=m0?(int)__builtin_ctzll(m0):(64+(m1?(int)__builtin_ctzll(m1):63));
    jmin=__builtin_amdgcn_readfirstlane(jmin)&~1; if(jmin>NTF-4)jmin=NTF-4; }
  const int NT=NTF-jmin;
  float*wsf=(float*)(shm+LDS_WS)+wid*64;
  const int vb0=(int)(lds0+LDS_V)+((lane>>4)&1)*32+(lane&3)*8+(4*hi+((lane&15)>>2))*64;
  const char*Kbase=shm+LDS_K; bf16x8 kf[8];
  const lds_cptr shm3=(lds_cptr)shm; const lds_cptr kp0=shm3+LDS_K+hi*1024+r32*16; const lds_cptr vp0=shm3+LDS_V+((lane>>4)&1)*32+(lane&3)*8+(4*hi+((lane&15)>>2))*64;
  const lds_cptr ckp0=shm3+LDS_CK+hi*16;
  #define CKP(t) (ckp0+(t)*256)
  bf16x8 qr[4];
  #pragma unroll
  for(int d0=0;d0<4;++d0)qr[d0]=*reinterpret_cast<const bf16x8*>(&Qw[(long)r32*DMP+d0*16+hi*8]);
  const float cq=ck[q0+wid*QBLK+r32];
  { const int n4=NT*16; const f32x4_*src=(const f32x4_*)ck; __attribute__((address_space(3))) f32x4_*dst=(__attribute__((address_space(3))) f32x4_*)(shm3+LDS_CK);
    for(int i=tid;i<n4;i+=NW*64)dst[i]=src[(NTF-1-(i>>4))*16+(i&15)]; }
  float mhat=0.f,l_reg=0.f;f32x16 o[2];o[0]=f32x16{};o[1]=f32x16{};
  const int qrel=wid*QBLK+r32;
  #define CMASK(P0,P1,t) do{int jb_=3-(t); if(jb_>=0)cmask(P0,P1,jb_,qrel,hi);}while(0)
  bool resc=false;
  #define START(P0,P1) do{ const float rm=fmaxf(rowmax(P0,P1),-Bq); resc=false; \
    { const float dl=rm; mhat=fadd_s(mhat,dl); \
      _Pragma("unroll") for(int r=0;r<16;++r){P0[r]=fsub_s(P0[r],dl);P1[r]=fsub_s(P1[r],dl);} } \
    _Pragma("unroll") for(int r=0;r<16;++r)P0[r]=__builtin_amdgcn_exp2f(P0[r]); }while(0)
  #define RESC() do{ if(resc){ asm volatile("s_waitcnt lgkmcnt(0)":::"memory"); \
      _Pragma("unroll") for(int d_=0;d_<2;++d_) _Pragma("unroll") for(int r=0;r<16;++r)o[d_][r]*=wsf[crow(r,hi)]; } }while(0)
  f32x16 pA0,pA1,pB0,pB1;
  int sl_prev=0,sl_cur=0,sl_next=SLOTB;
  #define ROT() do{sl_prev=sl_cur;sl_cur=sl_next;sl_next=(sl_next==(NSLOT-1)*SLOTB)?0:sl_next+SLOTB;}while(0)
  WAIT_BAR(0);
  asm volatile("":::"memory");
  cinit(pA0,pA1,CKP(0),cq);
  qkt(pA0,pA1,Kbase,qr,r32,hi);asm volatile("s_nop 15\n\ts_nop 7":"+v"(pA0),"+v"(pA1));CMASK(pA0,pA1,0);
  START(pA0,pA1);
  _Pragma("unroll") for(int r=0;r<16;++r)pA1[r]=__builtin_amdgcn_exp2f(pA1[r]);
  WAIT_BAR(0);
  DMA_K(3,0);DMA_V(1,SLOTB);
  ROT();
  kload8(kf,kp0+sl_cur);
  WAIT_BAR(2);
  s16x4 vlo[8],vhi[8]; u32x4_ pw0,pw1,pw2,pw3;
  #define PKW(P,B) cvtpk_s(P[B],P[B+1])
  #define PAF(k) __builtin_bit_cast(bf16x8,pw##k)
  #define VFR(i) (bf16x8){vlo[i][0],vlo[i][1],vlo[i][2],vlo[i][3],vhi[i][0],vhi[i][1],vhi[i][2],vhi[i][3]}
  #define PIN(x) asm volatile("":"+v"(x))
  #define MX3(a,b,c) __builtin_fmaxf(__builtin_fmaxf((a),(b)),(c))
  #define GAPA(MF,A0,A1,A2,A3,W0,W1,PW) do{ MF; sacc+=A0; sacc+=A1; sacc+=A2; sacc+=A3; PIN(sacc); W0; W1; PIN(PW); SBAR(); }while(0)
  #define EX(v) __builtin_amdgcn_exp2f(v)
  #define GAPB(MF,X,B) do{ MF; X[B]=EX(X[B]); X[B+1]=EX(X[B+1]); X[B+2]=EX(X[B+2]); X[B+3]=EX(X[B+3]); PIN(X); SBAR(); }while(0)
  #define VRD(i) do{ vlo[i]=vtr(vp_+(((i)>>2)*4096+((i)&3)*1024)); vhi[i]=vtr(vp_+(((i)>>2)*4096+((i)&3)*1024+512)); }while(0)
  #define KRD(G,j) do{ if(G){ kload2(kf,kp0+sl_next,j); SBAR(); } }while(0)
  #define STEP(C0,C1,P0,P1,t,GK,GV,GL) do{ SBAR(); \
    const lds_cptr vp_=vp0+sl_prev; \
    cinit(C0,C1,CKP(t),cq-mhat); SBAR(); \
    VRD(0); SBAR(); float sacc=(P0[0]+P0[1]); \
    GAPA(C0=__builtin_amdgcn_mfma_f32_32x32x16_bf16(kf[0],qr[0],C0,0,0,0), P0[2],P0[3],P0[4],P0[5],     pw0[0]=PKW(P0,0), pw0[1]=PKW(P0,2), pw0); \
    VRD(4); SBAR(); GAPA(C1=__builtin_amdgcn_mfma_f32_32x32x16_bf16(kf[1],qr[0],C1,0,0,0), P0[6],P0[7],P0[8],P0[9],     pw0[2]=PKW(P0,4), pw0[3]=PKW(P0,6), pw0); \
    VRD(1); SBAR(); GAPA(C0=__builtin_amdgcn_mfma_f32_32x32x16_bf16(kf[2],qr[1],C0,0,0,0),   P0[10],P0[11],P0[12],P0[13], pw1[0]=PKW(P0,8), pw1[1]=PKW(P0,10), pw1); \
    VRD(5); SBAR(); GAPA(C1=__builtin_amdgcn_mfma_f32_32x32x16_bf16(kf[3],qr[1],C1,0,0,0),   P0[14],P0[15],P1[0],P1[1],   pw1[2]=PKW(P0,12),pw1[3]=PKW(P0,14), pw1); \
    VRD(2); SBAR(); GAPA(C0=__builtin_amdgcn_mfma_f32_32x32x16_bf16(kf[4],qr[2],C0,0,0,0),   P1[2],P1[3],P1[4],P1[5],     pw2[0]=PKW(P1,0), pw2[1]=PKW(P1,2), pw2); \
    VRD(6); SBAR(); GAPA(C1=__builtin_amdgcn_mfma_f32_32x32x16_bf16(kf[5],qr[2],C1,0,0,0),   P1[6],P1[7],P1[8],P1[9],     pw2[2]=PKW(P1,4), pw2[3]=PKW(P1,6), pw2); \
    VRD(3); SBAR(); GAPA(C0=__builtin_amdgcn_mfma_f32_32x32x16_bf16(kf[6],qr[3],C0,0,0,0),   P1[10],P1[11],P1[12],P1[13], pw3[0]=PKW(P1,8), pw3[1]=PKW(P1,10), pw3); \
    VRD(7); SBAR(); GAPA(C1=__builtin_amdgcn_mfma_f32_32x32x16_bf16(kf[7],qr[3],C1,0,0,0),   P1[14],P1[15],0.f,0.f,       pw3[2]=PKW(P1,12),pw3[3]=PKW(P1,14), pw3); \
    l_reg+=sacc; \
    if(GK){DMA_K((t)+3,sl_cur);} if(GV){DMA_V((t)+1,sl_next);} \
    CMASK(C0,C1,t); \
    { float a=MX3(C0[0],C0[1],C1[0]),b=MX3(C0[2],C0[3],C1[1]); a=MX3(a,C1[2],C1[3]); \
      _Pragma("unroll") for(int r=4;r<16;r+=4){a=MX3(a,C0[r],C0[r+1]);b=MX3(b,C0[r+2],C0[r+3]);a=MX3(a,C1[r],C1[r+1]);b=MX3(b,C1[r+2],C1[r+3]);} \
      float rm=__builtin_fmaxf(a,b); { auto rr=__builtin_amdgcn_permlane32_swap(__float_as_uint(rm),__float_as_uint(rm),false,false); rm=__builtin_fmaxf(__uint_as_float(rr[0]),__uint_as_float(rr[1])); } \
      resc=false; \
      if(__builtin_expect(__any(rm>(float)THRL),0)){ const float dl=__builtin_fmaxf(rm,0.f); mhat+=dl; \
        _Pragma("unroll") for(int r=0;r<16;++r){C0[r]-=dl;C1[r]-=dl;} \
        const float f=__builtin_amdgcn_exp2f(-dl); l_reg*=f; if(hi==0)wsf[r32]=f; resc=true; } } \
    SBAR(); \
    GAPB(o[0]=__builtin_amdgcn_mfma_f32_32x32x16_bf16(PAF(0),VFR(0),o[0],0,0,0), C0,0); \
    GAPB(o[1]=__builtin_amdgcn_mfma_f32_32x32x16_bf16(PAF(0),VFR(4),o[1],0,0,0), C0,4); \
    KRD(GL,0); GAPB(o[0]=__builtin_amdgcn_mfma_f32_32x32x16_bf16(PAF(1),VFR(1),o[0],0,0,0), C0,8); \
    KRD(GL,1); GAPB(o[1]=__builtin_amdgcn_mfma_f32_32x32x16_bf16(PAF(1),VFR(5),o[1],0,0,0), C0,12); \
    KRD(GL,2); GAPB(o[0]=__builtin_amdgcn_mfma_f32_32x32x16_bf16(PAF(2),VFR(2),o[0],0,0,0), C1,0); \
    KRD(GL,3); GAPB(o[1]=__builtin_amdgcn_mfma_f32_32x32x16_bf16(PAF(2),VFR(6),o[1],0,0,0), C1,4); \
    GAPB(o[0]=__builtin_amdgcn_mfma_f32_32x32x16_bf16(PAF(3),VFR(3),o[0],0,0,0), C1,8); \
    GAPB(o[1]=__builtin_amdgcn_mfma_f32_32x32x16_bf16(PAF(3),VFR(7),o[1],0,0,0), C1,12); \
    }while(0)
  #define ENDW(tt) do{ if((tt)+3<NT){WAIT_BAR(2);} else if((tt)+2<NT){WAIT_BAR(1);} else {WAIT_BAR(0);} }while(0)
  int t=1;
  for(;t+1<NT&&t<5;t+=2){
    STEP(pB0,pB1,pA0,pA1,t,(t+3<NT),(t+1<NT),(t+1<NT));       ENDW(t);   RESC(); ROT();
    STEP(pA0,pA1,pB0,pB1,t+1,(t+4<NT),(t+2<NT),(t+2<NT));     ENDW(t+1); RESC(); ROT();
  }
  #undef CMASK
  #define CMASK(P0,P1,t) do{}while(0)
  for(;t+5<NT;t+=2){
    STEP(pB0,pB1,pA0,pA1,t,true,true,true);     WAIT_BAR(2); RESC(); ROT();
    STEP(pA0,pA1,pB0,pB1,t+1,true,true,true);   WAIT_BAR(2); RESC(); ROT();
  }
  for(;t+1<NT;t+=2){
    STEP(pB0,pB1,pA0,pA1,t,(t+3<NT),(t+1<NT),(t+1<NT));       ENDW(t);   RESC(); ROT();
    STEP(pA0,pA1,pB0,pB1,t+1,(t+4<NT),(t+2<NT),(t+2<NT));     ENDW(t+1); RESC(); ROT();
  }
  #undef CMASK
  #define CMASK(P0,P1,t) do{int jb_=3-(t); if(jb_>=0)cmask(P0,P1,jb_,qrel,hi);}while(0)
  STEP(pB0,pB1,pA0,pA1,NT-1,false,false,false); RESC();
  { float sacc=pB0[0]+pB0[1]; _Pragma("unroll") for(int r=2;r<16;++r)sacc+=pB0[r]; _Pragma("unroll") for(int r=0;r<16;++r)sacc+=pB1[r]; l_reg+=sacc;
    pw0=(u32x4_){PKW(pB0,0),PKW(pB0,2),PKW(pB0,4),PKW(pB0,6)};pw1=(u32x4_){PKW(pB0,8),PKW(pB0,10),PKW(pB0,12),PKW(pB0,14)};pw2=(u32x4_){PKW(pB1,0),PKW(pB1,2),PKW(pB1,4),PKW(pB1,6)};pw3=(u32x4_){PKW(pB1,8),PKW(pB1,10),PKW(pB1,12),PKW(pB1,14)};
    SBAR(); pv(o,vb0+sl_cur,PAF(0),PAF(1),PAF(2),PAF(3)); }
  #undef PKW
  #undef PAF
  #undef VFR
  #undef PIN
  #undef MX3
  #undef GAPA
  #undef GAPB
  #undef EX
  #undef VRD
  #undef KRD
  #undef STEP
  #undef ENDW
  {auto rr=__builtin_amdgcn_permlane32_swap(__float_as_uint(l_reg),__float_as_uint(l_reg),false,false);l_reg=__uint_as_float(rr[0])+__uint_as_float(rr[1]);}
  if(hi==0)wsf[32+r32]=l_reg;asm volatile("s_waitcnt lgkmcnt(0)":::"memory");
  float rli[16];
  #pragma unroll
  for(int r=0;r<16;++r)rli[r]=__builtin_amdgcn_rcpf(wsf[32+crow(r,hi)]);
  bf16*Ow=O+(rowbase+q0+wid*QBLK)*DMP+h*D;
  { bf16*stg=(bf16*)(shm+LDS_OST)+wid*2048;
    #pragma unroll
    for(int r=0;r<16;++r){const int orow=crow(r,hi);
      #pragma unroll
      for(int d0=0;d0<2;++d0)stg[orow*64+d0*32+r32]=(bf16)f2bf(o[d0][r]*rli[r]);}
    asm volatile("s_waitcnt lgkmcnt(0)":::"memory");
    #pragma unroll
    for(int i=0;i<4;++i){const int row=i*8+(lane>>3),ch=lane&7; const u32x4_ v=*(const u32x4_*)(stg+row*64+ch*8); *(u32x4_*)(Ow+(long)row*DMP+ch*8)=v;} }
  asm volatile("s_waitcnt lgkmcnt(0)\n\ts_barrier":::"memory");
  #undef DMA_K
  #undef DMA_V
  #undef CMASK
  #undef START
  #undef RESC
  #undef ROT
  #undef TJ
  #undef CKP
}
#undef SBAR
#undef WAIT_BAR
}

__device__ __forceinline__ void p_norms(const Frame& Fin_, const Params& P) {
    Frame F = Fin_; LAUNDER(F);
    const float* NP = (const float*)(P.ws + WS_NP); float* QN = (float*)(P.ws + WS_QN); float* KN = (float*)(P.ws + WS_KN);
    const int gw = ((int)blockIdx.x - 160) * NWAVES + F.wave, NGW = (F.G - 160) * NWAVES;
    for (int it = gw; it < T / 64; it += NGW) { const int b = it >> 7, tile = it & 127; const float* p = NP + ((size_t)b * SEQ + tile * 64) * 32 + F.lane;
        float v[32];
#pragma unroll
        for (int i = 0; i < 32; ++i) v[i] = p[i * 64];
        float m = 0.f;
#pragma unroll
        for (int i = 0; i < 32; ++i) m = fmaxf(m, v[i] + __shfl_xor(v[i], 1));
        m = fmaxf(m, __shfl_xor(m, 32)) * (1.0f + 1.0f / 64.0f);
        const int seg = F.lane & 31;
        if (F.lane < 32 && (seg & 1) == 0) { if (seg < 16) QN[(b * NH + (seg >> 1)) * 128 + tile] = m; else KN[(b * NH + ((seg - 16) >> 1)) * 128 + tile] = m; } }
}


#define XB_TMO      128
#define XB_XCNT(j)  (256  + 64 * (j))
#define XB_XSUB(j)  (1280 + 64 * (j))
#define XB_XGEN(j)  (2304 + 64 * (j))
#define XB_TOP      3328
#define XB_TOPGEN   3392
#define XCD_BAR_WORDS 3456
#define XB_SPIN_CAP (1u << 18)
constexpr int CW_BAR = 4096;
constexpr size_t CTL_ZERO_BYTES = 65536;
constexpr unsigned REP_MASK = 0u;
constexpr int CW_ATTNQ = 8192;
constexpr int LDSCTL_OFF = RING_BYTES, MISC_OFF = LDSCTL_OFF + 320;
__device__ __forceinline__ unsigned xb_ld(unsigned* p)              { return __hip_atomic_load(p, __ATOMIC_RELAXED, __HIP_MEMORY_SCOPE_AGENT); }
__device__ __forceinline__ unsigned xb_add(unsigned* p, unsigned v) { return __hip_atomic_fetch_add(p, v, __ATOMIC_RELAXED, __HIP_MEMORY_SCOPE_AGENT); }
__device__ __forceinline__ unsigned xb_xcc_id() { return (unsigned)__builtin_amdgcn_s_getreg((3 << 11) | 20) & 0xFu; }
#define XB_SPIN(cond, bar) do { unsigned _sp = 0; while (cond) { __builtin_amdgcn_s_sleep(1); \
    if ((++_sp & 255u) == 0u) { if (xb_ld(&(bar)[XB_TMO])) break; if (_sp > XB_SPIN_CAP) { atomicAdd(&(bar)[XB_TMO], 1u); break; } } } } while (0)
struct XcdBarrier { unsigned* bar; unsigned x; volatile LAS unsigned* st; };
__device__ __forceinline__ XcdBarrier xcd_barrier_post(unsigned* bar, volatile LAS unsigned* st) {
    XcdBarrier b; b.bar = bar; b.x = xb_xcc_id(); b.st = st;
    if (threadIdx.x == 0) (void)xb_add(&bar[XB_XCNT(b.x)], 1u);
    return b;
}
__device__ __forceinline__ void xcd_barrier_complete(unsigned* bar, unsigned x, unsigned& nloc, unsigned& nx) {
    const unsigned G = gridDim.x * gridDim.y * gridDim.z;
    unsigned sum, cnt, mine, sp = 0u;
    for (;;) {
        sum = 0u; cnt = 0u; mine = 0u;
#pragma unroll
        for (unsigned j = 0; j < 16; ++j) { const unsigned c = xb_ld(&bar[XB_XCNT(j)]); sum += c; cnt += (c > 0u) ? 1u : 0u; mine = (j == x) ? c : mine; }
        if (sum == G) break;
        __builtin_amdgcn_s_sleep(1);
        if ((++sp & 255u) == 0u) { if (xb_ld(&bar[XB_TMO])) break; if (sp > XB_SPIN_CAP) { atomicAdd(&bar[XB_TMO], 1u); break; } }
    }
    nloc = mine > 0u ? mine : 1u; nx = cnt > 0u ? cnt : 1u;
}
__device__ __forceinline__ void xcd_barrier(const XcdBarrier& b) {
    asm volatile("s_waitcnt vmcnt(0)" ::: "memory");
    __syncthreads();
    if (threadIdx.x == 0) {
        unsigned* bar = b.bar;
        __builtin_amdgcn_s_waitcnt(0);
        unsigned nloc = b.st[0], nx = b.st[1];
        if (nloc == 0u) { xcd_barrier_complete(bar, b.x, nloc, nx); b.st[0] = nloc; b.st[1] = nx; }
        const unsigned old = xb_add(&bar[XB_XSUB(b.x)], 1u);
        const unsigned gen = old / nloc;
        if (old + 1u == (gen + 1u) * nloc) {
            __builtin_amdgcn_fence(__ATOMIC_RELEASE, "agent");
            asm volatile("s_waitcnt vmcnt(0)" ::: "memory");
            const unsigned og = xb_add(&bar[XB_TOP], 1u);
            const unsigned tg = og / nx;
            __builtin_amdgcn_fence(__ATOMIC_ACQUIRE, "agent");
            if (og + 1u == (tg + 1u) * nx) xb_add(&bar[XB_TOPGEN], 1u);
            else XB_SPIN(xb_ld(&bar[XB_TOPGEN]) == tg, bar);
            xb_add(&bar[XB_XGEN(b.x)], 1u);
            asm volatile("s_waitcnt vmcnt(0)" ::: "memory");
        } else {
            __builtin_amdgcn_fence(__ATOMIC_ACQUIRE, "agent");
            XB_SPIN(xb_ld(&bar[XB_XGEN(b.x)]) == gen, bar);
            asm volatile("s_waitcnt vmcnt(0)" ::: "memory");
        }
    }
    __syncthreads();
}


__device__ __forceinline__ void attn_only_phase(const fox::Tensors& TT, char* lds, unsigned* ctr, volatile LAS int* qw) {
    if (threadIdx.x == 0) qw[0] = (int)__hip_atomic_fetch_add(ctr, 1u, __ATOMIC_RELAXED, __HIP_MEMORY_SCOPE_AGENT);
    __syncthreads();
    for (int slot = 0;; slot ^= 1) { const int u = qw[slot]; if (u >= 32 * 32) break;
        int nxt = 0; if (threadIdx.x == 0) nxt = (int)__hip_atomic_fetch_add(ctr, 1u, __ATOMIC_RELAXED, __HIP_MEMORY_SCOPE_AGENT);
        const int qb = 31 - (u >> 5), bh = u & 31; fox::attn_unit<8>(bh / NH, bh % NH, qb, TT, lds);
        if (threadIdx.x == 0) qw[slot ^ 1] = nxt; __syncthreads(); }
}

enum Phase { PH_PRO = 0, PH_PROJ, PH_CUMSUM, PH_SSMS, PH_CARRY, PH_SSMY, PH_ATTN, PH_GLU, PH_OUTA, PH_OUTB, PH_WOUT, PH_ROUTER, PH_POS, PH_MOEGU, PH_MOEMIX, PH_MOEDN, PH_FINAL, PH_N };

__global__ void __launch_bounds__(NTHR, 2) mega(Params P) {
    extern __shared__ __attribute__((aligned(16))) unsigned char lds_raw[];
    Frame F; F.lds = (LAS unsigned char*)lds_raw; F.tid = threadIdx.x; F.lane = F.tid & 63; F.wave = __builtin_amdgcn_readfirstlane(F.tid >> 6);
    F.G = gridDim.x; { const int bx = blockIdx.x; F.vcu = (F.G % 8 == 0) ? (bx % 8) * (F.G / 8) + bx / 8 : bx; }
    const int lo = P.ph_lo, hi = P.ph_hi;
    unsigned char* ws = P.ws;
    for (int u = F.tid; u < (LDS_BYTES - LDSCTL_OFF) / 4; u += NTHR) ((LAS unsigned*)(F.lds + LDSCTL_OFF))[u] = 0u;
    __syncthreads();
    XcdBarrier bar; bar.bar = (unsigned*)(ws + WS_CTL) + CW_BAR; bar.x = 0; bar.st = nullptr;
    if (hi - lo > 1) bar = xcd_barrier_post((unsigned*)(ws + WS_CTL) + CW_BAR, (volatile LAS unsigned*)(F.lds + MISC_OFF) + 8);
#define IN(k) (lo <= (k) && (k) < hi)
#define SEAM(k) do { if (IN(k) && IN((k) + 1)) xcd_barrier(bar); } while (0)
#define REPEAT(i) for (int rep_ = 0; rep_ < 1 + (int)((REP_MASK >> (i)) & 1u); ++rep_)
    REPEAT(0) { if (IN(PH_PRO)) p0_prologue(F, P);
    SEAM(PH_PRO); }
    REPEAT(1) { if (IN(PH_PROJ)) { for (int i = F.tid; i < 2048; i += NTHR) ((LAS float*)(F.lds + BIAS_OFF))[i] = P.in[4][i] * -LOG2E; __syncthreads();
        SchedPlain S{(const bf16*)(ws + WS_XN), (const bf16*)(ws + WS_WIN), T / 256, NPROJ / 256, {1024, 1024, 1024}};
        EpiProj E{(bf16*)(ws + WS_Q), (bf16*)(ws + WS_K), (bf16*)(ws + WS_V), (bf16*)(ws + WS_UH), (bf16*)(ws + WS_GATES), (const LAS float*)(F.lds + BIAS_OFF), (float*)(ws + WS_NP)}; run_gemm(F.lds, S.d, S, E); }
    SEAM(PH_PROJ); }
    REPEAT(2) { if (IN(PH_CUMSUM)) { if (blockIdx.x >= 160) p_norms(F, P); else if (blockIdx.x >= 128) p_cumsum(F, P);
        if (blockIdx.x >= 128) { __syncthreads(); p0_weights(F, P, 1); } }
    if (IN(PH_SSMS)) { SchedSsmS S{(const bf16*)(ws + WS_UH), (const bf16*)(ws + WS_WS)}; EpiSsmS E{(float*)(ws + WS_S)}; run_gemm(F.lds, GemmDims{512, KY, 512}, S, E); }
    if (IN(PH_CARRY)) { __syncthreads(); p_carry(F, P); }
    SEAM(PH_CARRY); }
    REPEAT(3) { if (IN(PH_SSMY)) { SchedSsmY S{(const bf16*)(ws + WS_UH), (const bf16*)(ws + WS_MX), F.G}; EpiSsmY E{(bf16*)(ws + WS_Z)}; run_gemm(F.lds, GemmDims{KY, KY, KY}, S, E); __syncthreads(); }
    if (IN(PH_ATTN)) { const fox::Tensors TT{(const bf16*)(ws + WS_Q), (const bf16*)(ws + WS_K), (const bf16*)(ws + WS_V), (bf16*)(ws + WS_OA), (const float*)(ws + WS_CK2), (const float*)(ws + WS_QN), (const float*)(ws + WS_KN)};
        attn_only_phase(TT, (char*)lds_raw, (unsigned*)(ws + WS_CTL) + CW_ATTNQ + 64 * rep_, (volatile LAS int*)(F.lds + MISC_OFF) + 16); }
    SEAM(PH_ATTN); }
    REPEAT(5) { if (IN(PH_GLU)) { for (int i = F.tid; i < 512; i += NTHR) ((LAS float*)(F.lds + BIAS_OFF))[i] = P.in[15][i] * -LOG2E; __syncthreads();
        SchedPlain S{(const bf16*)(ws + WS_Z), (const bf16*)(ws + WS_WGLU), T / 256, 2, {512, 512, 512}}; EpiGlu E{(const bf16*)(ws + WS_Z), (bf16*)(ws + WS_ZZ), (const LAS float*)(F.lds + BIAS_OFF)}; run_gemm(F.lds, S.d, S, E); }
    SEAM(PH_GLU); }
    REPEAT(6) { if (IN(PH_OUTB)) { SchedOutAB S{(const bf16*)(ws + WS_OA), (const bf16*)(ws + WS_ZZ), (const bf16*)(ws + WS_WOA), (const bf16*)(ws + WS_WOB)}; EpiOutAB E{(const unsigned char*)(ws + WS_GATES), (bf16*)(ws + WS_MERGED)};
        run_gemm(F.lds, GemmDims{1024, 512, 512}, S, E); }
    SEAM(PH_OUTB); }
    REPEAT(7) { if (IN(PH_WOUT)) { SchedPlain S{(const bf16*)(ws + WS_MERGED), (const bf16*)(ws + WS_WO), T / 256, 4, {1024, 1024, 1024}};
        { UnitX u0; u0.pn = 0; S.get((int)blockIdx.x, u0); stage_router_table(F, P, u0.pn); }
        EpiWout E{P.in[0], (bf16*)(ws + WS_H2), (float*)(ws + WS_PART), (const LAS unsigned char*)(F.lds + RT_OFF)}; run_gemm(F.lds, S.d, S, E); }
    SEAM(PH_WOUT); }
    REPEAT(8) { if (IN(PH_ROUTER)) p_router(F, P, rep_ == 0);
    SEAM(PH_ROUTER); }
    REPEAT(10) { if (IN(PH_MOEGU)) { moe_tile_table(F, P);
        SchedMoeGU S{(const bf16*)(ws + WS_H2), (const bf16*)(ws + WS_WGU), (const int*)(ws + WS_LIST), (const LAS int*)(F.lds + TT_OFF), MoeRange{0, 512, 0, 0, F.G}}; EpiMoeGU E{(bf16*)(ws + WS_HACT), (const float*)(ws + WS_LPW)}; run_gemm(F.lds, GemmDims{1024, 1024, 1024}, S, E); }
    SEAM(PH_MOEGU); }
    REPEAT(11) { if (IN(PH_MOEMIX)) { const LAS int* tt = (const LAS int*)(F.lds + TT_OFF); const int nu = 4 * tt[568]; int L = nu - 512; L = L < 0 ? 0 : (L > F.G ? F.G : L);
        { SchedMoeGU S{(const bf16*)(ws + WS_H2), (const bf16*)(ws + WS_WGU), (const int*)(ws + WS_LIST), tt, MoeRange{512, nu, 1, 0, F.G}}; EpiMoeGU E{(bf16*)(ws + WS_HACT), (const float*)(ws + WS_LPW)}; run_gemm(F.lds, GemmDims{1024, 1024, 1024}, S, E); }
        { const int dn_b = nu < 512 ? nu : 512;
          SchedMoeDN S{(const bf16*)(ws + WS_HACT), (const bf16*)(ws + WS_WD), tt, MoeRange{0, dn_b, 2, L, F.G}}; EpiMoeDN E{(bf16*)(ws + WS_Y)}; run_gemm(F.lds, GemmDims{512, 512, 512}, S, E); } }
    SEAM(PH_MOEMIX); }
    REPEAT(13) { if (IN(PH_MOEDN)) { const LAS int* tt = (const LAS int*)(F.lds + TT_OFF); const int nu = 4 * tt[568]; int L = nu - 512; L = L < 0 ? 0 : (L > F.G ? F.G : L);
        int d0 = 2 * (F.G - L); { const int dn_b = nu < 512 ? nu : 512; d0 = d0 < dn_b ? d0 : dn_b; }
        SchedMoeDN S{(const bf16*)(ws + WS_HACT), (const bf16*)(ws + WS_WD), tt, MoeRange{d0, nu, 0, 0, F.G}}; EpiMoeDN E{(bf16*)(ws + WS_Y)}; run_gemm(F.lds, GemmDims{512, 512, 512}, S, E); }
    SEAM(PH_MOEDN); }
    REPEAT(12) { if (IN(PH_FINAL)) p_final(F, P); }
#undef REPEAT
#undef SEAM
#undef IN
}

static void launch_mega(const Params& base, int lo, int hi, int grid, hipStream_t stream) {
    Params p = base; p.ph_lo = lo; p.ph_hi = hi;
    hipLaunchKernelGGL(mega, dim3(grid), dim3(NTHR), LDS_BYTES, stream, p);
}

extern "C" void kernel_launch(void* const* d_in, const int* in_sizes, int n_in, void* d_out, int out_size, void* d_ws, size_t ws_size, hipStream_t stream) {
    static int grid = 0;
    if (grid == 0) {
        if (n_in != 27 || out_size != T * DM || ws_size < WS_END) { fprintf(stderr, "kernel_launch: unexpected shapes (n_in %d out %d ws %zu)\n", n_in, out_size, ws_size); grid = -1; return; }
        if (hipFuncSetAttribute((const void*)mega, hipFuncAttributeMaxDynamicSharedMemorySize, LDS_BYTES) != hipSuccess) { fprintf(stderr, "hipFuncSetAttribute failed\n"); grid = -1; return; }
        int dev = 0, cus = 0, per_cu = 0; hipGetDevice(&dev); hipDeviceGetAttribute(&cus, hipDeviceAttributeMultiprocessorCount, dev);
        hipOccupancyMaxActiveBlocksPerMultiprocessor(&per_cu, (const void*)mega, NTHR, LDS_BYTES);
        (void)hipGetLastError();
        grid = cus * (per_cu < 1 ? 1 : 1);
    }
    if (grid < 0) return;
    Params P{};
    for (int i = 0; i < 27; ++i) P.in[i] = (const float*)d_in[i];
    P.out = (float*)d_out; P.ws = (unsigned char*)d_ws;
    if (hipMemsetAsync((char*)d_ws + WS_CTL, 0, CTL_ZERO_BYTES, stream) != hipSuccess) { fprintf(stderr, "kernel_launch: memset failed\n"); return; }
    P.ph_lo = 0; P.ph_hi = PH_N;
    void* args[] = {&P};
    const hipError_t le = hipLaunchCooperativeKernel((const void*)mega, dim3(grid), dim3(NTHR), args, LDS_BYTES, stream);
    if (le != hipSuccess) fprintf(stderr, "kernel_launch: cooperative launch failed: %s (grid %d)\n", hipGetErrorString(le), grid);
}
```
